# Optimizing an MI355X kernel written in HIP

```python
import jax, jax.numpy as jnp
from jax import lax
import numpy as np

D_MODEL = 1024
BATCH = 2
SEQ = 8192
DEPTH = 2
DEC_BATCH = 8
DEC_SEQ = 2048
PAST_LEN = 128

HEAD_DIM = 64
N_ATTN_HEADS = 8
N_KV_HEADS = 2
ATTN_WIDTH = N_ATTN_HEADS * HEAD_DIM
KV_WIDTH = N_KV_HEADS * HEAD_DIM
N_GMLP_HEADS = 8
GMLP_WIDTH = N_GMLP_HEADS * HEAD_DIM
MIX_WIDTH = ATTN_WIDTH + GMLP_WIDTH
IN_PROJ_WIDTH = ATTN_WIDTH + 2 * KV_WIDTH + 2 * GMLP_WIDTH
WINDOW = 128
BLOCK = 128
CHUNK = 128
D_FF = 2816
EPS = 1e-6

kernel_name = "hymba_swa_gmlp_macaron_encoder"


def rms_norm(x, gain):
    x32 = x.astype(jnp.float32)
    y = x32 * lax.rsqrt(jnp.mean(x32 * x32, axis=-1, keepdims=True) + EPS)
    return (y * gain.astype(jnp.float32)).astype(x.dtype)


def swiglu(x, w_gate, w_up, w_down):
    return (jax.nn.silu(x @ w_gate) * (x @ w_up)) @ w_down


def windowed_gqa(q, k, v, sink, slopes):
    b, s = q.shape[0], q.shape[1]
    nb = s // BLOCK
    g = N_ATTN_HEADS // N_KV_HEADS
    qb = q.reshape(b, nb, BLOCK, N_KV_HEADS, g, HEAD_DIM)

    def band(t):
        tp = jnp.pad(t, ((0, 0), (BLOCK, BLOCK), (0, 0), (0, 0)))
        tp = tp.reshape(b, nb + 2, BLOCK, N_KV_HEADS, HEAD_DIM)
        return jnp.concatenate([tp[:, :-2], tp[:, 1:-1], tp[:, 2:]], axis=2)

    kb, vb = band(k), band(v)
    scores = jnp.einsum('bnqkgd,bnskd->bnkgqs', qb, kb).astype(jnp.float32) * (HEAD_DIM ** -0.5)
    qi = jnp.arange(BLOCK)[:, None]
    kj = jnp.arange(3 * BLOCK)[None, :]
    rel = kj - BLOCK - qi
    kpos = (jnp.arange(nb) * BLOCK)[:, None, None] - BLOCK + kj[None]
    valid = (jnp.abs(rel) <= WINDOW)[None] & (kpos >= 0) & (kpos < s)
    dist = jnp.abs(rel).astype(jnp.float32)
    alibi = -slopes.astype(jnp.float32).reshape(N_KV_HEADS, g)[:, :, None, None] * dist
    scores = jnp.where(valid[None, :, None, None], scores + alibi[None, None], -jnp.inf)
    sink_l = sink.astype(jnp.float32).reshape(N_KV_HEADS, g)[None, None, :, :, None, None]
    m = jnp.maximum(jnp.max(scores, axis=-1, keepdims=True), sink_l)
    p = jnp.exp(scores - m)
    denom = jnp.sum(p, axis=-1, keepdims=True) + jnp.exp(sink_l - m)
    probs = (p / denom).astype(v.dtype)
    out = jnp.einsum('bnkgqs,bnskd->bnqkgd', probs, vb)
    return out.reshape(b, s, ATTN_WIDTH)


def chunked_spatial_gating(u, gv, v_gain, w_s, b_s):
    b, s = u.shape[0], u.shape[1]
    nc = s // CHUNK
    u = jax.nn.gelu(u)
    gv = jax.nn.gelu(gv)
    gh = gv.reshape(b, s, N_GMLP_HEADS, HEAD_DIM)
    gh = rms_norm(gh, v_gain.reshape(N_GMLP_HEADS, HEAD_DIM))
    gh = gh.reshape(b, nc, CHUNK, N_GMLP_HEADS, HEAD_DIM)
    mixed = jnp.einsum('hts,bnshd->bnthd', w_s.astype(gh.dtype), gh)
    mixed = mixed + b_s.T.astype(gh.dtype)[None, None, :, :, None]
    out = u.reshape(b, nc, CHUNK, N_GMLP_HEADS, HEAD_DIM) * mixed
    return out.reshape(b, s, GMLP_WIDTH)


def trunk(x, norm_ffn1, w1_gate, w1_up, w1_down, norm_mix, w_in, sink, gmlp_v_gain,
          w_spatial, b_spatial, w_out, norm_ffn2, w2_gate, w2_up, w2_down, norm_final):
    b, s, _ = x.shape
    slopes = 2.0 ** (-8.0 * jnp.arange(1, N_ATTN_HEADS + 1, dtype=jnp.float32) / N_ATTN_HEADS)
    o1 = ATTN_WIDTH
    o2 = o1 + KV_WIDTH
    o3 = o2 + KV_WIDTH
    o4 = o3 + GMLP_WIDTH
    for l in range(DEPTH):
        h = rms_norm(x, norm_ffn1[l])
        x = x + 0.5 * swiglu(h, w1_gate[l], w1_up[l], w1_down[l])
        h = rms_norm(x, norm_mix[l])
        z = h @ w_in[l]
        q = z[..., :o1].reshape(b, s, N_ATTN_HEADS, HEAD_DIM)
        k = z[..., o1:o2].reshape(b, s, N_KV_HEADS, HEAD_DIM)
        v = z[..., o2:o3].reshape(b, s, N_KV_HEADS, HEAD_DIM)
        u = z[..., o3:o4]
        gv = z[..., o4:]
        a = windowed_gqa(q, k, v, sink[l], slopes)
        c = chunked_spatial_gating(u, gv, gmlp_v_gain[l], w_spatial[l], b_spatial[l])
        x = x + jnp.concatenate([a, c], axis=-1) @ w_out[l]
        h = rms_norm(x, norm_ffn2[l])
        x = x + 0.5 * swiglu(h, w2_gate[l], w2_up[l], w2_down[l])
    return rms_norm(x, norm_final)


def setup_inputs(seed: int = 0) -> dict:
    key = jax.random.key(seed)
    ks = jax.random.split(key, 20)
    f32 = jnp.float32

    def nrm(k, shape, scale):
        return jax.random.normal(k, shape, f32) * scale

    def gain(k, shape):
        return jnp.ones(shape, f32) + 0.02 * jax.random.normal(k, shape, f32)

    return {
        "x_prompt": jax.random.normal(ks[0], (BATCH, SEQ, D_MODEL), f32),
        "x_sample": jax.random.normal(ks[1], (DEC_BATCH, DEC_SEQ, D_MODEL), f32),
        "norm_ffn1": gain(ks[2], (DEPTH, D_MODEL)),
        "w1_gate": nrm(ks[3], (DEPTH, D_MODEL, D_FF), D_MODEL ** -0.5),
        "w1_up": nrm(ks[4], (DEPTH, D_MODEL, D_FF), D_MODEL ** -0.5),
        "w1_down": nrm(ks[5], (DEPTH, D_FF, D_MODEL), D_FF ** -0.5),
        "norm_mix": gain(ks[6], (DEPTH, D_MODEL)),
        "w_in": nrm(ks[7], (DEPTH, D_MODEL, IN_PROJ_WIDTH), D_MODEL ** -0.5),
        "sink": nrm(ks[8], (DEPTH, N_ATTN_HEADS), 0.5),
        "gmlp_v_gain": gain(ks[9], (DEPTH, GMLP_WIDTH)),
        "w_spatial": nrm(ks[10], (DEPTH, N_GMLP_HEADS, CHUNK, CHUNK), CHUNK ** -0.5),
        "b_spatial": gain(ks[11], (DEPTH, N_GMLP_HEADS, CHUNK)),
        "w_out": nrm(ks[12], (DEPTH, MIX_WIDTH, D_MODEL), MIX_WIDTH ** -0.5),
        "norm_ffn2": gain(ks[13], (DEPTH, D_MODEL)),
        "w2_gate": nrm(ks[14], (DEPTH, D_MODEL, D_FF), D_MODEL ** -0.5),
        "w2_up": nrm(ks[15], (DEPTH, D_MODEL, D_FF), D_MODEL ** -0.5),
        "w2_down": nrm(ks[16], (DEPTH, D_FF, D_MODEL), D_FF ** -0.5),
        "norm_final": gain(ks[17], (D_MODEL,)),
    }


def reference(x_prompt, x_sample, norm_ffn1, w1_gate, w1_up, w1_down, norm_mix, w_in, sink,
              gmlp_v_gain, w_spatial, b_spatial, w_out, norm_ffn2, w2_gate, w2_up, w2_down,
              norm_final):
    y_prompt = trunk(x_prompt, norm_ffn1, w1_gate, w1_up, w1_down, norm_mix, w_in, sink,
                     gmlp_v_gain, w_spatial, b_spatial, w_out, norm_ffn2, w2_gate, w2_up,
                     w2_down, norm_final)
    y_sample = trunk(x_sample, norm_ffn1, w1_gate, w1_up, w1_down, norm_mix, w_in, sink,
                     gmlp_v_gain, w_spatial, b_spatial, w_out, norm_ffn2, w2_gate, w2_up,
                     w2_down, norm_final)
    return (y_prompt, y_sample)
```

```cpp
#define WT_LAST_ONLY 1
#include <hip/hip_runtime.h>
#include <hip/hip_cooperative_groups.h>
#include <cstdio>
#include <cstdint>
#include <cmath>
namespace cg = cooperative_groups;
namespace pg8 {
#define PG8_LAS __attribute__((address_space(3)))
typedef unsigned short bf16_t;
typedef short bf16x8 __attribute__((ext_vector_type(8)));
typedef float f32x4 __attribute__((ext_vector_type(4)));
typedef unsigned u32x4 __attribute__((ext_vector_type(4)));
constexpr int BM = 256, BK = 64, HALF = 128, HTB = HALF * BK * 2  , STAGE_BYTES = 8 * HTB, NXCD = 8, WGM = 8;

__host__ __device__ __forceinline__ int lds_byte(int r, int c) { const int st = (r >> 4) * 2 + (c >> 5), rr = r & 15, cc = c & 31, ob = rr * 64 + cc * 2; return st * 1024 + (ob ^ (((ob >> 9) & 1) << 5)); }
__host__ __device__ __forceinline__ void stage_rc(int b, int& R, int& C) { const int st = b / 1024, sb = b % 1024, swz = sb ^ (((sb >> 9) & 1) << 5); R = (st >> 1) * 16 + swz / 64; C = (st & 1) * 32 + (swz % 64) / 2; }
__host__ __device__ __forceinline__ int perm32(int rho) { const int n = rho >> 4, i = rho & 15; return 8 * (i >> 2) + 4 * n + (i & 3); }

struct Unit { int pm, pn; };
struct Gemm { const bf16_t* A; const bf16_t* Bt; int M, N, K; };

struct StaticOrder {
    int nM, nN, nwg, G, c;
    __host__ __device__ void init(int M, int N, int G_, int c_) { nM = M / BM; nN = N / BM; nwg = nM * nN; G = G_; c = c_; }
    __host__ __device__ bool next(int i, Unit& u) const {
        const long L = (long)i * G + c; if (L >= nwg) return false;
        int wgid = (int)L; { const int q = nwg / NXCD, r = nwg % NXCD, xcd = wgid % NXCD, off = wgid / NXCD; wgid = (xcd < r ? xcd * (q + 1) : r * (q + 1) + (xcd - r) * q) + off; }
        const int nig = WGM * nN, gid = wgid / nig, fm = gid * WGM, gsz = (nM - fm) < WGM ? (nM - fm) : WGM;
        u.pm = fm + ((wgid % nig) % gsz); u.pn = (wgid % nig) / gsz; return true;
    }
    __device__ __forceinline__ void a_ready(const Unit&) const {}
    __device__ __forceinline__ void done(const Unit&) const {}
};

__device__ __forceinline__ unsigned cvt_pk_bf16(float lo, float hi) { unsigned r; asm volatile("v_cvt_pk_bf16_f32 %0, %1, %2" : "=v"(r) : "v"(lo), "v"(hi)); return r; }
typedef float f32x2 __attribute__((ext_vector_type(2)));
constexpr float RMS_EPS = 1e-6f;
__device__ __forceinline__ int opaque_v(int v) { asm volatile("" : "+v"(v)); return v; }
constexpr float K_LOG2E = 1.4426950408889634f;
__device__ __forceinline__ float fast_exp2(float x) { return __builtin_amdgcn_exp2f(x); }
__device__ __forceinline__ float fast_rcp(float x) { return __builtin_amdgcn_rcpf(x); }
__device__ __forceinline__ float silu_f(float g) { return g * fast_rcp(1.0f + fast_exp2(-K_LOG2E * g)); }
__device__ __forceinline__ float gelu_tanh_f(float v) { const float t = v * (1.0f + 0.044715f * v * v); return v * fast_rcp(1.0f + fast_exp2(-2.3022081978f * t)); }
typedef unsigned long long ss_t;
constexpr float SS_SCALE = 1048576.0f;
__device__ __forceinline__ ss_t ss_fix(float s) { return (ss_t)(s * SS_SCALE + 0.5f); }
__device__ __forceinline__ float rs_of(ss_t v) { return __builtin_amdgcn_rsqf((float)v * (1.0f / (1024.0f * SS_SCALE)) + RMS_EPS); }
__device__ __forceinline__ float row_rs(const ss_t* ss, int row) { return __builtin_amdgcn_rsqf((float)ss[row] * (1.0f / (1024.0f * SS_SCALE)) + RMS_EPS); }

#ifndef EPI_WT
#define EPI_WT 1
#endif
#ifndef WT_LAST_ONLY
#define WT_LAST_ONLY 0
#endif
#define WT_SEL(last) (WT_LAST_ONLY ? (last) : true)
__device__ __forceinline__ void store16_out(bf16_t* base, size_t nbytes, size_t elem_off, u32x4 w, bool wt) {
    if (EPI_WT && wt) { const __amdgpu_buffer_rsrc_t rs = __builtin_amdgcn_make_buffer_rsrc((void*)base, (short)0, (int)nbytes, 0x00020000);
        __builtin_amdgcn_raw_buffer_store_b128(w, rs, (unsigned)(elem_off * 2), 0,   16); }
    else *(u32x4*)(base + elem_off) = w;
}
__device__ __forceinline__ f32x2 swiglu_pk(f32x2 ag, f32x2 au, float rsn, float rs2) {
    const f32x2 t = ag * rsn; f32x2 e; e.x = fast_exp2(t.x); e.y = fast_exp2(t.y);
    const f32x2 den = e + 1.0f; f32x2 r; r.x = fast_rcp(den.x); r.y = fast_rcp(den.y);
    return ((ag * au) * rs2) * r;
}
struct EpiSwiglu {
    static constexpr bool PERM = true, AFTER_DRAIN = false;
    bf16_t* H; int ldh; const ss_t* ss;
    __device__ __forceinline__ void operator()(const f32x4 (&acc)[2][2][4][2], const Unit& u, int wr, int wc, int fr, int fq, bool last) const {
        const int row0 = u.pm * BM + wr * 64 + fr, col0 = u.pn * HALF + wc * 32 + 8 * fq;
        ss_t sv[2][4];
#pragma unroll
        for (int ai = 0; ai < 2; ++ai)
#pragma unroll
            for (int m = 0; m < 4; ++m) sv[ai][m] = ss[row0 + ai * HALF + m * 16];
#pragma unroll
        for (int ai = 0; ai < 2; ++ai)
#pragma unroll
            for (int m = 0; m < 4; ++m) {
                const int row = row0 + ai * HALF + m * 16; const float rs = rs_of(sv[ai][m]), rsn = -K_LOG2E * rs, rs2 = rs * rs;
                const f32x4 ag0 = acc[ai][0][m][0], ag1 = acc[ai][0][m][1], au0 = acc[ai][1][m][0], au1 = acc[ai][1][m][1];
                const f32x2 h0 = swiglu_pk((f32x2){ag0[0], ag0[1]}, (f32x2){au0[0], au0[1]}, rsn, rs2), h1 = swiglu_pk((f32x2){ag0[2], ag0[3]}, (f32x2){au0[2], au0[3]}, rsn, rs2);
                const f32x2 h2 = swiglu_pk((f32x2){ag1[0], ag1[1]}, (f32x2){au1[0], au1[1]}, rsn, rs2), h3 = swiglu_pk((f32x2){ag1[2], ag1[3]}, (f32x2){au1[2], au1[3]}, rsn, rs2);
                u32x4 w; w.x = cvt_pk_bf16(h0.x, h0.y); w.y = cvt_pk_bf16(h1.x, h1.y); w.z = cvt_pk_bf16(h2.x, h2.y); w.w = cvt_pk_bf16(h3.x, h3.y);
                store16_out(H, (size_t)32768 * 2816 * 2, (size_t)row * ldh + col0, w, WT_SEL(last));
                asm volatile("" ::: "memory");
            }
    }
};
__device__ __forceinline__ float bfl(unsigned w) { return __builtin_bit_cast(float, w << 16); }
__device__ __forceinline__ float bfh(unsigned w) { return __builtin_bit_cast(float, w & 0xffff0000u); }
struct EpiResid {
    static constexpr bool PERM = true, AFTER_DRAIN = false;
    bf16_t* XB; ss_t* ssn; float scale;
    __device__ __forceinline__ void operator()(const f32x4 (&acc)[2][2][4][2], const Unit& u, int wr, int wc, int fr, int fq, bool last) const {
        const int row0 = u.pm * BM + wr * 64 + fr, col0 = u.pn * BM + wc * 32 + 8 * fq;
#pragma unroll
        for (int ai = 0; ai < 2; ++ai) {
            u32x4 xw[4][2];
#pragma unroll
            for (int m = 0; m < 4; ++m)
#pragma unroll
                for (int bj = 0; bj < 2; ++bj) xw[m][bj] = *(const u32x4*)(XB + (size_t)(row0 + ai * HALF + m * 16) * 1024 + col0 + bj * HALF);
#pragma unroll
            for (int m = 0; m < 4; ++m) {
                const int row = row0 + ai * HALF + m * 16; float s = 0.f;
#pragma unroll
                for (int bj = 0; bj < 2; ++bj) {
                    bf16_t* xp = XB + (size_t)row * 1024 + col0 + bj * HALF;
                    const u32x4 w0 = xw[m][bj];
                    f32x4 x0 = (f32x4){bfl(w0.x), bfh(w0.x), bfl(w0.y), bfh(w0.y)}, x1 = (f32x4){bfl(w0.z), bfh(w0.z), bfl(w0.w), bfh(w0.w)};
                    x0 = x0 + acc[ai][bj][m][0] * scale; x1 = x1 + acc[ai][bj][m][1] * scale;
                    s += (x0[0] * x0[0] + x0[1] * x0[1]) + (x0[2] * x0[2] + x0[3] * x0[3]) + (x1[0] * x1[0] + x1[1] * x1[1]) + (x1[2] * x1[2] + x1[3] * x1[3]);
                    u32x4 w; w.x = cvt_pk_bf16(x0[0], x0[1]); w.y = cvt_pk_bf16(x0[2], x0[3]); w.z = cvt_pk_bf16(x1[0], x1[1]); w.w = cvt_pk_bf16(x1[2], x1[3]);
                    store16_out(XB, (size_t)32768 * 1024 * 2, (size_t)row * 1024 + col0 + bj * HALF, w, WT_SEL(last));
                }
                s += __shfl_xor(s, 16); s += __shfl_xor(s, 32);
                if (fq == 0 && ssn) atomicAdd(ssn + row, ss_fix(s));
            }
            asm volatile("" ::: "memory");
        }
    }
};
struct EpiInProj {
    static constexpr bool PERM = true, AFTER_DRAIN = false;
    bf16_t* Z; const ss_t* ss; const float* vgain;
    __device__ __forceinline__ void operator()(const f32x4 (&acc)[2][2][4][2], const Unit& u, int wr, int wc, int fr, int fq, bool last) const {
        const int row0 = u.pm * BM + wr * 64 + fr, pn = u.pn;
        const int mode = pn < 2 ? 0 : (pn == 2 ? 1 : (pn < 5 ? 2 : 3));
        int colb[2]; f32x4 gv[2][2];
#pragma unroll
        for (int bj = 0; bj < 2; ++bj) {
            colb[bj] = mode == 3 ? 1280 + 64 * (4 * (pn - 5) + wc) + 32 * bj + 8 * fq : 256 * pn + 128 * bj + 32 * wc + 8 * fq;
#pragma unroll
            for (int n = 0; n < 2; ++n) gv[bj][n] = mode == 3 ? *(const f32x4*)(vgain + (colb[bj] - 1280) + 4 * n) : (f32x4){1.f, 1.f, 1.f, 1.f};
        }
        ss_t sv[2][4];
#pragma unroll
        for (int ai = 0; ai < 2; ++ai)
#pragma unroll
            for (int m = 0; m < 4; ++m) sv[ai][m] = ss[row0 + ai * HALF + m * 16];
#pragma unroll
        for (int ai = 0; ai < 2; ++ai)
#pragma unroll
            for (int m = 0; m < 4; ++m) {
                const int row = row0 + ai * HALF + m * 16; const float rs = rs_of(sv[ai][m]);
                f32x4 v[2][2];
#pragma unroll
                for (int bj = 0; bj < 2; ++bj)
#pragma unroll
                    for (int n = 0; n < 2; ++n) v[bj][n] = acc[ai][bj][m][n] * rs;
                if (mode == 0) {
#pragma unroll
                    for (int bj = 0; bj < 2; ++bj)
#pragma unroll
                        for (int n = 0; n < 2; ++n) v[bj][n] = v[bj][n] * (0.125f * K_LOG2E);
                } else if (mode >= 2) {
#pragma unroll
                    for (int bj = 0; bj < 2; ++bj)
#pragma unroll
                        for (int n = 0; n < 2; ++n)
#pragma unroll
                            for (int e = 0; e < 4; ++e) v[bj][n][e] = gelu_tanh_f(v[bj][n][e]);
                    if (mode == 3) {
                        float q = 0.f;
#pragma unroll
                        for (int bj = 0; bj < 2; ++bj)
#pragma unroll
                            for (int n = 0; n < 2; ++n) q += (v[bj][n][0] * v[bj][n][0] + v[bj][n][1] * v[bj][n][1]) + (v[bj][n][2] * v[bj][n][2] + v[bj][n][3] * v[bj][n][3]);
                        q += __shfl_xor(q, 16); q += __shfl_xor(q, 32);
                        const float r2 = __builtin_amdgcn_rsqf(q * (1.0f / 64.0f) + RMS_EPS);
#pragma unroll
                        for (int bj = 0; bj < 2; ++bj)
#pragma unroll
                            for (int n = 0; n < 2; ++n) v[bj][n] = v[bj][n] * r2 * gv[bj][n];
                    }
                }
#pragma unroll
                for (int bj = 0; bj < 2; ++bj) {
                    u32x4 w; w.x = cvt_pk_bf16(v[bj][0][0], v[bj][0][1]); w.y = cvt_pk_bf16(v[bj][0][2], v[bj][0][3]); w.z = cvt_pk_bf16(v[bj][1][0], v[bj][1][1]); w.w = cvt_pk_bf16(v[bj][1][2], v[bj][1][3]);
                    store16_out(Z, (size_t)32768 * 1792 * 2, (size_t)row * 1792 + colb[bj], w, WT_SEL(last));
                }
                asm volatile("" ::: "memory");
            }
    }
};

template <class Epi, class Sched, bool ALIGN_EPI = false, bool SP2 = false>
__device__ __forceinline__ void gemm_phase(PG8_LAS unsigned char* lds, const Gemm g, const Sched& S, const Epi& E) {
    const int tid = opaque_v((int)threadIdx.x), wid = __builtin_amdgcn_readfirstlane(tid >> 6), lane = tid & 63, wr = wid >> 2, wc = wid & 3, fr = lane & 15, fq = lane >> 4;
    const int K = g.K, nt = K / BK;
    unsigned voffA[2], voffB[2];
#pragma unroll
    for (int i = 0; i < 2; ++i) { int R, C; stage_rc(tid * 16 + i * 8192, R, C); const int Rb = Epi::PERM ? ((R & ~31) + perm32(R & 31)) : R;
        voffA[i] = (unsigned)(R * K + C) * 2u; voffB[i] = (unsigned)(Rb * K + C) * 2u; }
    const size_t kstep = (size_t)(BK * 2);
    const size_t hstep = (size_t)HALF * K * 2;
    const size_t tstep = 2 * hstep;
    const unsigned ldsw = (unsigned)wid * 1024u;
    const int aoff = lds_byte(wr * 64 + fr, fq * 8), boff = lds_byte(wc * 32 + fr, fq * 8);
#define PG8_SA(b, h) (((b) * 2 + (h)) * HTB)
#define PG8_SB(b, h) ((4 + (b) * 2 + (h)) * HTB)
#define PG8_STAGE(bufoff, gbase, voff) do { _Pragma("unroll") for (int _i = 0; _i < 2; ++_i) \
        __builtin_amdgcn_global_load_lds((const unsigned*)((const char*)(gbase) + (voff)[_i]), (PG8_LAS unsigned*)(lds + (bufoff) + ldsw + _i * 8192), 16, 0, 0); } while (0)
#define PG8_LDA(dst, b, h) do { _Pragma("unroll") for (int m = 0; m < 4; ++m) _Pragma("unroll") for (int k = 0; k < 2; ++k) dst[m][k] = *(const PG8_LAS bf16x8*)(lds + PG8_SA(b, h) + aoff + m * 2048 + k * 1024); } while (0)
#define PG8_LDB(dst, b, h) do { _Pragma("unroll") for (int n = 0; n < 2; ++n) _Pragma("unroll") for (int k = 0; k < 2; ++k) dst[n][k] = *(const PG8_LAS bf16x8*)(lds + PG8_SB(b, h) + boff + n * 2048 + k * 1024); } while (0)
#define PG8_MMA(ai, bj, At, Bt) do { __builtin_amdgcn_s_setprio(1); _Pragma("unroll") for (int m = 0; m < 4; ++m) _Pragma("unroll") for (int n = 0; n < 2; ++n) _Pragma("unroll") for (int k = 0; k < 2; ++k) \
        acc[ai][bj][m][n] = __builtin_amdgcn_mfma_f32_16x16x32_bf16(Bt[n][k], At[m][k], acc[ai][bj][m][n], 0, 0, 0); __builtin_amdgcn_s_setprio(0); } while (0)
#define PG8_WAIT_V(n) asm volatile("s_waitcnt vmcnt(" #n ")" ::: "memory")
#define PG8_WAIT_L(n) asm volatile("s_waitcnt lgkmcnt(" #n ")" ::: "memory")
#define PG8_BAR __builtin_amdgcn_s_barrier()
#define PG8_SCHED __builtin_amdgcn_sched_barrier(0)
    Unit cur, nxt; int ui = 0;
    if (!S.next(0, cur)) return;
    f32x4 acc[2][2][4][2];
#pragma unroll
    for (int a = 0; a < 2; ++a)
#pragma unroll
        for (int b = 0; b < 2; ++b)
#pragma unroll
            for (int m = 0; m < 4; ++m)
#pragma unroll
                for (int n = 0; n < 2; ++n) acc[a][b][m][n] = (f32x4){0.f, 0.f, 0.f, 0.f};
    bf16x8 At[4][2], B0[2][2], B1[2][2];
    const char* cA = (const char*)g.A + (size_t)cur.pm * tstep; const char* cB = (const char*)g.Bt + (size_t)cur.pn * tstep;
    S.a_ready(cur);
    if constexpr (SP2) {
        PG8_STAGE(PG8_SB(0, 0), cB, voffB); PG8_STAGE(PG8_SB(0, 1), cB + hstep, voffB); PG8_STAGE(PG8_SA(0, 0), cA, voffA); PG8_STAGE(PG8_SA(0, 1), cA + hstep, voffA);
        if (wr == 1) PG8_BAR;
        PG8_WAIT_V(2); PG8_BAR;
        PG8_STAGE(PG8_SB(1, 0), cB + kstep, voffB); PG8_STAGE(PG8_SA(1, 0), cA + kstep, voffA); PG8_STAGE(PG8_SB(1, 1), cB + hstep + kstep, voffB);
        PG8_WAIT_V(6); PG8_BAR;
    } else {
        PG8_STAGE(PG8_SB(0, 0), cB, voffB); PG8_STAGE(PG8_SA(0, 0), cA, voffA); PG8_STAGE(PG8_SB(0, 1), cB + hstep, voffB); PG8_STAGE(PG8_SA(0, 1), cA + hstep, voffA);
        if (wr == 1) PG8_BAR;
        PG8_WAIT_V(4); PG8_BAR;
        PG8_STAGE(PG8_SB(1, 0), cB + kstep, voffB); PG8_STAGE(PG8_SA(1, 0), cA + kstep, voffA); PG8_STAGE(PG8_SB(1, 1), cB + hstep + kstep, voffB);
        PG8_WAIT_V(6); PG8_BAR;
    }
    for (;;) {
        const bool has_next = S.next(ui + 1, nxt);
        const char* nA = has_next ? (const char*)g.A + (size_t)nxt.pm * tstep : cA; const char* nB = has_next ? (const char*)g.Bt + (size_t)nxt.pn * tstep : cB;
        for (int t = 0; t < nt; t += 2) {
            const bool last = (t == nt - 2);
            const char* a1 = cA + (size_t)(t + 1) * kstep;
            const char* a2 = last ? nA : cA + (size_t)(t + 2) * kstep; const char* b2 = last ? nB : cB + (size_t)(t + 2) * kstep;
            const char* a3 = a2 + kstep; const char* b3 = b2 + kstep;
            if (last && has_next) S.a_ready(nxt);
            if constexpr (SP2) {
            PG8_LDB(B0, 0, 0); PG8_LDB(B1, 0, 1); PG8_SCHED; PG8_LDA(At, 0, 0); PG8_STAGE(PG8_SA(1, 1), a1 + hstep, voffA);
            PG8_WAIT_V(8); PG8_WAIT_L(0); PG8_BAR; PG8_MMA(0, 0, At, B0); PG8_MMA(0, 1, At, B1); PG8_BAR; PG8_SCHED;
            PG8_LDA(At, 0, 1); PG8_STAGE(PG8_SB(0, 0), b2, voffB); PG8_STAGE(PG8_SB(0, 1), b2 + hstep, voffB); PG8_STAGE(PG8_SA(0, 0), a2, voffA);
            PG8_WAIT_V(8); PG8_WAIT_L(0); PG8_BAR; PG8_MMA(1, 0, At, B0); PG8_MMA(1, 1, At, B1); PG8_BAR; PG8_SCHED;
            PG8_LDB(B0, 1, 0); PG8_LDB(B1, 1, 1); PG8_SCHED; PG8_LDA(At, 1, 0); PG8_STAGE(PG8_SA(0, 1), a2 + hstep, voffA);
            PG8_WAIT_V(8); PG8_WAIT_L(0); PG8_BAR; PG8_MMA(0, 0, At, B0); PG8_MMA(0, 1, At, B1); PG8_BAR; PG8_SCHED;
            PG8_LDA(At, 1, 1); PG8_STAGE(PG8_SB(1, 0), b3, voffB); PG8_STAGE(PG8_SB(1, 1), b3 + hstep, voffB); PG8_STAGE(PG8_SA(1, 0), a3, voffA);
            PG8_WAIT_V(8); PG8_WAIT_L(0); PG8_BAR; PG8_MMA(1, 0, At, B0); PG8_MMA(1, 1, At, B1); PG8_BAR; PG8_SCHED;
            } else {
            PG8_LDB(B0, 0, 0); PG8_SCHED; PG8_LDA(At, 0, 0); PG8_STAGE(PG8_SA(1, 1), a1 + hstep, voffA);
            PG8_WAIT_L(8); PG8_BAR; PG8_WAIT_L(0); PG8_MMA(0, 0, At, B0); PG8_BAR; PG8_SCHED;
            PG8_LDB(B1, 0, 1); PG8_STAGE(PG8_SB(0, 0), b2, voffB);
            PG8_BAR; PG8_WAIT_L(0); PG8_MMA(0, 1, At, B1); PG8_BAR;
            PG8_LDA(At, 0, 1); PG8_STAGE(PG8_SA(0, 0), a2, voffA);
            PG8_BAR; PG8_WAIT_L(0); PG8_MMA(1, 0, At, B0); PG8_BAR; PG8_SCHED;
            PG8_STAGE(PG8_SB(0, 1), b2 + hstep, voffB);
            PG8_WAIT_V(6); PG8_BAR; PG8_MMA(1, 1, At, B1); PG8_BAR;
            PG8_LDB(B0, 1, 0); PG8_SCHED; PG8_LDA(At, 1, 0); PG8_STAGE(PG8_SA(0, 1), a2 + hstep, voffA);
            PG8_WAIT_L(8); PG8_BAR; PG8_WAIT_L(0); PG8_MMA(0, 0, At, B0); PG8_BAR; PG8_SCHED;
            PG8_LDB(B1, 1, 1); PG8_STAGE(PG8_SB(1, 0), b3, voffB);
            PG8_BAR; PG8_WAIT_L(0); PG8_MMA(0, 1, At, B1); PG8_BAR;
            PG8_LDA(At, 1, 1); PG8_STAGE(PG8_SA(1, 0), a3, voffA);
            PG8_BAR; PG8_WAIT_L(0); PG8_MMA(1, 0, At, B0); PG8_BAR; PG8_SCHED;
            PG8_STAGE(PG8_SB(1, 1), b3 + hstep, voffB);
            PG8_WAIT_V(6); PG8_BAR; PG8_MMA(1, 1, At, B1); PG8_BAR;
            }
        }
        if constexpr (ALIGN_EPI) { if (wr == 0) PG8_BAR; }
        if constexpr (!Epi::AFTER_DRAIN) { E(acc, cur, wr, wc, fr, fq, !has_next); S.done(cur); }
        if (!has_next) break;
#pragma unroll
        for (int a = 0; a < 2; ++a)
#pragma unroll
            for (int b = 0; b < 2; ++b)
#pragma unroll
                for (int m = 0; m < 4; ++m)
#pragma unroll
                    for (int n = 0; n < 2; ++n) acc[a][b][m][n] = (f32x4){0.f, 0.f, 0.f, 0.f};
        cur = nxt; cA = nA; cB = nB; ++ui;
        if constexpr (ALIGN_EPI) { if (wr == 1) PG8_BAR; }
    }
    PG8_WAIT_V(0);
    if constexpr (!ALIGN_EPI) { if (wr == 0) PG8_BAR; }
    PG8_BAR;
    if constexpr (Epi::AFTER_DRAIN) { E.fused(acc, cur, wr, wc, fr, fq, lds, wid, lane); S.done(cur); }
#undef PG8_SA
#undef PG8_SB
#undef PG8_STAGE
#undef PG8_LDA
#undef PG8_LDB
#undef PG8_MMA
#undef PG8_WAIT_V
#undef PG8_WAIT_L
#undef PG8_BAR
#undef PG8_SCHED
}
}

#ifndef PH_MASK
#define PH_MASK 127
#endif
#ifndef N_LAYER
#define N_LAYER 2
#endif
constexpr int NWAVES = 8;
constexpr int TOK = 32768, TOKP = 16384, DM = 1024, FF = 2816, NIN = 1792, NLAYER = N_LAYER, NBLK = TOK / 128;
constexpr size_t WS_SS = 0;
constexpr size_t WS_W = 2u << 20;
constexpr size_t W_GU1 = 0, W_D1 = W_GU1 + (size_t)2 * FF * DM * 2, W_IN = W_D1 + (size_t)DM * FF * 2, W_OUT = W_IN + (size_t)NIN * DM * 2,
                 W_GU2 = W_OUT + (size_t)DM * DM * 2, W_D2 = W_GU2 + (size_t)2 * FF * DM * 2, W_BYTES = W_D2 + (size_t)DM * FF * 2;
constexpr size_t WS_XB = WS_W + W_BYTES;
constexpr size_t WS_R1 = WS_XB + (size_t)TOK * DM * 2;
constexpr size_t WS_Z = WS_R1, WS_MIX = WS_R1 + (size_t)TOK * NIN * 2, WS_H = WS_R1;
constexpr size_t WS_WSB = WS_R1 + (size_t)TOK * FF * 2;
constexpr size_t WS_END = WS_WSB + (size_t)NLAYER * 8 * 128 * 128 * 2;
static_assert(WS_MIX + (size_t)TOK * DM * 2 == WS_WSB && WS_XB % 256 == 0 && WS_R1 % 256 == 0, "d_ws map");
constexpr int LDSCTL_OFF = 147456 - 256;
constexpr size_t WS_BAR = 0x1D0000, WS_BAR_BYTES = 16384;
constexpr int LDS_BYTES = 147456;

#define LAS __attribute__((address_space(3)))
typedef unsigned short bf16;
typedef unsigned v4u __attribute__((ext_vector_type(4)));
typedef unsigned v2u __attribute__((ext_vector_type(2)));
typedef float f32x4 __attribute__((ext_vector_type(4)));
typedef short bf16x8 __attribute__((ext_vector_type(8)));
typedef short s16x4 __attribute__((ext_vector_type(4)));
typedef short v4i16_t __attribute__((ext_vector_type(4)));
#define LDS_WAIT() asm volatile("s_waitcnt lgkmcnt(0)" ::: "memory")
typedef float f32x2_t __attribute__((ext_vector_type(2)));
typedef __bf16 bf16x2_t __attribute__((ext_vector_type(2)));
__device__ __forceinline__ unsigned pk2(float lo, float hi) { f32x2_t v = {lo, hi}; bf16x2_t b = __builtin_convertvector(v, bf16x2_t); return __builtin_bit_cast(unsigned, b); }
__device__ __forceinline__ float bf_lo(unsigned w) { return __builtin_bit_cast(float, w << 16); }
__device__ __forceinline__ float bf_hi(unsigned w) { return __builtin_bit_cast(float, w & 0xffff0000u); }
__device__ __forceinline__ s16x4 vtr(const LAS unsigned char* p) { return __builtin_bit_cast(s16x4, __builtin_amdgcn_ds_read_tr16_b64_v4i16((LAS v4i16_t*)p)); }
__device__ __forceinline__ int opaque(int v) { asm volatile("" : "+s"(v)); return v; }
__device__ __forceinline__ float wave_sum(float v) {
#pragma unroll
    for (int o = 1; o < 64; o <<= 1) v += __shfl_xor(v, o);
    return v;
}

#define XB_TMO      128
#define XB_XCNT(j)  (256  + 64 * (j))
#define XB_XSUB(j)  (1280 + 64 * (j))
#define XB_XGEN(j)  (2304 + 64 * (j))
#define XB_TOP      3328
#define XB_TOPGEN   3392
#define XCD_BAR_WORDS 3456
#define XB_SPIN_CAP (1u << 18)

__device__ __forceinline__ unsigned xb_ld(unsigned* p)              { return __hip_atomic_load(p, __ATOMIC_RELAXED, __HIP_MEMORY_SCOPE_AGENT); }
__device__ __forceinline__ unsigned xb_add(unsigned* p, unsigned v) { return __hip_atomic_fetch_add(p, v, __ATOMIC_RELAXED, __HIP_MEMORY_SCOPE_AGENT); }
__device__ __forceinline__ unsigned xb_xcc_id() { return (unsigned)__builtin_amdgcn_s_getreg((3 << 11) | 20) & 0xFu; }
#define XB_SPIN(cond, bar) do { unsigned _sp = 0; while (cond) { __builtin_amdgcn_s_sleep(1); \
    if ((++_sp & 255u) == 0u) { if (xb_ld(&(bar)[XB_TMO])) break; if (_sp > XB_SPIN_CAP) { atomicAdd(&(bar)[XB_TMO], 1u); break; } } } } while (0)

struct XcdBarrier {
    unsigned* bar; unsigned x;
    volatile LAS unsigned* st;
};

__device__ __forceinline__ XcdBarrier xcd_barrier_post(unsigned* bar, volatile LAS unsigned* st) {
    XcdBarrier b; b.bar = bar; b.x = xb_xcc_id(); b.st = st;
    if (threadIdx.x == 0) (void)xb_add(&bar[XB_XCNT(b.x)], 1u);
    return b;
}
__device__ __forceinline__ void xcd_barrier_complete(unsigned* bar, unsigned x, unsigned& nloc, unsigned& nx) {
    const unsigned G = gridDim.x * gridDim.y * gridDim.z;
    unsigned sum, cnt, mine, sp = 0u;
    for (;;) {
        sum = 0u; cnt = 0u; mine = 0u;
#pragma unroll
        for (unsigned j = 0; j < 16; ++j) { const unsigned c = xb_ld(&bar[XB_XCNT(j)]); sum += c; cnt += (c > 0u) ? 1u : 0u; mine = (j == x) ? c : mine; }
        if (sum == G) break;
        __builtin_amdgcn_s_sleep(1);
        if ((++sp & 255u) == 0u) { if (xb_ld(&bar[XB_TMO])) break; if (sp > XB_SPIN_CAP) { atomicAdd(&bar[XB_TMO], 1u); break; } }
    }
    nloc = mine > 0u ? mine : 1u; nx = cnt > 0u ? cnt : 1u;
}

__device__ __forceinline__ void xcd_barrier(const XcdBarrier& b) {
    asm volatile("s_waitcnt vmcnt(0)" ::: "memory");
    __syncthreads();
    if (threadIdx.x == 0) {
        unsigned* bar = b.bar;
        __builtin_amdgcn_s_waitcnt(0);
        unsigned nloc = b.st[0], nx = b.st[1];
        if (nloc == 0u) { xcd_barrier_complete(bar, b.x, nloc, nx); b.st[0] = nloc; b.st[1] = nx; }
        const unsigned old = xb_add(&bar[XB_XSUB(b.x)], 1u);
        const unsigned gen = old / nloc;
        if (old + 1u == (gen + 1u) * nloc) {
            __builtin_amdgcn_fence(__ATOMIC_RELEASE, "agent");
            asm volatile("s_waitcnt vmcnt(0)" ::: "memory");
            const unsigned og = xb_add(&bar[XB_TOP], 1u);
            const unsigned tg = og / nx;
            if (og + 1u == (tg + 1u) * nx) xb_add(&bar[XB_TOPGEN], 1u);
            else XB_SPIN(xb_ld(&bar[XB_TOPGEN]) == tg, bar);
            __builtin_amdgcn_fence(__ATOMIC_ACQUIRE, "agent");
            xb_add(&bar[XB_XGEN(b.x)], 1u);
            asm volatile("s_waitcnt vmcnt(0)" ::: "memory");
        } else {
            XB_SPIN(xb_ld(&bar[XB_XGEN(b.x)]) == gen, bar);
            __builtin_amdgcn_fence(__ATOMIC_ACQUIRE, "agent");
            asm volatile("s_waitcnt vmcnt(0)" ::: "memory");
        }
    }
    __syncthreads();
}

struct Args {
    const float *x_prompt, *x_sample, *norm_ffn1, *w1_gate, *w1_up, *w1_down, *norm_mix, *w_in, *sink, *vgain, *w_sp, *b_sp, *w_out, *norm_ffn2, *w2_gate, *w2_up, *w2_down, *norm_final;
    float* out; unsigned char* ws;
};

typedef const __attribute__((address_space(4))) Args* KArgs;
__device__ __forceinline__ KArgs kargs() { const __attribute__((address_space(4))) void* p = (const __attribute__((address_space(4))) void*)__builtin_amdgcn_kernarg_segment_ptr(); asm volatile("" : "+s"(p)); return (KArgs)p; }
__device__ __forceinline__ void conv_item(const float* W, int ldn, int K, const float* gain, bf16* WT, int dst_row0, int src_col0, int k0, LAS float* scr, int lane) {
    f32x4 v[8]; float g[8];
#pragma unroll
    for (int i = 0; i < 8; ++i) { const int kk = 8 * i + (lane >> 3); v[i] = *(const f32x4*)(W + (size_t)(k0 + kk) * ldn + src_col0 + 4 * (lane & 7)); g[i] = gain ? gain[k0 + kk] : 1.0f; }
#pragma unroll
    for (int i = 0; i < 8; ++i) { const int kk = 8 * i + (lane >> 3); LAS float* s = scr + kk * 33 + 4 * (lane & 7); s[0] = v[i][0] * g[i]; s[1] = v[i][1] * g[i]; s[2] = v[i][2] * g[i]; s[3] = v[i][3] * g[i]; }
    LDS_WAIT(); asm volatile("" ::: "memory");
    const int c = lane & 7;
#pragma unroll
    for (int j = 0; j < 4; ++j) { const int n = (lane >> 3) + 8 * j; const LAS float* s = scr + (8 * c) * 33 + n;
        v4u o; o.x = pk2(s[0 * 33], s[1 * 33]); o.y = pk2(s[2 * 33], s[3 * 33]); o.z = pk2(s[4 * 33], s[5 * 33]); o.w = pk2(s[6 * 33], s[7 * 33]);
        *(v4u*)(WT + (size_t)(dst_row0 + n) * K + k0 + 8 * c) = o; }
    LDS_WAIT(); asm volatile("" ::: "memory");
}
__device__ __forceinline__ void convert_layer(KArgs a, int l, LAS unsigned char* lds, int gw, int NGW, int wave, int lane) {
    LAS float* scr = (LAS float*)(lds + wave * 16384);
    bf16* Wb = l == 0 ? (bf16*)(a->ws + WS_W) : (bf16*)a->out;
    constexpr int I_GU = (2 * FF / 32) * (DM / 64), I_D = (DM / 32) * (FF / 64), I_IN = (NIN / 32) * (DM / 64), I_OUT = (DM / 32) * (DM / 64);
    constexpr int NITEMS = 2 * I_GU + 2 * I_D + I_IN + I_OUT;
    for (int it = gw; it < NITEMS; it += NGW) {
        int r = it; const float* src; const float* gain = nullptr; int ldn, K, nblk; size_t dsto; int kind;
        const float *gsrc = nullptr, *usrc = nullptr;
        if (r < I_GU) { kind = 1; gsrc = a->w1_gate + (size_t)l * DM * FF; usrc = a->w1_up + (size_t)l * DM * FF; gain = a->norm_ffn1 + l * DM; ldn = FF; K = DM; nblk = 2 * FF / 32; dsto = W_GU1; }
        else if ((r -= I_GU) < I_D) { kind = 0; gsrc = a->w1_down + (size_t)l * DM * FF; ldn = DM; K = FF; nblk = DM / 32; dsto = W_D1; }
        else if ((r -= I_D) < I_IN) { kind = 2; gsrc = a->w_in + (size_t)l * DM * NIN; gain = a->norm_mix + l * DM; ldn = NIN; K = DM; nblk = NIN / 32; dsto = W_IN; }
        else if ((r -= I_IN) < I_OUT) { kind = 0; gsrc = a->w_out + (size_t)l * DM * DM; ldn = DM; K = DM; nblk = DM / 32; dsto = W_OUT; }
        else if ((r -= I_OUT) < I_GU) { kind = 1; gsrc = a->w2_gate + (size_t)l * DM * FF; usrc = a->w2_up + (size_t)l * DM * FF; gain = a->norm_ffn2 + l * DM; ldn = FF; K = DM; nblk = 2 * FF / 32; dsto = W_GU2; }
        else { r -= I_GU; kind = 0; gsrc = a->w2_down + (size_t)l * DM * FF; ldn = DM; K = FF; nblk = DM / 32; dsto = W_D2; }
        const int kb = r / nblk, nb = r % nblk; int sc0 = 32 * nb; src = gsrc;
        if (kind == 1) { const int pn = nb >> 3, lb = nb & 7; src = lb < 4 ? gsrc : usrc; sc0 = 128 * pn + 32 * (lb & 3); }
        else if (kind == 2 && nb >= 40) { const int t = nb - 40, pnl = t >> 3, lb = t & 7, bj = lb >> 2, wc = lb & 3; sc0 = 1280 + 64 * (4 * pnl + wc) + 32 * bj; }
        conv_item(src, ldn, K, gain, (bf16*)((unsigned char*)Wb + dsto), 32 * nb, sc0, 64 * kb, scr, lane);
    }
}

constexpr int KS_STRIDE = 144;
constexpr int KS_BYTES = 384 * KS_STRIDE;
constexpr int TAB_OFF = 2 * KS_BYTES, TAB_N = 388, TAB_ZERO = 196;
static_assert(TAB_OFF + 4 * 4 * TAB_N * 4 <= LDSCTL_OFF, "LDS map");
constexpr int GS_STRIDE = 1040;
static_assert(128 * GS_STRIDE <= LDSCTL_OFF, "LDS map");
__device__ __forceinline__ void mixer_phase(KArgs a, int l, LAS unsigned char* lds, int G, int bid, int tid, int wave, int lane) {
    const bf16* Z = (const bf16*)(a->ws + WS_Z); bf16* MIX = (bf16*)(a->ws + WS_MIX);
    const int fr = lane & 15, fq = lane >> 4, tq = fr >> 2, tp = fr & 3;
    LAS unsigned char* Ks = lds; LAS unsigned char* Vs = lds + KS_BYTES; LAS unsigned char* Gs = lds;
#pragma unroll 1
    for (int blk = bid; blk < NBLK; blk += G) {
        const int sb = blk < 128 ? (blk & ~63) : (blk & ~15), se = sb + (blk < 128 ? 64 : 16);
        const bool has_prev = blk > sb, has_next = blk + 1 < se;
#ifndef MIX_NO_ATT
#ifndef REP_ATT
#define REP_ATT 1
#endif
#pragma unroll 1
        for (int kvh2 = 0; kvh2 < 2 * REP_ATT; ++kvh2) { const int kvh = kvh2 & 1;
            __syncthreads();
#pragma unroll
            for (int i = 0; i < 6; ++i) {
                const int id = tid + 512 * i, kj = id >> 3, c = id & 7, kb = kj >> 7;
                const bool ok = kb == 1 || (kb == 0 ? has_prev : has_next);
                v4u kv = (v4u){0u, 0u, 0u, 0u}, vv = (v4u){0u, 0u, 0u, 0u};
                if (ok) { const bf16* zr = Z + (size_t)(128 * (blk - 1) + kj) * NIN + 64 * kvh + 8 * c; kv = *(const v4u*)(zr + 512); vv = *(const v4u*)(zr + 640); }
                *(LAS v4u*)(Ks + kj * KS_STRIDE + c * 16) = kv; *(LAS v4u*)(Vs + kj * KS_STRIDE + c * 16) = vv;
            }
            for (int e = tid; e < 4 * 4 * TAB_N; e += 512) {
                const int hd = e / (4 * TAB_N), k = (e / TAB_N) & 3, i = e % TAB_N, rel = i + k - TAB_ZERO, ad = rel < 0 ? -rel : rel;
                const float sl = __builtin_amdgcn_exp2f(-(float)(kvh * 4 + hd + 1)) * pg8::K_LOG2E;
                ((LAS float*)(lds + TAB_OFF))[e] = ad <= 128 ? -sl * (float)ad : -INFINITY;
            }
            __syncthreads();
            {
                const int hq = kvh * 4 + (wave >> 1), half = wave & 1;
                const float sinkl = a->sink[l * 8 + hq] * pg8::K_LOG2E;
                bf16x8 qf[4][2];
#pragma unroll
                for (int qg = 0; qg < 4; ++qg)
#pragma unroll
                    for (int dk = 0; dk < 2; ++dk) qf[qg][dk] = *(const bf16x8*)(Z + (size_t)(128 * blk + 64 * half + 16 * qg + fr) * NIN + hq * 64 + 32 * dk + 8 * fq);
                f32x4 o[4][4];
#pragma unroll
                for (int db = 0; db < 4; ++db)
#pragma unroll
                    for (int qg = 0; qg < 4; ++qg) o[db][qg] = (f32x4){0.f, 0.f, 0.f, 0.f};
                float mrow[4], lsum[4];
#pragma unroll
                for (int qg = 0; qg < 4; ++qg) { mrow[qg] = sinkl; lsum[qg] = 0.f; }
                const int dl0 = 4 * fq - fr, kcp = dl0 & 3;
                const LAS unsigned char* tbl = lds + TAB_OFF + ((wave >> 1) * 4 + kcp) * (TAB_N * 4) + 4 * (dl0 - kcp + TAB_ZERO - 128 - 48);
#pragma unroll 2
                for (int kt = 0; kt < 10; ++kt) {
                    const int key0 = 64 * half + 32 * kt, tb = key0 >> 7;
                    if ((tb == 0 && !has_prev) || (tb == 2 && !has_next)) continue;
                    f32x4 s[2][4];
#pragma unroll
                    for (int kb = 0; kb < 2; ++kb)
#pragma unroll
                        for (int qg = 0; qg < 4; ++qg) s[kb][qg] = (f32x4){0.f, 0.f, 0.f, 0.f};
#pragma unroll
                    for (int kb = 0; kb < 2; ++kb)
#pragma unroll
                        for (int dk = 0; dk < 2; ++dk) {
                            const bf16x8 kf = *(const LAS bf16x8*)(Ks + (key0 + 16 * kb + fr) * KS_STRIDE + 64 * dk + 16 * fq);
#pragma unroll
                            for (int qg = 0; qg < 4; ++qg) s[kb][qg] = __builtin_amdgcn_mfma_f32_16x16x32_bf16(kf, qf[qg][dk], s[kb][qg], 0, 0, 0);
                        }
                    bf16x8 pb[4];
                    const LAS unsigned char* tbp = tbl + 128 * kt;
#pragma unroll
                    for (int qg = 0; qg < 4; ++qg) {
                        float mx = mrow[qg];
#pragma unroll
                        for (int kb = 0; kb < 2; ++kb) {
                            const f32x4 bv = *(const LAS f32x4*)(tbp + 64 * (kb - qg + 3));
                            s[kb][qg] = s[kb][qg] + bv;
                            mx = fmaxf(mx, fmaxf(fmaxf(s[kb][qg][0], s[kb][qg][1]), fmaxf(s[kb][qg][2], s[kb][qg][3])));
                        }
                        mx = fmaxf(mx, __shfl_xor(mx, 16)); mx = fmaxf(mx, __shfl_xor(mx, 32));
                        const float mold = mrow[qg];
                        float ps = 0.f;
#pragma unroll
                        for (int kb = 0; kb < 2; ++kb)
#pragma unroll
                            for (int j = 0; j < 4; ++j) { const float p = __builtin_amdgcn_exp2f(s[kb][qg][j] - mx); s[kb][qg][j] = p; ps += p; }
                        {
                            const float alpha = __builtin_amdgcn_exp2f(mold - mx); mrow[qg] = mx;
                            lsum[qg] = lsum[qg] * alpha;
#pragma unroll
                            for (int db = 0; db < 4; ++db) o[db][qg] = o[db][qg] * alpha;
                        }
                        lsum[qg] += ps;
                        v4u w; w.x = pk2(s[0][qg][0], s[0][qg][1]); w.y = pk2(s[0][qg][2], s[0][qg][3]); w.z = pk2(s[1][qg][0], s[1][qg][1]); w.w = pk2(s[1][qg][2], s[1][qg][3]);
                        pb[qg] = __builtin_bit_cast(bf16x8, w);
                    }
#pragma unroll
                    for (int db = 0; db < 4; ++db) {
                        const LAS unsigned char* vp = Vs + (key0 + 4 * fq + tq) * KS_STRIDE + (16 * db + 4 * tp) * 2;
                        const s16x4 lo = vtr(vp), hi = vtr(vp + 16 * KS_STRIDE);
                        const bf16x8 vf = (bf16x8){lo[0], lo[1], lo[2], lo[3], hi[0], hi[1], hi[2], hi[3]};
#pragma unroll
                        for (int qg = 0; qg < 4; ++qg) o[db][qg] = __builtin_amdgcn_mfma_f32_16x16x32_bf16(vf, pb[qg], o[db][qg], 0, 0, 0);
                    }
                }
#pragma unroll
                for (int qg = 0; qg < 4; ++qg) {
                    float lt = lsum[qg]; lt += __shfl_xor(lt, 16); lt += __shfl_xor(lt, 32); lt += __builtin_amdgcn_exp2f(sinkl - mrow[qg]);
                    const float inv = 1.0f / lt;
                    bf16* op = MIX + (size_t)(128 * blk + 64 * half + 16 * qg + fr) * DM + hq * 64 + 4 * fq;
#pragma unroll
                    for (int db = 0; db < 4; ++db) { const f32x4 v = o[db][qg] * inv; v2u w; w.x = pk2(v[0], v[1]); w.y = pk2(v[2], v[3]); *(v2u*)(op + 16 * db) = w; }
                }
            }
        }
#endif
        {
            const int tidg = pg8::opaque_v(tid);
            const int h = wave;
            const v4u* wsb = (const v4u*)(a->ws + WS_WSB) + ((size_t)(l * 8 + h) * 32) * 64 + lane;
            v4u gl[16];
#pragma unroll
            for (int i = 0; i < 16; ++i) { const int id = tidg + 512 * i, srow = id >> 6, c = id & 63; gl[i] = *(const v4u*)(Z + (size_t)(128 * blk + srow) * NIN + 1280 + 8 * c); }
            __syncthreads();
#pragma unroll
            for (int i = 0; i < 16; ++i) { const int id = tidg + 512 * i, srow = id >> 6, c = id & 63; *(LAS v4u*)(Gs + srow * GS_STRIDE + c * 16) = gl[i]; }
#pragma unroll 1
            for (int th = 0; th < 2; ++th) {
                const int tbase = 64 * th;
                v4u wf[4][4]; v2u uu[4][4]; float bias[4];
#pragma unroll
                for (int tb = 0; tb < 4; ++tb) { const size_t row = (size_t)128 * blk + tbase + 16 * tb + fr; bias[tb] = a->b_sp[(l * 8 + h) * 128 + tbase + 16 * tb + fr];
#pragma unroll
                    for (int c = 0; c < 4; ++c) wf[tb][c] = wsb[((4 * th + tb) * 4 + c) * 64];
#pragma unroll
                    for (int db = 0; db < 4; ++db) uu[tb][db] = *(const v2u*)(Z + row * NIN + 768 + 64 * h + 16 * db + 4 * fq); }
                if (th == 0) __syncthreads();
                f32x4 d[4][4];
#pragma unroll
                for (int tb = 0; tb < 4; ++tb)
#pragma unroll
                    for (int db = 0; db < 4; ++db) d[tb][db] = (f32x4){0.f, 0.f, 0.f, 0.f};
#pragma unroll
                for (int c = 0; c < 4; ++c)
#pragma unroll
                    for (int db = 0; db < 4; ++db) {
                        const LAS unsigned char* gp = Gs + (32 * c + 8 * fq + tq) * GS_STRIDE + (64 * h + 16 * db + 4 * tp) * 2;
                        const s16x4 lo = vtr(gp), hi = vtr(gp + 4 * GS_STRIDE);
                        const bf16x8 af = (bf16x8){lo[0], lo[1], lo[2], lo[3], hi[0], hi[1], hi[2], hi[3]};
#pragma unroll
                        for (int tb = 0; tb < 4; ++tb) d[tb][db] = __builtin_amdgcn_mfma_f32_16x16x32_bf16(af, __builtin_bit_cast(bf16x8, wf[tb][c]), d[tb][db], 0, 0, 0);
                    }
#pragma unroll
                for (int tb = 0; tb < 4; ++tb) { const size_t row = (size_t)128 * blk + tbase + 16 * tb + fr;
#pragma unroll
                    for (int db = 0; db < 4; ++db) {
                        const int d0 = 64 * h + 16 * db + 4 * fq; const v2u u2 = uu[tb][db]; const f32x4 dv = d[tb][db]; const float bs = bias[tb];
                        v2u w; w.x = pk2(bf_lo(u2.x) * (dv[0] + bs), bf_hi(u2.x) * (dv[1] + bs)); w.y = pk2(bf_lo(u2.y) * (dv[2] + bs), bf_hi(u2.y) * (dv[3] + bs));
                        *(v2u*)(MIX + row * DM + 512 + d0) = w;
                    } }
            }
        }
    }
    __syncthreads();
}

#define GRID_SYNC1() do { XcdBarrier b_ = bar; b_.x = (unsigned)opaque((int)bar.x); xcd_barrier(b_); } while (0)
#ifdef DUP_SYNC
#define GRID_SYNC() do { GRID_SYNC1(); GRID_SYNC1(); } while (0)
#else
#define GRID_SYNC() GRID_SYNC1()
#endif
__global__ void __launch_bounds__(NWAVES * 64, 2) fwd_megakernel(Args a) {
    extern __shared__ __attribute__((aligned(16))) unsigned char lds_raw[];
    LAS unsigned char* lds = (LAS unsigned char*)lds_raw;
    cg::grid_group grid = cg::this_grid();
    const int tid = threadIdx.x, lane = tid & 63, wave = __builtin_amdgcn_readfirstlane(tid >> 6);
    const int G = gridDim.x, bid = blockIdx.x;
    const int vcu = (G % 8 == 0) ? (bid % 8) * (G / 8) + bid / 8 : bid;
    const int gw = vcu * NWAVES + wave, NGW = G * NWAVES;
    if (tid < 64) ((LAS unsigned*)(lds + LDSCTL_OFF))[tid] = 0u;
    __syncthreads();
    const XcdBarrier bar = xcd_barrier_post((unsigned*)(kargs()->ws + WS_BAR), (volatile LAS unsigned*)(lds + LDSCTL_OFF));
    grid.sync();
#define KA (kargs())
#define X (KA->out)
#define SS ((pg8::ss_t*)(KA->ws + WS_SS))
#define XB ((bf16*)(KA->ws + WS_XB))
#define Wb (l == 0 ? (bf16*)(KA->ws + WS_W) : (bf16*)KA->out)
#define Hb ((bf16*)(KA->ws + WS_H))
#define Zb ((bf16*)(KA->ws + WS_Z))
#define MIXb ((bf16*)(KA->ws + WS_MIX))

    { bf16* xb_ = XB; pg8::ss_t* ss_ = SS; const float* xp_ = KA->x_prompt; const float* xs_ = KA->x_sample;
    for (int r0 = gw; r0 < TOK; r0 += 4 * NGW) {
        f32x4 v[4][4];
#pragma unroll
        for (int q = 0; q < 4; ++q) { const int r = r0 + q * NGW; const float* src = r < TOKP ? xp_ + (size_t)r * DM : xs_ + (size_t)(r - TOKP) * DM;
#pragma unroll
            for (int j = 0; j < 4; ++j) v[q][j] = *(const f32x4*)(src + 256 * j + 4 * lane); }
#pragma unroll
        for (int q = 0; q < 4; ++q) { const int r = r0 + q * NGW; float s = 0.f;
#pragma unroll
            for (int j = 0; j < 4; ++j) { const f32x4 x = v[q][j]; v2u w; w.x = pk2(x[0], x[1]); w.y = pk2(x[2], x[3]); *(v2u*)(xb_ + (size_t)r * DM + 256 * j + 4 * lane) = w;
                s += (x[0] * x[0] + x[1] * x[1]) + (x[2] * x[2] + x[3] * x[3]); }
            s = wave_sum(s);
            if (lane == 0) ss_[r] = pg8::ss_fix(s); }
    }
    for (int i = bid * 512 + tid; i < 6 * TOK; i += G * 512) ss_[TOK + i] = 0ull; }
    {
        const float* wsp_ = KA->w_sp; v4u* wsb_ = (v4u*)(KA->ws + WS_WSB);
        for (int e = bid * 512 + tid; e < NLAYER * 8 * 32 * 64; e += G * 512) {
            const int ln = e & 63, f = e >> 6, c = f & 3, tb = (f >> 2) & 7, lh = f >> 5;
            const float* wp = wsp_ + ((size_t)lh * 128 + 16 * tb + (ln & 15)) * 128 + 32 * c + 8 * (ln >> 4);
            const f32x4 w0 = *(const f32x4*)wp, w1 = *(const f32x4*)(wp + 4);
            v4u o; o.x = pk2(w0[0], w0[1]); o.y = pk2(w0[2], w0[3]); o.z = pk2(w1[0], w1[1]); o.w = pk2(w1[2], w1[3]);
            wsb_[e] = o;
        }
    }
    convert_layer(kargs(), 0, lds, gw, NGW, wave, lane);
    convert_layer(kargs(), 1, lds, gw, NGW, wave, lane);
    GRID_SYNC();

    for (int l = 0; l < NLAYER; ++l) {
        #define ssA (SS + (size_t)(3 * l) * TOK)
#define ssB (SS + (size_t)(3 * l + 1) * TOK)
#define ssC (SS + (size_t)(3 * l + 2) * TOK)
#define ssD (SS + (size_t)(3 * l + 3) * TOK)
        if (PH_MASK & 1) { pg8::Gemm g{XB, (const bf16*)((unsigned char*)Wb + W_GU1), TOK, 2 * FF, DM}; pg8::StaticOrder S; S.init(TOK, 2 * FF, G, opaque(bid));
          pg8::EpiSwiglu E{Hb, FF, ssA};
#ifdef DUP_PA
          pg8::gemm_phase<pg8::EpiSwiglu, pg8::StaticOrder, true, true>(lds, g, S, E); __syncthreads();
#endif
          pg8::gemm_phase<pg8::EpiSwiglu, pg8::StaticOrder, true, true>(lds, g, S, E); }
        GRID_SYNC();
        if (PH_MASK & 2) { pg8::Gemm g{Hb, (const bf16*)((unsigned char*)Wb + W_D1), TOK, DM, FF}; pg8::StaticOrder S; S.init(TOK, DM, G, opaque(bid));
          pg8::EpiResid E{XB, ssB, 0.5f};
#ifdef DUP_PB
          { pg8::EpiResid E0{XB, nullptr, 0.0f}; pg8::gemm_phase<pg8::EpiResid, pg8::StaticOrder, true, true>(lds, g, S, E0); __syncthreads(); }
#endif
          pg8::gemm_phase<pg8::EpiResid, pg8::StaticOrder, true, true>(lds, g, S, E); }
        GRID_SYNC();
        if (PH_MASK & 4) { pg8::Gemm g{XB, (const bf16*)((unsigned char*)Wb + W_IN), TOK, NIN, DM}; pg8::StaticOrder S; S.init(TOK, NIN, G, opaque(bid));
          pg8::EpiInProj E{Zb, ssB, KA->vgain + l * 512};
          pg8::gemm_phase<pg8::EpiInProj, pg8::StaticOrder, true, true>(lds, g, S, E); }
        GRID_SYNC();
#ifdef MIXER_COPY
        if (PH_MASK & 8) { for (size_t i = (size_t)bid * 512 + threadIdx.x; i < (size_t)TOK * 128; i += (size_t)G * 512) { const size_t r = i >> 7, c = i & 127; *(v4u*)(MIXb + r * DM + 8 * c) = *(const v4u*)(Zb + r * NIN + 8 * c); } }
#else
        if (PH_MASK & 8) { const int t_ = pg8::opaque_v((int)threadIdx.x); mixer_phase(kargs(), l, lds, G, opaque(vcu), t_, __builtin_amdgcn_readfirstlane(t_ >> 6), t_ & 63); }
#ifdef DUP_PD
        { const int t_ = pg8::opaque_v((int)threadIdx.x); mixer_phase(kargs(), l, lds, G, opaque(vcu), t_, __builtin_amdgcn_readfirstlane(t_ >> 6), t_ & 63); }
#endif
#endif
        GRID_SYNC();
        if (PH_MASK & 16) { pg8::Gemm g{MIXb, (const bf16*)((unsigned char*)Wb + W_OUT), TOK, DM, DM}; pg8::StaticOrder S; S.init(TOK, DM, G, opaque(bid));
          pg8::EpiResid E{XB, ssC, 1.0f};
#ifdef DUP_PB
          { pg8::EpiResid E0{XB, nullptr, 0.0f}; pg8::gemm_phase<pg8::EpiResid, pg8::StaticOrder, true, true>(lds, g, S, E0); __syncthreads(); }
#endif
          pg8::gemm_phase<pg8::EpiResid, pg8::StaticOrder, true, true>(lds, g, S, E); }
        GRID_SYNC();
        if (PH_MASK & 32) { pg8::Gemm g{XB, (const bf16*)((unsigned char*)Wb + W_GU2), TOK, 2 * FF, DM}; pg8::StaticOrder S; S.init(TOK, 2 * FF, G, opaque(bid));
          pg8::EpiSwiglu E{Hb, FF, ssC};
#ifdef DUP_PA
          pg8::gemm_phase<pg8::EpiSwiglu, pg8::StaticOrder, true, true>(lds, g, S, E); __syncthreads();
#endif
          pg8::gemm_phase<pg8::EpiSwiglu, pg8::StaticOrder, true, true>(lds, g, S, E); }
        GRID_SYNC();
        if (PH_MASK & 64) { pg8::Gemm g{Hb, (const bf16*)((unsigned char*)Wb + W_D2), TOK, DM, FF}; pg8::StaticOrder S; S.init(TOK, DM, G, opaque(bid));
          pg8::EpiResid E{XB, ssD, 0.5f};
#ifdef DUP_PB
          { pg8::EpiResid E0{XB, nullptr, 0.0f}; pg8::gemm_phase<pg8::EpiResid, pg8::StaticOrder, true, true>(lds, g, S, E0); __syncthreads(); }
#endif
          pg8::gemm_phase<pg8::EpiResid, pg8::StaticOrder, true, true>(lds, g, S, E); }
        GRID_SYNC();
    }
    {
        const int t_ = pg8::opaque_v((int)threadIdx.x), lane = t_ & 63, gw = opaque(vcu) * NWAVES + __builtin_amdgcn_readfirstlane(t_ >> 6);
        const pg8::ss_t* ssF = SS + (size_t)6 * TOK; const bf16* xb_ = XB; float* out_ = X;
        f32x4 gn[4];
#pragma unroll
        for (int j = 0; j < 4; ++j) gn[j] = *(const f32x4*)(KA->norm_final + 256 * j + 4 * lane);
        for (int r0 = gw; r0 < TOK; r0 += 4 * NGW) {
            v2u w[4][4]; pg8::ss_t sv[4];
#pragma unroll
            for (int q = 0; q < 4; ++q) { const int r = r0 + q * NGW; sv[q] = ssF[r];
#pragma unroll
                for (int j = 0; j < 4; ++j) w[q][j] = *(const v2u*)(xb_ + (size_t)r * DM + 256 * j + 4 * lane); }
#pragma unroll
            for (int q = 0; q < 4; ++q) { const int r = r0 + q * NGW; const float rs = pg8::rs_of(sv[q]);
#pragma unroll
                for (int j = 0; j < 4; ++j) { const f32x4 v = (f32x4){bf_lo(w[q][j].x), bf_hi(w[q][j].x), bf_lo(w[q][j].y), bf_hi(w[q][j].y)}; *(f32x4*)(out_ + (size_t)r * DM + 256 * j + 4 * lane) = v * rs * gn[j]; } }
        }
    }
}
#undef KA
#undef X
#undef SS
#undef XB
#undef Wb
#undef Hb
#undef Zb
#undef MIXb
#undef ssA
#undef ssB
#undef ssC
#undef ssD

extern "C" void kernel_launch(void* const* d_in, const int* in_sizes, int n_in, void* d_out, int out_size, void* d_ws, size_t ws_size, hipStream_t stream) {
    static int grid = 0;
    if (grid == 0) {
        if (n_in != 18 || out_size != TOK * DM || ws_size < WS_END) { fprintf(stderr, "kernel_launch: unexpected shapes (n_in %d out %d ws %zu, need %zu)\n", n_in, out_size, ws_size, (size_t)WS_END); grid = -1; return; }
        int dev = 0, cus = 0, per_cu = 0;
        if (hipGetDevice(&dev) != hipSuccess || hipDeviceGetAttribute(&cus, hipDeviceAttributeMultiprocessorCount, dev) != hipSuccess) { grid = -1; return; }
        if (hipFuncSetAttribute((const void*)fwd_megakernel, hipFuncAttributeMaxDynamicSharedMemorySize, LDS_BYTES) != hipSuccess) { fprintf(stderr, "kernel_launch: hipFuncSetAttribute failed\n"); grid = -1; return; }
        if (hipOccupancyMaxActiveBlocksPerMultiprocessor(&per_cu, (const void*)fwd_megakernel, NWAVES * 64, LDS_BYTES) != hipSuccess || per_cu < 1) { fprintf(stderr, "kernel_launch: occupancy query says %d\n", per_cu); per_cu = 1; }
        (void)hipGetLastError();
        grid = cus;
    }
    if (grid < 0) return;
    if (hipMemsetAsync((char*)d_ws + WS_BAR, 0, WS_BAR_BYTES, stream) != hipSuccess) { fprintf(stderr, "kernel_launch: memset failed\n"); return; }
    Args a{};
    const float** f = (const float**)&a;
    for (int i = 0; i < 18; ++i) f[i] = (const float*)d_in[i];
    a.out = (float*)d_out; a.ws = (unsigned char*)d_ws;
    void* args[] = {&a};
    hipError_t e = hipLaunchCooperativeKernel((const void*)fwd_megakernel, dim3(grid), dim3(NWAVES * 64), args, LDS_BYTES, stream);
    if (e != hipSuccess) fprintf(stderr, "kernel_launch: cooperative launch failed: %s (grid %d)\n", hipGetErrorString(e), grid);
}
```

```cpp
#include <hip/hip_runtime.h>
#include <hip/hip_cooperative_groups.h>
#include <cstdio>
#include <cstdint>
#include <cmath>
namespace cg = cooperative_groups;
namespace pg8 {
#define PG8_LAS __attribute__((address_space(3)))
typedef unsigned short bf16_t;
typedef short bf16x8 __attribute__((ext_vector_type(8)));
typedef float f32x4 __attribute__((ext_vector_type(4)));
typedef unsigned u32x4 __attribute__((ext_vector_type(4)));
constexpr int BM = 256, BK = 64, HALF = 128, HTB = HALF * BK * 2  , STAGE_BYTES = 8 * HTB, NXCD = 8, WGM = 8;

__host__ __device__ __forceinline__ int lds_byte(int r, int c) { const int st = (r >> 4) * 2 + (c >> 5), rr = r & 15, cc = c & 31, ob = rr * 64 + cc * 2; return st * 1024 + (ob ^ (((ob >> 9) & 1) << 5)); }
__host__ __device__ __forceinline__ void stage_rc(int b, int& R, int& C) { const int st = b / 1024, sb = b % 1024, swz = sb ^ (((sb >> 9) & 1) << 5); R = (st >> 1) * 16 + swz / 64; C = (st & 1) * 32 + (swz % 64) / 2; }
__host__ __device__ __forceinline__ int perm32(int rho) { const int n = rho >> 4, i = rho & 15; return 8 * (i >> 2) + 4 * n + (i & 3); }

struct Unit { int pm, pn; };
struct Gemm { const bf16_t* A; const bf16_t* Bt; int M, N, K; };

struct StaticOrder {
    int nM, nN, nwg, G, c;
    __host__ __device__ void init(int M, int N, int G_, int c_) { nM = M / BM; nN = N / BM; nwg = nM * nN; G = G_; c = c_; }
    __host__ __device__ bool next(int i, Unit& u) const {
        const long L = (long)i * G + c; if (L >= nwg) return false;
        int wgid = (int)L; { const int q = nwg / NXCD, r = nwg % NXCD, xcd = wgid % NXCD, off = wgid / NXCD; wgid = (xcd < r ? xcd * (q + 1) : r * (q + 1) + (xcd - r) * q) + off; }
        const int nig = WGM * nN, gid = wgid / nig, fm = gid * WGM, gsz = (nM - fm) < WGM ? (nM - fm) : WGM;
        u.pm = fm + ((wgid % nig) % gsz); u.pn = (wgid % nig) / gsz; return true;
    }
    __device__ __forceinline__ void a_ready(const Unit&) const {}
    __device__ __forceinline__ void done(const Unit&) const {}
};

__device__ __forceinline__ unsigned cvt_pk_bf16(float lo, float hi) { unsigned r; asm volatile("v_cvt_pk_bf16_f32 %0, %1, %2" : "=v"(r) : "v"(lo), "v"(hi)); return r; }
typedef float f32x2 __attribute__((ext_vector_type(2)));
constexpr float RMS_EPS = 1e-6f;
__device__ __forceinline__ int opaque_v(int v) { asm volatile("" : "+v"(v)); return v; }
constexpr float K_LOG2E = 1.4426950408889634f;
__device__ __forceinline__ float fast_exp2(float x) { return __builtin_amdgcn_exp2f(x); }
__device__ __forceinline__ float fast_rcp(float x) { return __builtin_amdgcn_rcpf(x); }
__device__ __forceinline__ float silu_f(float g) { return g * fast_rcp(1.0f + fast_exp2(-K_LOG2E * g)); }
__device__ __forceinline__ float gelu_tanh_f(float v) { const float t = v * (1.0f + 0.044715f * v * v); return v * fast_rcp(1.0f + fast_exp2(-2.3022081978f * t)); }
typedef unsigned long long ss_t;
constexpr float SS_SCALE = 1048576.0f;
__device__ __forceinline__ ss_t ss_fix(float s) { return (ss_t)(s * SS_SCALE + 0.5f); }
__device__ __forceinline__ float rs_of(ss_t v) { return __builtin_amdgcn_rsqf((float)v * (1.0f / (1024.0f * SS_SCALE)) + RMS_EPS); }
__device__ __forceinline__ float row_rs(const ss_t* ss, int row) { return __builtin_amdgcn_rsqf((float)ss[row] * (1.0f / (1024.0f * SS_SCALE)) + RMS_EPS); }

__device__ __forceinline__ f32x2 swiglu_pk(f32x2 ag, f32x2 au, float rsn, float rs2) {
    const f32x2 t = ag * rsn; f32x2 e; e.x = fast_exp2(t.x); e.y = fast_exp2(t.y);
    const f32x2 den = e + 1.0f; f32x2 r; r.x = fast_rcp(den.x); r.y = fast_rcp(den.y);
    return ((ag * au) * rs2) * r;
}
struct EpiSwiglu {
    static constexpr bool PERM = true, AFTER_DRAIN = false;
    bf16_t* H; int ldh; const ss_t* ss;
    __device__ __forceinline__ void operator()(const f32x4 (&acc)[2][2][4][2], const Unit& u, int wr, int wc, int fr, int fq) const {
        const int row0 = u.pm * BM + wr * 64 + fr, col0 = u.pn * HALF + wc * 32 + 8 * fq;
        ss_t sv[2][4];
#pragma unroll
        for (int ai = 0; ai < 2; ++ai)
#pragma unroll
            for (int m = 0; m < 4; ++m) sv[ai][m] = ss[row0 + ai * HALF + m * 16];
#pragma unroll
        for (int ai = 0; ai < 2; ++ai)
#pragma unroll
            for (int m = 0; m < 4; ++m) {
                const int row = row0 + ai * HALF + m * 16; const float rs = rs_of(sv[ai][m]), rsn = -K_LOG2E * rs, rs2 = rs * rs;
                const f32x4 ag0 = acc[ai][0][m][0], ag1 = acc[ai][0][m][1], au0 = acc[ai][1][m][0], au1 = acc[ai][1][m][1];
                const f32x2 h0 = swiglu_pk((f32x2){ag0[0], ag0[1]}, (f32x2){au0[0], au0[1]}, rsn, rs2), h1 = swiglu_pk((f32x2){ag0[2], ag0[3]}, (f32x2){au0[2], au0[3]}, rsn, rs2);
                const f32x2 h2 = swiglu_pk((f32x2){ag1[0], ag1[1]}, (f32x2){au1[0], au1[1]}, rsn, rs2), h3 = swiglu_pk((f32x2){ag1[2], ag1[3]}, (f32x2){au1[2], au1[3]}, rsn, rs2);
                u32x4 w; w.x = cvt_pk_bf16(h0.x, h0.y); w.y = cvt_pk_bf16(h1.x, h1.y); w.z = cvt_pk_bf16(h2.x, h2.y); w.w = cvt_pk_bf16(h3.x, h3.y);
                *(u32x4*)(H + (size_t)row * ldh + col0) = w;
                asm volatile("" ::: "memory");
            }
    }
};
__device__ __forceinline__ float bfl(unsigned w) { return __builtin_bit_cast(float, w << 16); }
__device__ __forceinline__ float bfh(unsigned w) { return __builtin_bit_cast(float, w & 0xffff0000u); }
struct EpiResid {
    static constexpr bool PERM = true, AFTER_DRAIN = false;
    bf16_t* XB; ss_t* ssn; float scale;
    __device__ __forceinline__ void operator()(const f32x4 (&acc)[2][2][4][2], const Unit& u, int wr, int wc, int fr, int fq) const {
        const int row0 = u.pm * BM + wr * 64 + fr, col0 = u.pn * BM + wc * 32 + 8 * fq;
#pragma unroll
        for (int ai = 0; ai < 2; ++ai) {
            u32x4 xw[4][2];
#pragma unroll
            for (int m = 0; m < 4; ++m)
#pragma unroll
                for (int bj = 0; bj < 2; ++bj) xw[m][bj] = *(const u32x4*)(XB + (size_t)(row0 + ai * HALF + m * 16) * 1024 + col0 + bj * HALF);
#pragma unroll
            for (int m = 0; m < 4; ++m) {
                const int row = row0 + ai * HALF + m * 16; float s = 0.f;
#pragma unroll
                for (int bj = 0; bj < 2; ++bj) {
                    bf16_t* xp = XB + (size_t)row * 1024 + col0 + bj * HALF;
                    const u32x4 w0 = xw[m][bj];
                    f32x4 x0 = (f32x4){bfl(w0.x), bfh(w0.x), bfl(w0.y), bfh(w0.y)}, x1 = (f32x4){bfl(w0.z), bfh(w0.z), bfl(w0.w), bfh(w0.w)};
                    x0 = x0 + acc[ai][bj][m][0] * scale; x1 = x1 + acc[ai][bj][m][1] * scale;
                    s += (x0[0] * x0[0] + x0[1] * x0[1]) + (x0[2] * x0[2] + x0[3] * x0[3]) + (x1[0] * x1[0] + x1[1] * x1[1]) + (x1[2] * x1[2] + x1[3] * x1[3]);
                    u32x4 w; w.x = cvt_pk_bf16(x0[0], x0[1]); w.y = cvt_pk_bf16(x0[2], x0[3]); w.z = cvt_pk_bf16(x1[0], x1[1]); w.w = cvt_pk_bf16(x1[2], x1[3]);
                    *(u32x4*)xp = w;
                }
                s += __shfl_xor(s, 16); s += __shfl_xor(s, 32);
                if (fq == 0 && ssn) atomicAdd(ssn + row, ss_fix(s));
            }
            asm volatile("" ::: "memory");
        }
    }
};
struct EpiInProj {
    static constexpr bool PERM = true, AFTER_DRAIN = false;
    bf16_t* Z; const ss_t* ss; const float* vgain;
    __device__ __forceinline__ void operator()(const f32x4 (&acc)[2][2][4][2], const Unit& u, int wr, int wc, int fr, int fq) const {
        const int row0 = u.pm * BM + wr * 64 + fr, pn = u.pn;
        const int mode = pn < 2 ? 0 : (pn == 2 ? 1 : (pn < 5 ? 2 : 3));
        int colb[2]; f32x4 gv[2][2];
#pragma unroll
        for (int bj = 0; bj < 2; ++bj) {
            colb[bj] = mode == 3 ? 1280 + 64 * (4 * (pn - 5) + wc) + 32 * bj + 8 * fq : 256 * pn + 128 * bj + 32 * wc + 8 * fq;
#pragma unroll
            for (int n = 0; n < 2; ++n) gv[bj][n] = mode == 3 ? *(const f32x4*)(vgain + (colb[bj] - 1280) + 4 * n) : (f32x4){1.f, 1.f, 1.f, 1.f};
        }
        ss_t sv[2][4];
#pragma unroll
        for (int ai = 0; ai < 2; ++ai)
#pragma unroll
            for (int m = 0; m < 4; ++m) sv[ai][m] = ss[row0 + ai * HALF + m * 16];
#pragma unroll
        for (int ai = 0; ai < 2; ++ai)
#pragma unroll
            for (int m = 0; m < 4; ++m) {
                const int row = row0 + ai * HALF + m * 16; const float rs = rs_of(sv[ai][m]);
                f32x4 v[2][2];
#pragma unroll
                for (int bj = 0; bj < 2; ++bj)
#pragma unroll
                    for (int n = 0; n < 2; ++n) v[bj][n] = acc[ai][bj][m][n] * rs;
                if (mode == 0) {
#pragma unroll
                    for (int bj = 0; bj < 2; ++bj)
#pragma unroll
                        for (int n = 0; n < 2; ++n) v[bj][n] = v[bj][n] * (0.125f * K_LOG2E);
                } else if (mode >= 2) {
#pragma unroll
                    for (int bj = 0; bj < 2; ++bj)
#pragma unroll
                        for (int n = 0; n < 2; ++n)
#pragma unroll
                            for (int e = 0; e < 4; ++e) v[bj][n][e] = gelu_tanh_f(v[bj][n][e]);
                    if (mode == 3) {
                        float q = 0.f;
#pragma unroll
                        for (int bj = 0; bj < 2; ++bj)
#pragma unroll
                            for (int n = 0; n < 2; ++n) q += (v[bj][n][0] * v[bj][n][0] + v[bj][n][1] * v[bj][n][1]) + (v[bj][n][2] * v[bj][n][2] + v[bj][n][3] * v[bj][n][3]);
                        q += __shfl_xor(q, 16); q += __shfl_xor(q, 32);
                        const float r2 = __builtin_amdgcn_rsqf(q * (1.0f / 64.0f) + RMS_EPS);
#pragma unroll
                        for (int bj = 0; bj < 2; ++bj)
#pragma unroll
                            for (int n = 0; n < 2; ++n) v[bj][n] = v[bj][n] * r2 * gv[bj][n];
                    }
                }
#pragma unroll
                for (int bj = 0; bj < 2; ++bj) {
                    u32x4 w; w.x = cvt_pk_bf16(v[bj][0][0], v[bj][0][1]); w.y = cvt_pk_bf16(v[bj][0][2], v[bj][0][3]); w.z = cvt_pk_bf16(v[bj][1][0], v[bj][1][1]); w.w = cvt_pk_bf16(v[bj][1][2], v[bj][1][3]);
                    *(u32x4*)(Z + (size_t)row * 1792 + colb[bj]) = w;
                }
                asm volatile("" ::: "memory");
            }
    }
};

template <class Epi, class Sched, bool ALIGN_EPI = false, bool SP2 = false>
__device__ __forceinline__ void gemm_phase(PG8_LAS unsigned char* lds, const Gemm g, const Sched& S, const Epi& E) {
    const int tid = opaque_v((int)threadIdx.x), wid = __builtin_amdgcn_readfirstlane(tid >> 6), lane = tid & 63, wr = wid >> 2, wc = wid & 3, fr = lane & 15, fq = lane >> 4;
    const int K = g.K, nt = K / BK;
    unsigned voffA[2], voffB[2];
#pragma unroll
    for (int i = 0; i < 2; ++i) { int R, C; stage_rc(tid * 16 + i * 8192, R, C); const int Rb = Epi::PERM ? ((R & ~31) + perm32(R & 31)) : R;
        voffA[i] = (unsigned)(R * K + C) * 2u; voffB[i] = (unsigned)(Rb * K + C) * 2u; }
    const size_t kstep = (size_t)(BK * 2);
    const size_t hstep = (size_t)HALF * K * 2;
    const size_t tstep = 2 * hstep;
    const unsigned ldsw = (unsigned)wid * 1024u;
    const int aoff = lds_byte(wr * 64 + fr, fq * 8), boff = lds_byte(wc * 32 + fr, fq * 8);
#define PG8_SA(b, h) (((b) * 2 + (h)) * HTB)
#define PG8_SB(b, h) ((4 + (b) * 2 + (h)) * HTB)
#define PG8_STAGE(bufoff, gbase, voff) do { _Pragma("unroll") for (int _i = 0; _i < 2; ++_i) \
        __builtin_amdgcn_global_load_lds((const unsigned*)((const char*)(gbase) + (voff)[_i]), (PG8_LAS unsigned*)(lds + (bufoff) + ldsw + _i * 8192), 16, 0, 0); } while (0)
#define PG8_LDA(dst, b, h) do { _Pragma("unroll") for (int m = 0; m < 4; ++m) _Pragma("unroll") for (int k = 0; k < 2; ++k) dst[m][k] = *(const PG8_LAS bf16x8*)(lds + PG8_SA(b, h) + aoff + m * 2048 + k * 1024); } while (0)
#define PG8_LDB(dst, b, h) do { _Pragma("unroll") for (int n = 0; n < 2; ++n) _Pragma("unroll") for (int k = 0; k < 2; ++k) dst[n][k] = *(const PG8_LAS bf16x8*)(lds + PG8_SB(b, h) + boff + n * 2048 + k * 1024); } while (0)
#define PG8_MMA(ai, bj, At, Bt) do { __builtin_amdgcn_s_setprio(1); _Pragma("unroll") for (int m = 0; m < 4; ++m) _Pragma("unroll") for (int n = 0; n < 2; ++n) _Pragma("unroll") for (int k = 0; k < 2; ++k) \
        acc[ai][bj][m][n] = __builtin_amdgcn_mfma_f32_16x16x32_bf16(Bt[n][k], At[m][k], acc[ai][bj][m][n], 0, 0, 0); __builtin_amdgcn_s_setprio(0); } while (0)
#define PG8_WAIT_V(n) asm volatile("s_waitcnt vmcnt(" #n ")" ::: "memory")
#define PG8_WAIT_L(n) asm volatile("s_waitcnt lgkmcnt(" #n ")" ::: "memory")
#define PG8_BAR __builtin_amdgcn_s_barrier()
#define PG8_SCHED __builtin_amdgcn_sched_barrier(0)
    Unit cur, nxt; int ui = 0;
    if (!S.next(0, cur)) return;
    f32x4 acc[2][2][4][2];
#pragma unroll
    for (int a = 0; a < 2; ++a)
#pragma unroll
        for (int b = 0; b < 2; ++b)
#pragma unroll
            for (int m = 0; m < 4; ++m)
#pragma unroll
                for (int n = 0; n < 2; ++n) acc[a][b][m][n] = (f32x4){0.f, 0.f, 0.f, 0.f};
    bf16x8 At[4][2], B0[2][2], B1[2][2];
    const char* cA = (const char*)g.A + (size_t)cur.pm * tstep; const char* cB = (const char*)g.Bt + (size_t)cur.pn * tstep;
    S.a_ready(cur);
    if constexpr (SP2) {
        PG8_STAGE(PG8_SB(0, 0), cB, voffB); PG8_STAGE(PG8_SB(0, 1), cB + hstep, voffB); PG8_STAGE(PG8_SA(0, 0), cA, voffA); PG8_STAGE(PG8_SA(0, 1), cA + hstep, voffA);
        if (wr == 1) PG8_BAR;
        PG8_WAIT_V(2); PG8_BAR;
        PG8_STAGE(PG8_SB(1, 0), cB + kstep, voffB); PG8_STAGE(PG8_SA(1, 0), cA + kstep, voffA); PG8_STAGE(PG8_SB(1, 1), cB + hstep + kstep, voffB);
        PG8_WAIT_V(6); PG8_BAR;
    } else {
        PG8_STAGE(PG8_SB(0, 0), cB, voffB); PG8_STAGE(PG8_SA(0, 0), cA, voffA); PG8_STAGE(PG8_SB(0, 1), cB + hstep, voffB); PG8_STAGE(PG8_SA(0, 1), cA + hstep, voffA);
        if (wr == 1) PG8_BAR;
        PG8_WAIT_V(4); PG8_BAR;
        PG8_STAGE(PG8_SB(1, 0), cB + kstep, voffB); PG8_STAGE(PG8_SA(1, 0), cA + kstep, voffA); PG8_STAGE(PG8_SB(1, 1), cB + hstep + kstep, voffB);
        PG8_WAIT_V(6); PG8_BAR;
    }
    for (;;) {
        const bool has_next = S.next(ui + 1, nxt);
        const char* nA = has_next ? (const char*)g.A + (size_t)nxt.pm * tstep : cA; const char* nB = has_next ? (const char*)g.Bt + (size_t)nxt.pn * tstep : cB;
        for (int t = 0; t < nt; t += 2) {
            const bool last = (t == nt - 2);
            const char* a1 = cA + (size_t)(t + 1) * kstep;
            const char* a2 = last ? nA : cA + (size_t)(t + 2) * kstep; const char* b2 = last ? nB : cB + (size_t)(t + 2) * kstep;
            const char* a3 = a2 + kstep; const char* b3 = b2 + kstep;
            if (last && has_next) S.a_ready(nxt);
            if constexpr (SP2) {
            PG8_LDB(B0, 0, 0); PG8_LDB(B1, 0, 1); PG8_SCHED; PG8_LDA(At, 0, 0); PG8_STAGE(PG8_SA(1, 1), a1 + hstep, voffA);
            PG8_WAIT_V(8); PG8_WAIT_L(0); PG8_BAR; PG8_MMA(0, 0, At, B0); PG8_MMA(0, 1, At, B1); PG8_BAR; PG8_SCHED;
            PG8_LDA(At, 0, 1); PG8_STAGE(PG8_SB(0, 0), b2, voffB); PG8_STAGE(PG8_SB(0, 1), b2 + hstep, voffB); PG8_STAGE(PG8_SA(0, 0), a2, voffA);
            PG8_WAIT_V(8); PG8_WAIT_L(0); PG8_BAR; PG8_MMA(1, 0, At, B0); PG8_MMA(1, 1, At, B1); PG8_BAR; PG8_SCHED;
            PG8_LDB(B0, 1, 0); PG8_LDB(B1, 1, 1); PG8_SCHED; PG8_LDA(At, 1, 0); PG8_STAGE(PG8_SA(0, 1), a2 + hstep, voffA);
            PG8_WAIT_V(8); PG8_WAIT_L(0); PG8_BAR; PG8_MMA(0, 0, At, B0); PG8_MMA(0, 1, At, B1); PG8_BAR; PG8_SCHED;
            PG8_LDA(At, 1, 1); PG8_STAGE(PG8_SB(1, 0), b3, voffB); PG8_STAGE(PG8_SB(1, 1), b3 + hstep, voffB); PG8_STAGE(PG8_SA(1, 0), a3, voffA);
            PG8_WAIT_V(8); PG8_WAIT_L(0); PG8_BAR; PG8_MMA(1, 0, At, B0); PG8_MMA(1, 1, At, B1); PG8_BAR; PG8_SCHED;
            } else {
            PG8_LDB(B0, 0, 0); PG8_SCHED; PG8_LDA(At, 0, 0); PG8_STAGE(PG8_SA(1, 1), a1 + hstep, voffA);
            PG8_WAIT_L(8); PG8_BAR; PG8_WAIT_L(0); PG8_MMA(0, 0, At, B0); PG8_BAR; PG8_SCHED;
            PG8_LDB(B1, 0, 1); PG8_STAGE(PG8_SB(0, 0), b2, voffB);
            PG8_BAR; PG8_WAIT_L(0); PG8_MMA(0, 1, At, B1); PG8_BAR;
            PG8_LDA(At, 0, 1); PG8_STAGE(PG8_SA(0, 0), a2, voffA);
            PG8_BAR; PG8_WAIT_L(0); PG8_MMA(1, 0, At, B0); PG8_BAR; PG8_SCHED;
            PG8_STAGE(PG8_SB(0, 1), b2 + hstep, voffB);
            PG8_WAIT_V(6); PG8_BAR; PG8_MMA(1, 1, At, B1); PG8_BAR;
            PG8_LDB(B0, 1, 0); PG8_SCHED; PG8_LDA(At, 1, 0); PG8_STAGE(PG8_SA(0, 1), a2 + hstep, voffA);
            PG8_WAIT_L(8); PG8_BAR; PG8_WAIT_L(0); PG8_MMA(0, 0, At, B0); PG8_BAR; PG8_SCHED;
            PG8_LDB(B1, 1, 1); PG8_STAGE(PG8_SB(1, 0), b3, voffB);
            PG8_BAR; PG8_WAIT_L(0); PG8_MMA(0, 1, At, B1); PG8_BAR;
            PG8_LDA(At, 1, 1); PG8_STAGE(PG8_SA(1, 0), a3, voffA);
            PG8_BAR; PG8_WAIT_L(0); PG8_MMA(1, 0, At, B0); PG8_BAR; PG8_SCHED;
            PG8_STAGE(PG8_SB(1, 1), b3 + hstep, voffB);
            PG8_WAIT_V(6); PG8_BAR; PG8_MMA(1, 1, At, B1); PG8_BAR;
            }
        }
        if constexpr (ALIGN_EPI) { if (wr == 0) PG8_BAR; }
        if constexpr (!Epi::AFTER_DRAIN) { E(acc, cur, wr, wc, fr, fq); S.done(cur); }
        if (!has_next) break;
#pragma unroll
        for (int a = 0; a < 2; ++a)
#pragma unroll
            for (int b = 0; b < 2; ++b)
#pragma unroll
                for (int m = 0; m < 4; ++m)
#pragma unroll
                    for (int n = 0; n < 2; ++n) acc[a][b][m][n] = (f32x4){0.f, 0.f, 0.f, 0.f};
        cur = nxt; cA = nA; cB = nB; ++ui;
        if constexpr (ALIGN_EPI) { if (wr == 1) PG8_BAR; }
    }
    PG8_WAIT_V(0);
    if constexpr (!ALIGN_EPI) { if (wr == 0) PG8_BAR; }
    PG8_BAR;
    if constexpr (Epi::AFTER_DRAIN) { E.fused(acc, cur, wr, wc, fr, fq, lds, wid, lane); S.done(cur); }
#undef PG8_SA
#undef PG8_SB
#undef PG8_STAGE
#undef PG8_LDA
#undef PG8_LDB
#undef PG8_MMA
#undef PG8_WAIT_V
#undef PG8_WAIT_L
#undef PG8_BAR
#undef PG8_SCHED
}
}

#ifndef PH_MASK
#define PH_MASK 127
#endif
#ifndef N_LAYER
#define N_LAYER 2
#endif
constexpr int NWAVES = 8;
#ifndef L1_CUT
#define L1_CUT 7168
#endif
constexpr int TOK = 32768, TOKP = 16384, DM = 1024, FF = 2816, NIN = 1792, NLAYER = N_LAYER, NBLK = TOK / 128;
constexpr size_t WS_SS = 0;
constexpr size_t WS_W = 2u << 20;
constexpr size_t W_GU1 = 0, W_D1 = W_GU1 + (size_t)2 * FF * DM * 2, W_IN = W_D1 + (size_t)DM * FF * 2, W_OUT = W_IN + (size_t)NIN * DM * 2,
                 W_GU2 = W_OUT + (size_t)DM * DM * 2, W_D2 = W_GU2 + (size_t)2 * FF * DM * 2, W_BYTES = W_D2 + (size_t)DM * FF * 2;
constexpr size_t WS_XB = WS_W + W_BYTES;
constexpr size_t WS_R1 = WS_XB + (size_t)TOK * DM * 2;
constexpr size_t WS_Z = WS_R1, WS_MIX = WS_R1 + (size_t)TOK * NIN * 2, WS_H = WS_R1;
constexpr size_t WS_WSB = WS_R1 + (size_t)TOK * FF * 2;
constexpr size_t WS_END = WS_WSB + (size_t)NLAYER * 8 * 128 * 128 * 2;
static_assert(WS_MIX + (size_t)TOK * DM * 2 == WS_WSB && WS_XB % 256 == 0 && WS_R1 % 256 == 0, "d_ws map");
constexpr int LDSCTL_OFF = 147456 - 256;
constexpr size_t WS_BAR = 0x1D0000, WS_BAR_BYTES = 16384;
constexpr int LDS_BYTES = 147456;

#define LAS __attribute__((address_space(3)))
typedef unsigned short bf16;
typedef unsigned v4u __attribute__((ext_vector_type(4)));
typedef unsigned v2u __attribute__((ext_vector_type(2)));
typedef float f32x4 __attribute__((ext_vector_type(4)));
typedef short bf16x8 __attribute__((ext_vector_type(8)));
typedef short s16x4 __attribute__((ext_vector_type(4)));
typedef short v4i16_t __attribute__((ext_vector_type(4)));
#define LDS_WAIT() asm volatile("s_waitcnt lgkmcnt(0)" ::: "memory")
typedef float f32x2_t __attribute__((ext_vector_type(2)));
typedef __bf16 bf16x2_t __attribute__((ext_vector_type(2)));
__device__ __forceinline__ unsigned pk2(float lo, float hi) { f32x2_t v = {lo, hi}; bf16x2_t b = __builtin_convertvector(v, bf16x2_t); return __builtin_bit_cast(unsigned, b); }
__device__ __forceinline__ float bf_lo(unsigned w) { return __builtin_bit_cast(float, w << 16); }
__device__ __forceinline__ float bf_hi(unsigned w) { return __builtin_bit_cast(float, w & 0xffff0000u); }
__device__ __forceinline__ s16x4 vtr(const LAS unsigned char* p) { return __builtin_bit_cast(s16x4, __builtin_amdgcn_ds_read_tr16_b64_v4i16((LAS v4i16_t*)p)); }
__device__ __forceinline__ int opaque(int v) { asm volatile("" : "+s"(v)); return v; }
__device__ __forceinline__ float wave_sum(float v) {
#pragma unroll
    for (int o = 1; o < 64; o <<= 1) v += __shfl_xor(v, o);
    return v;
}

#define XB_TMO      128
#define XB_XCNT(j)  (256  + 64 * (j))
#define XB_XSUB(j)  (1280 + 64 * (j))
#define XB_XGEN(j)  (2304 + 64 * (j))
#define XB_TOP      3328
#define XB_TOPGEN   3392
#define XCD_BAR_WORDS 3456
#define XB_SPIN_CAP (1u << 18)

__device__ __forceinline__ unsigned xb_ld(unsigned* p)              { return __hip_atomic_load(p, __ATOMIC_RELAXED, __HIP_MEMORY_SCOPE_AGENT); }
__device__ __forceinline__ unsigned xb_add(unsigned* p, unsigned v) { return __hip_atomic_fetch_add(p, v, __ATOMIC_RELAXED, __HIP_MEMORY_SCOPE_AGENT); }
__device__ __forceinline__ unsigned xb_xcc_id() { return (unsigned)__builtin_amdgcn_s_getreg((3 << 11) | 20) & 0xFu; }
#define XB_SPIN(cond, bar) do { unsigned _sp = 0; while (cond) { __builtin_amdgcn_s_sleep(1); \
    if ((++_sp & 255u) == 0u) { if (xb_ld(&(bar)[XB_TMO])) break; if (_sp > XB_SPIN_CAP) { atomicAdd(&(bar)[XB_TMO], 1u); break; } } } } while (0)

struct XcdBarrier {
    unsigned* bar; unsigned x;
    volatile LAS unsigned* st;
};

__device__ __forceinline__ XcdBarrier xcd_barrier_post(unsigned* bar, volatile LAS unsigned* st) {
    XcdBarrier b; b.bar = bar; b.x = xb_xcc_id(); b.st = st;
    if (threadIdx.x == 0) (void)xb_add(&bar[XB_XCNT(b.x)], 1u);
    return b;
}
__device__ __forceinline__ void xcd_barrier_complete(unsigned* bar, unsigned x, unsigned& nloc, unsigned& nx) {
    const unsigned G = gridDim.x * gridDim.y * gridDim.z;
    unsigned sum, cnt, mine, sp = 0u;
    for (;;) {
        sum = 0u; cnt = 0u; mine = 0u;
#pragma unroll
        for (unsigned j = 0; j < 16; ++j) { const unsigned c = xb_ld(&bar[XB_XCNT(j)]); sum += c; cnt += (c > 0u) ? 1u : 0u; mine = (j == x) ? c : mine; }
        if (sum == G) break;
        __builtin_amdgcn_s_sleep(1);
        if ((++sp & 255u) == 0u) { if (xb_ld(&bar[XB_TMO])) break; if (sp > XB_SPIN_CAP) { atomicAdd(&bar[XB_TMO], 1u); break; } }
    }
    nloc = mine > 0u ? mine : 1u; nx = cnt > 0u ? cnt : 1u;
}

__device__ __forceinline__ void xcd_barrier(const XcdBarrier& b) {
    asm volatile("s_waitcnt vmcnt(0)" ::: "memory");
    __syncthreads();
    if (threadIdx.x == 0) {
        unsigned* bar = b.bar;
        __builtin_amdgcn_s_waitcnt(0);
        unsigned nloc = b.st[0], nx = b.st[1];
        if (nloc == 0u) { xcd_barrier_complete(bar, b.x, nloc, nx); b.st[0] = nloc; b.st[1] = nx; }
        const unsigned old = xb_add(&bar[XB_XSUB(b.x)], 1u);
        const unsigned gen = old / nloc;
        if (old + 1u == (gen + 1u) * nloc) {
            __builtin_amdgcn_fence(__ATOMIC_RELEASE, "agent");
            asm volatile("s_waitcnt vmcnt(0)" ::: "memory");
            const unsigned og = xb_add(&bar[XB_TOP], 1u);
            const unsigned tg = og / nx;
            if (og + 1u == (tg + 1u) * nx) xb_add(&bar[XB_TOPGEN], 1u);
            else XB_SPIN(xb_ld(&bar[XB_TOPGEN]) == tg, bar);
            __builtin_amdgcn_fence(__ATOMIC_ACQUIRE, "agent");
            xb_add(&bar[XB_XGEN(b.x)], 1u);
            asm volatile("s_waitcnt vmcnt(0)" ::: "memory");
        } else {
            XB_SPIN(xb_ld(&bar[XB_XGEN(b.x)]) == gen, bar);
            __builtin_amdgcn_fence(__ATOMIC_ACQUIRE, "agent");
            asm volatile("s_waitcnt vmcnt(0)" ::: "memory");
        }
    }
    __syncthreads();
}

struct Args {
    const float *x_prompt, *x_sample, *norm_ffn1, *w1_gate, *w1_up, *w1_down, *norm_mix, *w_in, *sink, *vgain, *w_sp, *b_sp, *w_out, *norm_ffn2, *w2_gate, *w2_up, *w2_down, *norm_final;
    float* out; unsigned char* ws;
};

typedef const __attribute__((address_space(4))) Args* KArgs;
__device__ __forceinline__ KArgs kargs() { const __attribute__((address_space(4))) void* p = (const __attribute__((address_space(4))) void*)__builtin_amdgcn_kernarg_segment_ptr(); asm volatile("" : "+s"(p)); return (KArgs)p; }
__device__ __forceinline__ void conv_item(const float* W, int ldn, int K, const float* gain, bf16* WT, int dst_row0, int src_col0, int k0, LAS float* scr, int lane) {
    f32x4 v[8]; float g[8];
#pragma unroll
    for (int i = 0; i < 8; ++i) { const int kk = 8 * i + (lane >> 3); v[i] = *(const f32x4*)(W + (size_t)(k0 + kk) * ldn + src_col0 + 4 * (lane & 7)); g[i] = gain ? gain[k0 + kk] : 1.0f; }
#pragma unroll
    for (int i = 0; i < 8; ++i) { const int kk = 8 * i + (lane >> 3); LAS float* s = scr + kk * 33 + 4 * (lane & 7); s[0] = v[i][0] * g[i]; s[1] = v[i][1] * g[i]; s[2] = v[i][2] * g[i]; s[3] = v[i][3] * g[i]; }
    LDS_WAIT(); asm volatile("" ::: "memory");
    const int c = lane & 7;
#pragma unroll
    for (int j = 0; j < 4; ++j) { const int n = (lane >> 3) + 8 * j; const LAS float* s = scr + (8 * c) * 33 + n;
        v4u o; o.x = pk2(s[0 * 33], s[1 * 33]); o.y = pk2(s[2 * 33], s[3 * 33]); o.z = pk2(s[4 * 33], s[5 * 33]); o.w = pk2(s[6 * 33], s[7 * 33]);
        *(v4u*)(WT + (size_t)(dst_row0 + n) * K + k0 + 8 * c) = o; }
    LDS_WAIT(); asm volatile("" ::: "memory");
}
__device__ __forceinline__ void convert_layer(KArgs a, int l, LAS unsigned char* lds, int gw, int NGW, int wave, int lane, int it_lo, int it_hi) {
    LAS float* scr = (LAS float*)(lds + wave * 16384);
    bf16* Wb = l == 0 ? (bf16*)(a->ws + WS_W) : (bf16*)a->out;
    constexpr int I_GU = (2 * FF / 32) * (DM / 64), I_D = (DM / 32) * (FF / 64), I_IN = (NIN / 32) * (DM / 64), I_OUT = (DM / 32) * (DM / 64);
    constexpr int NITEMS = 2 * I_GU + 2 * I_D + I_IN + I_OUT;
    const int it_end = it_hi < NITEMS ? it_hi : NITEMS;
    for (int it = it_lo + gw; it < it_end; it += NGW) {
        int r = it; const float* src; const float* gain = nullptr; int ldn, K, nblk; size_t dsto; int kind;
        const float *gsrc = nullptr, *usrc = nullptr;
        if (r < I_GU) { kind = 1; gsrc = a->w1_gate + (size_t)l * DM * FF; usrc = a->w1_up + (size_t)l * DM * FF; gain = a->norm_ffn1 + l * DM; ldn = FF; K = DM; nblk = 2 * FF / 32; dsto = W_GU1; }
        else if ((r -= I_GU) < I_D) { kind = 0; gsrc = a->w1_down + (size_t)l * DM * FF; ldn = DM; K = FF; nblk = DM / 32; dsto = W_D1; }
        else if ((r -= I_D) < I_IN) { kind = 2; gsrc = a->w_in + (size_t)l * DM * NIN; gain = a->norm_mix + l * DM; ldn = NIN; K = DM; nblk = NIN / 32; dsto = W_IN; }
        else if ((r -= I_IN) < I_OUT) { kind = 0; gsrc = a->w_out + (size_t)l * DM * DM; ldn = DM; K = DM; nblk = DM / 32; dsto = W_OUT; }
        else if ((r -= I_OUT) < I_GU) { kind = 1; gsrc = a->w2_gate + (size_t)l * DM * FF; usrc = a->w2_up + (size_t)l * DM * FF; gain = a->norm_ffn2 + l * DM; ldn = FF; K = DM; nblk = 2 * FF / 32; dsto = W_GU2; }
        else { r -= I_GU; kind = 0; gsrc = a->w2_down + (size_t)l * DM * FF; ldn = DM; K = FF; nblk = DM / 32; dsto = W_D2; }
        const int kb = r / nblk, nb = r % nblk; int sc0 = 32 * nb; src = gsrc;
        if (kind == 1) { const int pn = nb >> 3, lb = nb & 7; src = lb < 4 ? gsrc : usrc; sc0 = 128 * pn + 32 * (lb & 3); }
        else if (kind == 2 && nb >= 40) { const int t = nb - 40, pnl = t >> 3, lb = t & 7, bj = lb >> 2, wc = lb & 3; sc0 = 1280 + 64 * (4 * pnl + wc) + 32 * bj; }
        conv_item(src, ldn, K, gain, (bf16*)((unsigned char*)Wb + dsto), 32 * nb, sc0, 64 * kb, scr, lane);
    }
}

constexpr int KS_STRIDE = 144;
constexpr int KS_BYTES = 384 * KS_STRIDE;
constexpr int TAB_OFF = 2 * KS_BYTES, TAB_N = 388, TAB_ZERO = 196;
static_assert(TAB_OFF + 4 * 4 * TAB_N * 4 <= LDSCTL_OFF, "LDS map");
constexpr int GS_STRIDE = 1040;
static_assert(128 * GS_STRIDE <= LDSCTL_OFF, "LDS map");
__device__ __forceinline__ void mixer_phase(KArgs a, int l, LAS unsigned char* lds, int G, int bid, int tid, int wave, int lane) {
    const bf16* Z = (const bf16*)(a->ws + WS_Z); bf16* MIX = (bf16*)(a->ws + WS_MIX);
    const int fr = lane & 15, fq = lane >> 4, tq = fr >> 2, tp = fr & 3;
    LAS unsigned char* Ks = lds; LAS unsigned char* Vs = lds + KS_BYTES; LAS unsigned char* Gs = lds;
#pragma unroll 1
    for (int blk = bid; blk < NBLK; blk += G) {
        const int sb = blk < 128 ? (blk & ~63) : (blk & ~15), se = sb + (blk < 128 ? 64 : 16);
        const bool has_prev = blk > sb, has_next = blk + 1 < se;
#ifndef MIX_NO_ATT
#ifndef REP_ATT
#define REP_ATT 1
#endif
#pragma unroll 1
        for (int kvh2 = 0; kvh2 < 2 * REP_ATT; ++kvh2) { const int kvh = kvh2 & 1;
            __syncthreads();
#pragma unroll
            for (int i = 0; i < 6; ++i) {
                const int id = tid + 512 * i, kj = id >> 3, c = id & 7, kb = kj >> 7;
                const bool ok = kb == 1 || (kb == 0 ? has_prev : has_next);
                v4u kv = (v4u){0u, 0u, 0u, 0u}, vv = (v4u){0u, 0u, 0u, 0u};
                if (ok) { const bf16* zr = Z + (size_t)(128 * (blk - 1) + kj) * NIN + 64 * kvh + 8 * c; kv = *(const v4u*)(zr + 512); vv = *(const v4u*)(zr + 640); }
                *(LAS v4u*)(Ks + kj * KS_STRIDE + c * 16) = kv; *(LAS v4u*)(Vs + kj * KS_STRIDE + c * 16) = vv;
            }
            for (int e = tid; e < 4 * 4 * TAB_N; e += 512) {
                const int hd = e / (4 * TAB_N), k = (e / TAB_N) & 3, i = e % TAB_N, rel = i + k - TAB_ZERO, ad = rel < 0 ? -rel : rel;
                const float sl = __builtin_amdgcn_exp2f(-(float)(kvh * 4 + hd + 1)) * pg8::K_LOG2E;
                ((LAS float*)(lds + TAB_OFF))[e] = ad <= 128 ? -sl * (float)ad : -INFINITY;
            }
            __syncthreads();
            {
                const int hq = kvh * 4 + (wave >> 1), half = wave & 1;
                const float sinkl = a->sink[l * 8 + hq] * pg8::K_LOG2E;
                bf16x8 qf[4][2];
#pragma unroll
                for (int qg = 0; qg < 4; ++qg)
#pragma unroll
                    for (int dk = 0; dk < 2; ++dk) qf[qg][dk] = *(const bf16x8*)(Z + (size_t)(128 * blk + 64 * half + 16 * qg + fr) * NIN + hq * 64 + 32 * dk + 8 * fq);
                f32x4 o[4][4];
#pragma unroll
                for (int db = 0; db < 4; ++db)
#pragma unroll
                    for (int qg = 0; qg < 4; ++qg) o[db][qg] = (f32x4){0.f, 0.f, 0.f, 0.f};
                float mrow[4], lsum[4];
#pragma unroll
                for (int qg = 0; qg < 4; ++qg) { mrow[qg] = sinkl; lsum[qg] = 0.f; }
                const int dl0 = 4 * fq - fr, kcp = dl0 & 3;
                const LAS unsigned char* tbl = lds + TAB_OFF + ((wave >> 1) * 4 + kcp) * (TAB_N * 4) + 4 * (dl0 - kcp + TAB_ZERO - 128 - 48);
#pragma unroll 2
                for (int kt = 0; kt < 10; ++kt) {
                    const int key0 = 64 * half + 32 * kt, tb = key0 >> 7;
                    if ((tb == 0 && !has_prev) || (tb == 2 && !has_next)) continue;
                    f32x4 s[2][4];
#pragma unroll
                    for (int kb = 0; kb < 2; ++kb)
#pragma unroll
                        for (int qg = 0; qg < 4; ++qg) s[kb][qg] = (f32x4){0.f, 0.f, 0.f, 0.f};
#pragma unroll
                    for (int kb = 0; kb < 2; ++kb)
#pragma unroll
                        for (int dk = 0; dk < 2; ++dk) {
                            const bf16x8 kf = *(const LAS bf16x8*)(Ks + (key0 + 16 * kb + fr) * KS_STRIDE + 64 * dk + 16 * fq);
#pragma unroll
                            for (int qg = 0; qg < 4; ++qg) s[kb][qg] = __builtin_amdgcn_mfma_f32_16x16x32_bf16(kf, qf[qg][dk], s[kb][qg], 0, 0, 0);
                        }
                    bf16x8 pb[4];
                    const LAS unsigned char* tbp = tbl + 128 * kt;
#pragma unroll
                    for (int qg = 0; qg < 4; ++qg) {
                        float mx = mrow[qg];
#pragma unroll
                        for (int kb = 0; kb < 2; ++kb) {
                            const f32x4 bv = *(const LAS f32x4*)(tbp + 64 * (kb - qg + 3));
                            s[kb][qg] = s[kb][qg] + bv;
                            mx = fmaxf(mx, fmaxf(fmaxf(s[kb][qg][0], s[kb][qg][1]), fmaxf(s[kb][qg][2], s[kb][qg][3])));
                        }
                        mx = fmaxf(mx, __shfl_xor(mx, 16)); mx = fmaxf(mx, __shfl_xor(mx, 32));
                        const float mold = mrow[qg];
                        float ps = 0.f;
#pragma unroll
                        for (int kb = 0; kb < 2; ++kb)
#pragma unroll
                            for (int j = 0; j < 4; ++j) { const float p = __builtin_amdgcn_exp2f(s[kb][qg][j] - mx); s[kb][qg][j] = p; ps += p; }
                        {
                            const float alpha = __builtin_amdgcn_exp2f(mold - mx); mrow[qg] = mx;
                            lsum[qg] = lsum[qg] * alpha;
#pragma unroll
                            for (int db = 0; db < 4; ++db) o[db][qg] = o[db][qg] * alpha;
                        }
                        lsum[qg] += ps;
                        v4u w; w.x = pk2(s[0][qg][0], s[0][qg][1]); w.y = pk2(s[0][qg][2], s[0][qg][3]); w.z = pk2(s[1][qg][0], s[1][qg][1]); w.w = pk2(s[1][qg][2], s[1][qg][3]);
                        pb[qg] = __builtin_bit_cast(bf16x8, w);
                    }
#pragma unroll
                    for (int db = 0; db < 4; ++db) {
                        const LAS unsigned char* vp = Vs + (key0 + 4 * fq + tq) * KS_STRIDE + (16 * db + 4 * tp) * 2;
                        const s16x4 lo = vtr(vp), hi = vtr(vp + 16 * KS_STRIDE);
                        const bf16x8 vf = (bf16x8){lo[0], lo[1], lo[2], lo[3], hi[0], hi[1], hi[2], hi[3]};
#pragma unroll
                        for (int qg = 0; qg < 4; ++qg) o[db][qg] = __builtin_amdgcn_mfma_f32_16x16x32_bf16(vf, pb[qg], o[db][qg], 0, 0, 0);
                    }
                }
#pragma unroll
                for (int qg = 0; qg < 4; ++qg) {
                    float lt = lsum[qg]; lt += __shfl_xor(lt, 16); lt += __shfl_xor(lt, 32); lt += __builtin_amdgcn_exp2f(sinkl - mrow[qg]);
                    const float inv = 1.0f / lt;
                    bf16* op = MIX + (size_t)(128 * blk + 64 * half + 16 * qg + fr) * DM + hq * 64 + 4 * fq;
#pragma unroll
                    for (int db = 0; db < 4; ++db) { const f32x4 v = o[db][qg] * inv; v2u w; w.x = pk2(v[0], v[1]); w.y = pk2(v[2], v[3]); *(v2u*)(op + 16 * db) = w; }
                }
            }
        }
#endif
        {
            const int tidg = pg8::opaque_v(tid);
            const int h = wave;
            const v4u* wsb = (const v4u*)(a->ws + WS_WSB) + ((size_t)(l * 8 + h) * 32) * 64 + lane;
            v4u gl[16];
#pragma unroll
            for (int i = 0; i < 16; ++i) { const int id = tidg + 512 * i, srow = id >> 6, c = id & 63; gl[i] = *(const v4u*)(Z + (size_t)(128 * blk + srow) * NIN + 1280 + 8 * c); }
            __syncthreads();
#pragma unroll
            for (int i = 0; i < 16; ++i) { const int id = tidg + 512 * i, srow = id >> 6, c = id & 63; *(LAS v4u*)(Gs + srow * GS_STRIDE + c * 16) = gl[i]; }
#pragma unroll 1
            for (int th = 0; th < 2; ++th) {
                const int tbase = 64 * th;
                v4u wf[4][4]; v2u uu[4][4]; float bias[4];
#pragma unroll
                for (int tb = 0; tb < 4; ++tb) { const size_t row = (size_t)128 * blk + tbase + 16 * tb + fr; bias[tb] = a->b_sp[(l * 8 + h) * 128 + tbase + 16 * tb + fr];
#pragma unroll
                    for (int c = 0; c < 4; ++c) wf[tb][c] = wsb[((4 * th + tb) * 4 + c) * 64];
#pragma unroll
                    for (int db = 0; db < 4; ++db) uu[tb][db] = *(const v2u*)(Z + row * NIN + 768 + 64 * h + 16 * db + 4 * fq); }
                if (th == 0) __syncthreads();
                f32x4 d[4][4];
#pragma unroll
                for (int tb = 0; tb < 4; ++tb)
#pragma unroll
                    for (int db = 0; db < 4; ++db) d[tb][db] = (f32x4){0.f, 0.f, 0.f, 0.f};
#pragma unroll
                for (int c = 0; c < 4; ++c)
#pragma unroll
                    for (int db = 0; db < 4; ++db) {
                        const LAS unsigned char* gp = Gs + (32 * c + 8 * fq + tq) * GS_STRIDE + (64 * h + 16 * db + 4 * tp) * 2;
                        const s16x4 lo = vtr(gp), hi = vtr(gp + 4 * GS_STRIDE);
                        const bf16x8 af = (bf16x8){lo[0], lo[1], lo[2], lo[3], hi[0], hi[1], hi[2], hi[3]};
#pragma unroll
                        for (int tb = 0; tb < 4; ++tb) d[tb][db] = __builtin_amdgcn_mfma_f32_16x16x32_bf16(af, __builtin_bit_cast(bf16x8, wf[tb][c]), d[tb][db], 0, 0, 0);
                    }
#pragma unroll
                for (int tb = 0; tb < 4; ++tb) { const size_t row = (size_t)128 * blk + tbase + 16 * tb + fr;
#pragma unroll
                    for (int db = 0; db < 4; ++db) {
                        const int d0 = 64 * h + 16 * db + 4 * fq; const v2u u2 = uu[tb][db]; const f32x4 dv = d[tb][db]; const float bs = bias[tb];
                        v2u w; w.x = pk2(bf_lo(u2.x) * (dv[0] + bs), bf_hi(u2.x) * (dv[1] + bs)); w.y = pk2(bf_lo(u2.y) * (dv[2] + bs), bf_hi(u2.y) * (dv[3] + bs));
                        *(v2u*)(MIX + row * DM + 512 + d0) = w;
                    } }
            }
        }
    }
    __syncthreads();
}

#define GRID_SYNC1() do { XcdBarrier b_ = bar; b_.x = (unsigned)opaque((int)bar.x); xcd_barrier(b_); } while (0)
#ifdef DUP_SYNC
#define GRID_SYNC() do { GRID_SYNC1(); GRID_SYNC1(); } while (0)
#else
#define GRID_SYNC() GRID_SYNC1()
#endif
__global__ void __launch_bounds__(NWAVES * 64, 2) fwd_megakernel(Args a) {
    extern __shared__ __attribute__((aligned(16))) unsigned char lds_raw[];
    LAS unsigned char* lds = (LAS unsigned char*)lds_raw;
    cg::grid_group grid = cg::this_grid();
    const int tid = threadIdx.x, lane = tid & 63, wave = __builtin_amdgcn_readfirstlane(tid >> 6);
    const int G = gridDim.x, bid = blockIdx.x;
    const int vcu = (G % 8 == 0) ? (bid % 8) * (G / 8) + bid / 8 : bid;
    const int gw = vcu * NWAVES + wave, NGW = G * NWAVES;
    if (tid < 64) ((LAS unsigned*)(lds + LDSCTL_OFF))[tid] = 0u;
    __syncthreads();
    const XcdBarrier bar = xcd_barrier_post((unsigned*)(kargs()->ws + WS_BAR), (volatile LAS unsigned*)(lds + LDSCTL_OFF));
    grid.sync();
#define KA (kargs())
#define X (KA->out)
#define SS ((pg8::ss_t*)(KA->ws + WS_SS))
#define XB ((bf16*)(KA->ws + WS_XB))
#define Wb (l == 0 ? (bf16*)(KA->ws + WS_W) : (bf16*)KA->out)
#define Hb ((bf16*)(KA->ws + WS_H))
#define Zb ((bf16*)(KA->ws + WS_Z))
#define MIXb ((bf16*)(KA->ws + WS_MIX))

    { bf16* xb_ = XB; pg8::ss_t* ss_ = SS; const float* xp_ = KA->x_prompt; const float* xs_ = KA->x_sample;
    for (int r0 = gw; r0 < TOK; r0 += 4 * NGW) {
        f32x4 v[4][4];
#pragma unroll
        for (int q = 0; q < 4; ++q) { const int r = r0 + q * NGW; const float* src = r < TOKP ? xp_ + (size_t)r * DM : xs_ + (size_t)(r - TOKP) * DM;
#pragma unroll
            for (int j = 0; j < 4; ++j) v[q][j] = *(const f32x4*)(src + 256 * j + 4 * lane); }
#pragma unroll
        for (int q = 0; q < 4; ++q) { const int r = r0 + q * NGW; float s = 0.f;
#pragma unroll
            for (int j = 0; j < 4; ++j) { const f32x4 x = v[q][j]; v2u w; w.x = pk2(x[0], x[1]); w.y = pk2(x[2], x[3]); *(v2u*)(xb_ + (size_t)r * DM + 256 * j + 4 * lane) = w;
                s += (x[0] * x[0] + x[1] * x[1]) + (x[2] * x[2] + x[3] * x[3]); }
            s = wave_sum(s);
            if (lane == 0) ss_[r] = pg8::ss_fix(s); }
    }
    for (int i = bid * 512 + tid; i < 6 * TOK; i += G * 512) ss_[TOK + i] = 0ull; }
    {
        const float* wsp_ = KA->w_sp; v4u* wsb_ = (v4u*)(KA->ws + WS_WSB);
        for (int e = bid * 512 + tid; e < NLAYER * 8 * 32 * 64; e += G * 512) {
            const int ln = e & 63, f = e >> 6, c = f & 3, tb = (f >> 2) & 7, lh = f >> 5;
            const float* wp = wsp_ + ((size_t)lh * 128 + 16 * tb + (ln & 15)) * 128 + 32 * c + 8 * (ln >> 4);
            const f32x4 w0 = *(const f32x4*)wp, w1 = *(const f32x4*)(wp + 4);
            v4u o; o.x = pk2(w0[0], w0[1]); o.y = pk2(w0[2], w0[3]); o.z = pk2(w1[0], w1[1]); o.w = pk2(w1[2], w1[3]);
            wsb_[e] = o;
        }
    }
    const int l1_cut = (G == 256) ? L1_CUT : 0;
    convert_layer(kargs(), 0, lds, gw, NGW, wave, lane, 0, 1 << 30);
    convert_layer(kargs(), 1, lds, gw, NGW, wave, lane, l1_cut, 1 << 30);
    GRID_SYNC();

    for (int l = 0; l < NLAYER; ++l) {
        #define ssA (SS + (size_t)(3 * l) * TOK)
#define ssB (SS + (size_t)(3 * l + 1) * TOK)
#define ssC (SS + (size_t)(3 * l + 2) * TOK)
#define ssD (SS + (size_t)(3 * l + 3) * TOK)
        if (PH_MASK & 1) { pg8::Gemm g{XB, (const bf16*)((unsigned char*)Wb + W_GU1), TOK, 2 * FF, DM}; pg8::StaticOrder S; S.init(TOK, 2 * FF, G, opaque(bid));
          pg8::EpiSwiglu E{Hb, FF, ssA};
#ifdef DUP_PA
          pg8::gemm_phase<pg8::EpiSwiglu, pg8::StaticOrder, true, true>(lds, g, S, E); __syncthreads();
#endif
          pg8::gemm_phase<pg8::EpiSwiglu, pg8::StaticOrder, true, true>(lds, g, S, E); }
        GRID_SYNC();
        if (PH_MASK & 2) { pg8::Gemm g{Hb, (const bf16*)((unsigned char*)Wb + W_D1), TOK, DM, FF}; pg8::StaticOrder S; S.init(TOK, DM, G, opaque(bid));
          pg8::EpiResid E{XB, ssB, 0.5f};
#ifdef DUP_PB
          { pg8::EpiResid E0{XB, nullptr, 0.0f}; pg8::gemm_phase<pg8::EpiResid, pg8::StaticOrder, true, true>(lds, g, S, E0); __syncthreads(); }
#endif
          pg8::gemm_phase<pg8::EpiResid, pg8::StaticOrder, true, true>(lds, g, S, E); }
        GRID_SYNC();
        if (PH_MASK & 4) { pg8::Gemm g{XB, (const bf16*)((unsigned char*)Wb + W_IN), TOK, NIN, DM}; pg8::StaticOrder S; S.init(TOK, NIN, G, opaque(bid));
          pg8::EpiInProj E{Zb, ssB, KA->vgain + l * 512};
          pg8::gemm_phase<pg8::EpiInProj, pg8::StaticOrder, true, true>(lds, g, S, E); }
        if (l == 0 && G == 256 && bid >= 128) {
          const int t_ = pg8::opaque_v((int)threadIdx.x), w_ = __builtin_amdgcn_readfirstlane(t_ >> 6);
          convert_layer(kargs(), 1, lds, (opaque(bid) - 128) * NWAVES + w_, 128 * NWAVES, w_, t_ & 63, 0, L1_CUT); }
        GRID_SYNC();
#ifdef MIXER_COPY
        if (PH_MASK & 8) { for (size_t i = (size_t)bid * 512 + threadIdx.x; i < (size_t)TOK * 128; i += (size_t)G * 512) { const size_t r = i >> 7, c = i & 127; *(v4u*)(MIXb + r * DM + 8 * c) = *(const v4u*)(Zb + r * NIN + 8 * c); } }
#else
        if (PH_MASK & 8) { const int t_ = pg8::opaque_v((int)threadIdx.x); mixer_phase(kargs(), l, lds, G, opaque(vcu), t_, __builtin_amdgcn_readfirstlane(t_ >> 6), t_ & 63); }
#ifdef DUP_PD
        { const int t_ = pg8::opaque_v((int)threadIdx.x); mixer_phase(kargs(), l, lds, G, opaque(vcu), t_, __builtin_amdgcn_readfirstlane(t_ >> 6), t_ & 63); }
#endif
#endif
        GRID_SYNC();
        if (PH_MASK & 16) { pg8::Gemm g{MIXb, (const bf16*)((unsigned char*)Wb + W_OUT), TOK, DM, DM}; pg8::StaticOrder S; S.init(TOK, DM, G, opaque(bid));
          pg8::EpiResid E{XB, ssC, 1.0f};
#ifdef DUP_PB
          { pg8::EpiResid E0{XB, nullptr, 0.0f}; pg8::gemm_phase<pg8::EpiResid, pg8::StaticOrder, true, true>(lds, g, S, E0); __syncthreads(); }
#endif
          pg8::gemm_phase<pg8::EpiResid, pg8::StaticOrder, true, true>(lds, g, S, E); }
        GRID_SYNC();
        if (PH_MASK & 32) { pg8::Gemm g{XB, (const bf16*)((unsigned char*)Wb + W_GU2), TOK, 2 * FF, DM}; pg8::StaticOrder S; S.init(TOK, 2 * FF, G, opaque(bid));
          pg8::EpiSwiglu E{Hb, FF, ssC};
#ifdef DUP_PA
          pg8::gemm_phase<pg8::EpiSwiglu, pg8::StaticOrder, true, true>(lds, g, S, E); __syncthreads();
#endif
          pg8::gemm_phase<pg8::EpiSwiglu, pg8::StaticOrder, true, true>(lds, g, S, E); }
        GRID_SYNC();
        if (PH_MASK & 64) { pg8::Gemm g{Hb, (const bf16*)((unsigned char*)Wb + W_D2), TOK, DM, FF}; pg8::StaticOrder S; S.init(TOK, DM, G, opaque(bid));
          pg8::EpiResid E{XB, ssD, 0.5f};
#ifdef DUP_PB
          { pg8::EpiResid E0{XB, nullptr, 0.0f}; pg8::gemm_phase<pg8::EpiResid, pg8::StaticOrder, true, true>(lds, g, S, E0); __syncthreads(); }
#endif
          pg8::gemm_phase<pg8::EpiResid, pg8::StaticOrder, true, true>(lds, g, S, E); }
        GRID_SYNC();
    }
    {
        const int t_ = pg8::opaque_v((int)threadIdx.x), lane = t_ & 63, gw = opaque(vcu) * NWAVES + __builtin_amdgcn_readfirstlane(t_ >> 6);
        const pg8::ss_t* ssF = SS + (size_t)6 * TOK; const bf16* xb_ = XB; float* out_ = X;
        f32x4 gn[4];
#pragma unroll
        for (int j = 0; j < 4; ++j) gn[j] = *(const f32x4*)(KA->norm_final + 256 * j + 4 * lane);
        for (int r0 = gw; r0 < TOK; r0 += 4 * NGW) {
            v2u w[4][4]; pg8::ss_t sv[4];
#pragma unroll
            for (int q = 0; q < 4; ++q) { const int r = r0 + q * NGW; sv[q] = ssF[r];
#pragma unroll
                for (int j = 0; j < 4; ++j) w[q][j] = *(const v2u*)(xb_ + (size_t)r * DM + 256 * j + 4 * lane); }
#pragma unroll
            for (int q = 0; q < 4; ++q) { const int r = r0 + q * NGW; const float rs = pg8::rs_of(sv[q]);
#pragma unroll
                for (int j = 0; j < 4; ++j) { const f32x4 v = (f32x4){bf_lo(w[q][j].x), bf_hi(w[q][j].x), bf_lo(w[q][j].y), bf_hi(w[q][j].y)}; *(f32x4*)(out_ + (size_t)r * DM + 256 * j + 4 * lane) = v * rs * gn[j]; } }
        }
    }
}
#undef KA
#undef X
#undef SS
#undef XB
#undef Wb
#undef Hb
#undef Zb
#undef MIXb
#undef ssA
#undef ssB
#undef ssC
#undef ssD

extern "C" void kernel_launch(void* const* d_in, const int* in_sizes, int n_in, void* d_out, int out_size, void* d_ws, size_t ws_size, hipStream_t stream) {
    static int grid = 0;
    if (grid == 0) {
        if (n_in != 18 || out_size != TOK * DM || ws_size < WS_END) { fprintf(stderr, "kernel_launch: unexpected shapes (n_in %d out %d ws %zu, need %zu)\n", n_in, out_size, ws_size, (size_t)WS_END); grid = -1; return; }
        int dev = 0, cus = 0, per_cu = 0;
        if (hipGetDevice(&dev) != hipSuccess || hipDeviceGetAttribute(&cus, hipDeviceAttributeMultiprocessorCount, dev) != hipSuccess) { grid = -1; return; }
        if (hipFuncSetAttribute((const void*)fwd_megakernel, hipFuncAttributeMaxDynamicSharedMemorySize, LDS_BYTES) != hipSuccess) { fprintf(stderr, "kernel_launch: hipFuncSetAttribute failed\n"); grid = -1; return; }
        if (hipOccupancyMaxActiveBlocksPerMultiprocessor(&per_cu, (const void*)fwd_megakernel, NWAVES * 64, LDS_BYTES) != hipSuccess || per_cu < 1) { fprintf(stderr, "kernel_launch: occupancy query says %d\n", per_cu); per_cu = 1; }
        (void)hipGetLastError();
        grid = cus;
    }
    if (grid < 0) return;
    if (hipMemsetAsync((char*)d_ws + WS_BAR, 0, WS_BAR_BYTES, stream) != hipSuccess) { fprintf(stderr, "kernel_launch: memset failed\n"); return; }
    Args a{};
    const float** f = (const float**)&a;
    for (int i = 0; i < 18; ++i) f[i] = (const float*)d_in[i];
    a.out = (float*)d_out; a.ws = (unsigned char*)d_ws;
    void* args[] = {&a};
    hipError_t e = hipLaunchCooperativeKernel((const void*)fwd_megakernel, dim3(grid), dim3(NWAVES * 64), args, LDS_BYTES, stream);
    if (e != hipSuccess) fprintf(stderr, "kernel_launch: cooperative launch failed: %s (grid %d)\n", hipGetErrorString(e), grid);
}
```

```cpp
#include <hip/hip_runtime.h>
#include <hip/hip_cooperative_groups.h>
#include <cstdio>
#include <cstdint>
#include <cmath>
namespace cg = cooperative_groups;
namespace pg8 {
#define PG8_LAS __attribute__((address_space(3)))
typedef unsigned short bf16_t;
typedef short bf16x8 __attribute__((ext_vector_type(8)));
typedef float f32x4 __attribute__((ext_vector_type(4)));
typedef unsigned u32x4 __attribute__((ext_vector_type(4)));
constexpr int BM = 256, BK = 64, HALF = 128, HTB = HALF * BK * 2  , STAGE_BYTES = 8 * HTB, NXCD = 8, WGM = 8;

__host__ __device__ __forceinline__ int lds_byte(int r, int c) { const int st = (r >> 4) * 2 + (c >> 5), rr = r & 15, cc = c & 31, ob = rr * 64 + cc * 2; return st * 1024 + (ob ^ (((ob >> 9) & 1) << 5)); }
__host__ __device__ __forceinline__ void stage_rc(int b, int& R, int& C) { const int st = b / 1024, sb = b % 1024, swz = sb ^ (((sb >> 9) & 1) << 5); R = (st >> 1) * 16 + swz / 64; C = (st & 1) * 32 + (swz % 64) / 2; }
__host__ __device__ __forceinline__ int perm32(int rho) { const int n = rho >> 4, i = rho & 15; return 8 * (i >> 2) + 4 * n + (i & 3); }

struct Unit { int pm, pn; };
struct Gemm { const bf16_t* A; const bf16_t* Bt; int M, N, K; };

struct StaticOrder {
    int nM, nN, nwg, G, c;
    __host__ __device__ void init(int M, int N, int G_, int c_) { nM = M / BM; nN = N / BM; nwg = nM * nN; G = G_; c = c_; }
    __host__ __device__ bool next(int i, Unit& u) const {
        const long L = (long)i * G + c; if (L >= nwg) return false;
        int wgid = (int)L; { const int q = nwg / NXCD, r = nwg % NXCD, xcd = wgid % NXCD, off = wgid / NXCD; wgid = (xcd < r ? xcd * (q + 1) : r * (q + 1) + (xcd - r) * q) + off; }
        const int nig = WGM * nN, gid = wgid / nig, fm = gid * WGM, gsz = (nM - fm) < WGM ? (nM - fm) : WGM;
        u.pm = fm + ((wgid % nig) % gsz); u.pn = (wgid % nig) / gsz; return true;
    }
    __device__ __forceinline__ void a_ready(const Unit&) const {}
    __device__ __forceinline__ void done(const Unit&) const {}
};

__device__ __forceinline__ unsigned cvt_pk_bf16(float lo, float hi) { unsigned r; asm volatile("v_cvt_pk_bf16_f32 %0, %1, %2" : "=v"(r) : "v"(lo), "v"(hi)); return r; }
typedef float f32x2 __attribute__((ext_vector_type(2)));
constexpr float RMS_EPS = 1e-6f;
__device__ __forceinline__ int opaque_v(int v) { asm volatile("" : "+v"(v)); return v; }
constexpr float K_LOG2E = 1.4426950408889634f;
__device__ __forceinline__ float fast_exp2(float x) { return __builtin_amdgcn_exp2f(x); }
__device__ __forceinline__ float fast_rcp(float x) { return __builtin_amdgcn_rcpf(x); }
__device__ __forceinline__ float silu_f(float g) { return g * fast_rcp(1.0f + fast_exp2(-K_LOG2E * g)); }
__device__ __forceinline__ float gelu_tanh_f(float v) { const float t = v * (1.0f + 0.044715f * v * v); return v * fast_rcp(1.0f + fast_exp2(-2.3022081978f * t)); }
typedef unsigned long long ss_t;
constexpr float SS_SCALE = 1048576.0f;
__device__ __forceinline__ ss_t ss_fix(float s) { return (ss_t)(s * SS_SCALE + 0.5f); }
__device__ __forceinline__ float rs_of(ss_t v) { return __builtin_amdgcn_rsqf((float)v * (1.0f / (1024.0f * SS_SCALE)) + RMS_EPS); }
__device__ __forceinline__ float row_rs(const ss_t* ss, int row) { return __builtin_amdgcn_rsqf((float)ss[row] * (1.0f / (1024.0f * SS_SCALE)) + RMS_EPS); }

__device__ __forceinline__ f32x2 swiglu_pk(f32x2 ag, f32x2 au, float rsn, float rs2) {
    const f32x2 t = ag * rsn; f32x2 e; e.x = fast_exp2(t.x); e.y = fast_exp2(t.y);
    const f32x2 den = e + 1.0f; f32x2 r; r.x = fast_rcp(den.x); r.y = fast_rcp(den.y);
    return ((ag * au) * rs2) * r;
}
struct EpiSwiglu {
    static constexpr bool PERM = true, AFTER_DRAIN = false;
    bf16_t* H; int ldh; const ss_t* ss;
    __device__ __forceinline__ void operator()(const f32x4 (&acc)[2][2][4][2], const Unit& u, int wr, int wc, int fr, int fq) const {
        const int row0 = u.pm * BM + wr * 64 + fr, col0 = u.pn * HALF + wc * 32 + 8 * fq;
        ss_t sv[2][4];
#pragma unroll
        for (int ai = 0; ai < 2; ++ai)
#pragma unroll
            for (int m = 0; m < 4; ++m) sv[ai][m] = ss[row0 + ai * HALF + m * 16];
#pragma unroll
        for (int ai = 0; ai < 2; ++ai)
#pragma unroll
            for (int m = 0; m < 4; ++m) {
                const int row = row0 + ai * HALF + m * 16; const float rs = rs_of(sv[ai][m]), rsn = -K_LOG2E * rs, rs2 = rs * rs;
                const f32x4 ag0 = acc[ai][0][m][0], ag1 = acc[ai][0][m][1], au0 = acc[ai][1][m][0], au1 = acc[ai][1][m][1];
                const f32x2 h0 = swiglu_pk((f32x2){ag0[0], ag0[1]}, (f32x2){au0[0], au0[1]}, rsn, rs2), h1 = swiglu_pk((f32x2){ag0[2], ag0[3]}, (f32x2){au0[2], au0[3]}, rsn, rs2);
                const f32x2 h2 = swiglu_pk((f32x2){ag1[0], ag1[1]}, (f32x2){au1[0], au1[1]}, rsn, rs2), h3 = swiglu_pk((f32x2){ag1[2], ag1[3]}, (f32x2){au1[2], au1[3]}, rsn, rs2);
                u32x4 w; w.x = cvt_pk_bf16(h0.x, h0.y); w.y = cvt_pk_bf16(h1.x, h1.y); w.z = cvt_pk_bf16(h2.x, h2.y); w.w = cvt_pk_bf16(h3.x, h3.y);
                *(u32x4*)(H + (size_t)row * ldh + col0) = w;
                asm volatile("" ::: "memory");
            }
    }
};
__device__ __forceinline__ float bfl(unsigned w) { return __builtin_bit_cast(float, w << 16); }
__device__ __forceinline__ float bfh(unsigned w) { return __builtin_bit_cast(float, w & 0xffff0000u); }
struct EpiResid {
    static constexpr bool PERM = true, AFTER_DRAIN = false;
    bf16_t* XB; ss_t* ssn; float scale;
    __device__ __forceinline__ void operator()(const f32x4 (&acc)[2][2][4][2], const Unit& u, int wr, int wc, int fr, int fq) const {
        const int row0 = u.pm * BM + wr * 64 + fr, col0 = u.pn * BM + wc * 32 + 8 * fq;
#pragma unroll
        for (int ai = 0; ai < 2; ++ai) {
            u32x4 xw[4][2];
#pragma unroll
            for (int m = 0; m < 4; ++m)
#pragma unroll
                for (int bj = 0; bj < 2; ++bj) xw[m][bj] = *(const u32x4*)(XB + (size_t)(row0 + ai * HALF + m * 16) * 1024 + col0 + bj * HALF);
#pragma unroll
            for (int m = 0; m < 4; ++m) {
                const int row = row0 + ai * HALF + m * 16; float s = 0.f;
#pragma unroll
                for (int bj = 0; bj < 2; ++bj) {
                    bf16_t* xp = XB + (size_t)row * 1024 + col0 + bj * HALF;
                    const u32x4 w0 = xw[m][bj];
                    f32x4 x0 = (f32x4){bfl(w0.x), bfh(w0.x), bfl(w0.y), bfh(w0.y)}, x1 = (f32x4){bfl(w0.z), bfh(w0.z), bfl(w0.w), bfh(w0.w)};
                    x0 = x0 + acc[ai][bj][m][0] * scale; x1 = x1 + acc[ai][bj][m][1] * scale;
                    s += (x0[0] * x0[0] + x0[1] * x0[1]) + (x0[2] * x0[2] + x0[3] * x0[3]) + (x1[0] * x1[0] + x1[1] * x1[1]) + (x1[2] * x1[2] + x1[3] * x1[3]);
                    u32x4 w; w.x = cvt_pk_bf16(x0[0], x0[1]); w.y = cvt_pk_bf16(x0[2], x0[3]); w.z = cvt_pk_bf16(x1[0], x1[1]); w.w = cvt_pk_bf16(x1[2], x1[3]);
                    *(u32x4*)xp = w;
                }
                s += __shfl_xor(s, 16); s += __shfl_xor(s, 32);
                if (fq == 0 && ssn) atomicAdd(ssn + row, ss_fix(s));
            }
            asm volatile("" ::: "memory");
        }
    }
};
struct EpiInProj {
    static constexpr bool PERM = true, AFTER_DRAIN = false;
    bf16_t* Z; const ss_t* ss; const float* vgain;
    __device__ __forceinline__ void operator()(const f32x4 (&acc)[2][2][4][2], const Unit& u, int wr, int wc, int fr, int fq) const {
        const int row0 = u.pm * BM + wr * 64 + fr, pn = u.pn;
        const int mode = pn < 2 ? 0 : (pn == 2 ? 1 : (pn < 5 ? 2 : 3));
        int colb[2]; f32x4 gv[2][2];
#pragma unroll
        for (int bj = 0; bj < 2; ++bj) {
            colb[bj] = mode == 3 ? 1280 + 64 * (4 * (pn - 5) + wc) + 32 * bj + 8 * fq : 256 * pn + 128 * bj + 32 * wc + 8 * fq;
#pragma unroll
            for (int n = 0; n < 2; ++n) gv[bj][n] = mode == 3 ? *(const f32x4*)(vgain + (colb[bj] - 1280) + 4 * n) : (f32x4){1.f, 1.f, 1.f, 1.f};
        }
        ss_t sv[2][4];
#pragma unroll
        for (int ai = 0; ai < 2; ++ai)
#pragma unroll
            for (int m = 0; m < 4; ++m) sv[ai][m] = ss[row0 + ai * HALF + m * 16];
#pragma unroll
        for (int ai = 0; ai < 2; ++ai)
#pragma unroll
            for (int m = 0; m < 4; ++m) {
                const int row = row0 + ai * HALF + m * 16; const float rs = rs_of(sv[ai][m]);
                f32x4 v[2][2];
#pragma unroll
                for (int bj = 0; bj < 2; ++bj)
#pragma unroll
                    for (int n = 0; n < 2; ++n) v[bj][n] = acc[ai][bj][m][n] * rs;
                if (mode == 0) {
#pragma unroll
                    for (int bj = 0; bj < 2; ++bj)
#pragma unroll
                        for (int n = 0; n < 2; ++n) v[bj][n] = v[bj][n] * (0.125f * K_LOG2E);
                } else if (mode >= 2) {
#pragma unroll
                    for (int bj = 0; bj < 2; ++bj)
#pragma unroll
                        for (int n = 0; n < 2; ++n)
#pragma unroll
                            for (int e = 0; e < 4; ++e) v[bj][n][e] = gelu_tanh_f(v[bj][n][e]);
                    if (mode == 3) {
                        float q = 0.f;
#pragma unroll
                        for (int bj = 0; bj < 2; ++bj)
#pragma unroll
                            for (int n = 0; n < 2; ++n) q += (v[bj][n][0] * v[bj][n][0] + v[bj][n][1] * v[bj][n][1]) + (v[bj][n][2] * v[bj][n][2] + v[bj][n][3] * v[bj][n][3]);
                        q += __shfl_xor(q, 16); q += __shfl_xor(q, 32);
                        const float r2 = __builtin_amdgcn_rsqf(q * (1.0f / 64.0f) + RMS_EPS);
#pragma unroll
                        for (int bj = 0; bj < 2; ++bj)
#pragma unroll
                            for (int n = 0; n < 2; ++n) v[bj][n] = v[bj][n] * r2 * gv[bj][n];
                    }
                }
#pragma unroll
                for (int bj = 0; bj < 2; ++bj) {
                    u32x4 w; w.x = cvt_pk_bf16(v[bj][0][0], v[bj][0][1]); w.y = cvt_pk_bf16(v[bj][0][2], v[bj][0][3]); w.z = cvt_pk_bf16(v[bj][1][0], v[bj][1][1]); w.w = cvt_pk_bf16(v[bj][1][2], v[bj][1][3]);
                    *(u32x4*)(Z + (size_t)row * 1792 + colb[bj]) = w;
                }
                asm volatile("" ::: "memory");
            }
    }
};

template <class Epi, class Sched, bool ALIGN_EPI = false, bool SP2 = false>
__device__ __forceinline__ void gemm_phase(PG8_LAS unsigned char* lds, const Gemm g, const Sched& S, const Epi& E) {
    const int tid = opaque_v((int)threadIdx.x), wid = __builtin_amdgcn_readfirstlane(tid >> 6), lane = tid & 63, wr = wid >> 2, wc = wid & 3, fr = lane & 15, fq = lane >> 4;
    const int K = g.K, nt = K / BK;
    unsigned voffA[2], voffB[2];
#pragma unroll
    for (int i = 0; i < 2; ++i) { int R, C; stage_rc(tid * 16 + i * 8192, R, C); const int Rb = Epi::PERM ? ((R & ~31) + perm32(R & 31)) : R;
        voffA[i] = (unsigned)(R * K + C) * 2u; voffB[i] = (unsigned)(Rb * K + C) * 2u; }
    const size_t kstep = (size_t)(BK * 2);
    const size_t hstep = (size_t)HALF * K * 2;
    const size_t tstep = 2 * hstep;
    const unsigned ldsw = (unsigned)wid * 1024u;
    const int aoff = lds_byte(wr * 64 + fr, fq * 8), boff = lds_byte(wc * 32 + fr, fq * 8);
#define PG8_SA(b, h) (((b) * 2 + (h)) * HTB)
#define PG8_SB(b, h) ((4 + (b) * 2 + (h)) * HTB)
#define PG8_STAGE(bufoff, gbase, voff) do { _Pragma("unroll") for (int _i = 0; _i < 2; ++_i) \
        __builtin_amdgcn_global_load_lds((const unsigned*)((const char*)(gbase) + (voff)[_i]), (PG8_LAS unsigned*)(lds + (bufoff) + ldsw + _i * 8192), 16, 0, 0); } while (0)
#define PG8_LDA(dst, b, h) do { _Pragma("unroll") for (int m = 0; m < 4; ++m) _Pragma("unroll") for (int k = 0; k < 2; ++k) dst[m][k] = *(const PG8_LAS bf16x8*)(lds + PG8_SA(b, h) + aoff + m * 2048 + k * 1024); } while (0)
#define PG8_LDB(dst, b, h) do { _Pragma("unroll") for (int n = 0; n < 2; ++n) _Pragma("unroll") for (int k = 0; k < 2; ++k) dst[n][k] = *(const PG8_LAS bf16x8*)(lds + PG8_SB(b, h) + boff + n * 2048 + k * 1024); } while (0)
#define PG8_MMA(ai, bj, At, Bt) do { __builtin_amdgcn_s_setprio(1); _Pragma("unroll") for (int m = 0; m < 4; ++m) _Pragma("unroll") for (int n = 0; n < 2; ++n) _Pragma("unroll") for (int k = 0; k < 2; ++k) \
        acc[ai][bj][m][n] = __builtin_amdgcn_mfma_f32_16x16x32_bf16(Bt[n][k], At[m][k], acc[ai][bj][m][n], 0, 0, 0); __builtin_amdgcn_s_setprio(0); } while (0)
#define PG8_WAIT_V(n) asm volatile("s_waitcnt vmcnt(" #n ")" ::: "memory")
#define PG8_WAIT_L(n) asm volatile("s_waitcnt lgkmcnt(" #n ")" ::: "memory")
#define PG8_BAR __builtin_amdgcn_s_barrier()
#define PG8_SCHED __builtin_amdgcn_sched_barrier(0)
    Unit cur, nxt; int ui = 0;
    if (!S.next(0, cur)) return;
    f32x4 acc[2][2][4][2];
#pragma unroll
    for (int a = 0; a < 2; ++a)
#pragma unroll
        for (int b = 0; b < 2; ++b)
#pragma unroll
            for (int m = 0; m < 4; ++m)
#pragma unroll
                for (int n = 0; n < 2; ++n) acc[a][b][m][n] = (f32x4){0.f, 0.f, 0.f, 0.f};
    bf16x8 At[4][2], B0[2][2], B1[2][2];
    const char* cA = (const char*)g.A + (size_t)cur.pm * tstep; const char* cB = (const char*)g.Bt + (size_t)cur.pn * tstep;
    S.a_ready(cur);
    if constexpr (SP2) {
        PG8_STAGE(PG8_SB(0, 0), cB, voffB); PG8_STAGE(PG8_SB(0, 1), cB + hstep, voffB); PG8_STAGE(PG8_SA(0, 0), cA, voffA); PG8_STAGE(PG8_SA(0, 1), cA + hstep, voffA);
        if (wr == 1) PG8_BAR;
        PG8_WAIT_V(2); PG8_BAR;
        PG8_STAGE(PG8_SB(1, 0), cB + kstep, voffB); PG8_STAGE(PG8_SA(1, 0), cA + kstep, voffA); PG8_STAGE(PG8_SB(1, 1), cB + hstep + kstep, voffB);
        PG8_WAIT_V(6); PG8_BAR;
    } else {
        PG8_STAGE(PG8_SB(0, 0), cB, voffB); PG8_STAGE(PG8_SA(0, 0), cA, voffA); PG8_STAGE(PG8_SB(0, 1), cB + hstep, voffB); PG8_STAGE(PG8_SA(0, 1), cA + hstep, voffA);
        if (wr == 1) PG8_BAR;
        PG8_WAIT_V(4); PG8_BAR;
        PG8_STAGE(PG8_SB(1, 0), cB + kstep, voffB); PG8_STAGE(PG8_SA(1, 0), cA + kstep, voffA); PG8_STAGE(PG8_SB(1, 1), cB + hstep + kstep, voffB);
        PG8_WAIT_V(6); PG8_BAR;
    }
    for (;;) {
        const bool has_next = S.next(ui + 1, nxt);
        const char* nA = has_next ? (const char*)g.A + (size_t)nxt.pm * tstep : cA; const char* nB = has_next ? (const char*)g.Bt + (size_t)nxt.pn * tstep : cB;
        for (int t = 0; t < nt; t += 2) {
            const bool last = (t == nt - 2);
            const char* a1 = cA + (size_t)(t + 1) * kstep;
            const char* a2 = last ? nA : cA + (size_t)(t + 2) * kstep; const char* b2 = last ? nB : cB + (size_t)(t + 2) * kstep;
            const char* a3 = a2 + kstep; const char* b3 = b2 + kstep;
            if (last && has_next) S.a_ready(nxt);
            if constexpr (SP2) {
            PG8_LDB(B0, 0, 0); PG8_LDB(B1, 0, 1); PG8_SCHED; PG8_LDA(At, 0, 0); PG8_STAGE(PG8_SA(1, 1), a1 + hstep, voffA);
            PG8_WAIT_V(8); PG8_WAIT_L(0); PG8_BAR; PG8_MMA(0, 0, At, B0); PG8_MMA(0, 1, At, B1); PG8_BAR; PG8_SCHED;
            PG8_LDA(At, 0, 1); PG8_STAGE(PG8_SB(0, 0), b2, voffB); PG8_STAGE(PG8_SB(0, 1), b2 + hstep, voffB); PG8_STAGE(PG8_SA(0, 0), a2, voffA);
            PG8_WAIT_V(8); PG8_WAIT_L(0); PG8_BAR; PG8_MMA(1, 0, At, B0); PG8_MMA(1, 1, At, B1); PG8_BAR; PG8_SCHED;
            PG8_LDB(B0, 1, 0); PG8_LDB(B1, 1, 1); PG8_SCHED; PG8_LDA(At, 1, 0); PG8_STAGE(PG8_SA(0, 1), a2 + hstep, voffA);
            PG8_WAIT_V(8); PG8_WAIT_L(0); PG8_BAR; PG8_MMA(0, 0, At, B0); PG8_MMA(0, 1, At, B1); PG8_BAR; PG8_SCHED;
            PG8_LDA(At, 1, 1); PG8_STAGE(PG8_SB(1, 0), b3, voffB); PG8_STAGE(PG8_SB(1, 1), b3 + hstep, voffB); PG8_STAGE(PG8_SA(1, 0), a3, voffA);
            PG8_WAIT_V(8); PG8_WAIT_L(0); PG8_BAR; PG8_MMA(1, 0, At, B0); PG8_MMA(1, 1, At, B1); PG8_BAR; PG8_SCHED;
            } else {
            PG8_LDB(B0, 0, 0); PG8_SCHED; PG8_LDA(At, 0, 0); PG8_STAGE(PG8_SA(1, 1), a1 + hstep, voffA);
            PG8_WAIT_L(8); PG8_BAR; PG8_WAIT_L(0); PG8_MMA(0, 0, At, B0); PG8_BAR; PG8_SCHED;
            PG8_LDB(B1, 0, 1); PG8_STAGE(PG8_SB(0, 0), b2, voffB);
            PG8_BAR; PG8_WAIT_L(0); PG8_MMA(0, 1, At, B1); PG8_BAR;
            PG8_LDA(At, 0, 1); PG8_STAGE(PG8_SA(0, 0), a2, voffA);
            PG8_BAR; PG8_WAIT_L(0); PG8_MMA(1, 0, At, B0); PG8_BAR; PG8_SCHED;
            PG8_STAGE(PG8_SB(0, 1), b2 + hstep, voffB);
            PG8_WAIT_V(6); PG8_BAR; PG8_MMA(1, 1, At, B1); PG8_BAR;
            PG8_LDB(B0, 1, 0); PG8_SCHED; PG8_LDA(At, 1, 0); PG8_STAGE(PG8_SA(0, 1), a2 + hstep, voffA);
            PG8_WAIT_L(8); PG8_BAR; PG8_WAIT_L(0); PG8_MMA(0, 0, At, B0); PG8_BAR; PG8_SCHED;
            PG8_LDB(B1, 1, 1); PG8_STAGE(PG8_SB(1, 0), b3, voffB);
            PG8_BAR; PG8_WAIT_L(0); PG8_MMA(0, 1, At, B1); PG8_BAR;
            PG8_LDA(At, 1, 1); PG8_STAGE(PG8_SA(1, 0), a3, voffA);
            PG8_BAR; PG8_WAIT_L(0); PG8_MMA(1, 0, At, B0); PG8_BAR; PG8_SCHED;
            PG8_STAGE(PG8_SB(1, 1), b3 + hstep, voffB);
            PG8_WAIT_V(6); PG8_BAR; PG8_MMA(1, 1, At, B1); PG8_BAR;
            }
        }
        if constexpr (ALIGN_EPI) { if (wr == 0) PG8_BAR; }
        if constexpr (!Epi::AFTER_DRAIN) { E(acc, cur, wr, wc, fr, fq); S.done(cur); }
        if (!has_next) break;
#pragma unroll
        for (int a = 0; a < 2; ++a)
#pragma unroll
            for (int b = 0; b < 2; ++b)
#pragma unroll
                for (int m = 0; m < 4; ++m)
#pragma unroll
                    for (int n = 0; n < 2; ++n) acc[a][b][m][n] = (f32x4){0.f, 0.f, 0.f, 0.f};
        cur = nxt; cA = nA; cB = nB; ++ui;
        if constexpr (ALIGN_EPI) { if (wr == 1) PG8_BAR; }
    }
    PG8_WAIT_V(0);
    if constexpr (!ALIGN_EPI) { if (wr == 0) PG8_BAR; }
    PG8_BAR;
    if constexpr (Epi::AFTER_DRAIN) { E.fused(acc, cur, wr, wc, fr, fq, lds, wid, lane); S.done(cur); }
#undef PG8_SA
#undef PG8_SB
#undef PG8_STAGE
#undef PG8_LDA
#undef PG8_LDB
#undef PG8_MMA
#undef PG8_WAIT_V
#undef PG8_WAIT_L
#undef PG8_BAR
#undef PG8_SCHED
}
}

#ifndef PH_MASK
#define PH_MASK 127
#endif
#ifndef N_LAYER
#define N_LAYER 2
#endif
constexpr int NWAVES = 8;
#ifndef L1_CUT
#define L1_CUT 7168
#endif
constexpr int TOK = 32768, TOKP = 16384, DM = 1024, FF = 2816, NIN = 1792, NLAYER = N_LAYER, NBLK = TOK / 128;
constexpr size_t WS_SS = 0;
constexpr size_t WS_W = 2u << 20;
constexpr size_t W_GU1 = 0, W_D1 = W_GU1 + (size_t)2 * FF * DM * 2, W_IN = W_D1 + (size_t)DM * FF * 2, W_OUT = W_IN + (size_t)NIN * DM * 2,
                 W_GU2 = W_OUT + (size_t)DM * DM * 2, W_D2 = W_GU2 + (size_t)2 * FF * DM * 2, W_BYTES = W_D2 + (size_t)DM * FF * 2;
constexpr size_t WS_XB = WS_W + W_BYTES;
constexpr size_t WS_R1 = WS_XB + (size_t)TOK * DM * 2;
constexpr size_t WS_Z = WS_R1, WS_MIX = WS_R1 + (size_t)TOK * NIN * 2, WS_H = WS_R1;
constexpr size_t WS_WSB = WS_R1 + (size_t)TOK * FF * 2;
constexpr size_t WS_END = WS_WSB + (size_t)NLAYER * 8 * 128 * 128 * 2;
static_assert(WS_MIX + (size_t)TOK * DM * 2 == WS_WSB && WS_XB % 256 == 0 && WS_R1 % 256 == 0, "d_ws map");
constexpr int LDSCTL_OFF = 147456 - 256;
constexpr size_t WS_BAR = 0x1D0000, WS_BAR_BYTES = 16384;
constexpr int LDS_BYTES = 147456;

#define LAS __attribute__((address_space(3)))
typedef unsigned short bf16;
typedef unsigned v4u __attribute__((ext_vector_type(4)));
typedef unsigned v2u __attribute__((ext_vector_type(2)));
typedef float f32x4 __attribute__((ext_vector_type(4)));
typedef short bf16x8 __attribute__((ext_vector_type(8)));
typedef short s16x4 __attribute__((ext_vector_type(4)));
typedef short v4i16_t __attribute__((ext_vector_type(4)));
#define LDS_WAIT() asm volatile("s_waitcnt lgkmcnt(0)" ::: "memory")
typedef float f32x2_t __attribute__((ext_vector_type(2)));
typedef __bf16 bf16x2_t __attribute__((ext_vector_type(2)));
__device__ __forceinline__ unsigned pk2(float lo, float hi) { f32x2_t v = {lo, hi}; bf16x2_t b = __builtin_convertvector(v, bf16x2_t); return __builtin_bit_cast(unsigned, b); }
__device__ __forceinline__ float bf_lo(unsigned w) { return __builtin_bit_cast(float, w << 16); }
__device__ __forceinline__ float bf_hi(unsigned w) { return __builtin_bit_cast(float, w & 0xffff0000u); }
__device__ __forceinline__ s16x4 vtr(const LAS unsigned char* p) { return __builtin_bit_cast(s16x4, __builtin_amdgcn_ds_read_tr16_b64_v4i16((LAS v4i16_t*)p)); }
__device__ __forceinline__ int opaque(int v) { asm volatile("" : "+s"(v)); return v; }
__device__ __forceinline__ float wave_sum(float v) {
#pragma unroll
    for (int o = 1; o < 64; o <<= 1) v += __shfl_xor(v, o);
    return v;
}

#define XB_TMO      128
#define XB_XCNT(j)  (256  + 64 * (j))
#define XB_XSUB(j)  (1280 + 64 * (j))
#define XB_XGEN(j)  (2304 + 64 * (j))
#define XB_TOP      3328
#define XB_TOPGEN   3392
#define XCD_BAR_WORDS 3456
#define XB_SPIN_CAP (1u << 18)

__device__ __forceinline__ unsigned xb_ld(unsigned* p)              { return __hip_atomic_load(p, __ATOMIC_RELAXED, __HIP_MEMORY_SCOPE_AGENT); }
__device__ __forceinline__ unsigned xb_add(unsigned* p, unsigned v) { return __hip_atomic_fetch_add(p, v, __ATOMIC_RELAXED, __HIP_MEMORY_SCOPE_AGENT); }
__device__ __forceinline__ unsigned xb_xcc_id() { return (unsigned)__builtin_amdgcn_s_getreg((3 << 11) | 20) & 0xFu; }
#define XB_SPIN(cond, bar) do { unsigned _sp = 0; while (cond) { __builtin_amdgcn_s_sleep(1); \
    if ((++_sp & 255u) == 0u) { if (xb_ld(&(bar)[XB_TMO])) break; if (_sp > XB_SPIN_CAP) { atomicAdd(&(bar)[XB_TMO], 1u); break; } } } } while (0)

struct XcdBarrier {
    unsigned* bar; unsigned x;
    volatile LAS unsigned* st;
};

__device__ __forceinline__ XcdBarrier xcd_barrier_post(unsigned* bar, volatile LAS unsigned* st) {
    XcdBarrier b; b.bar = bar; b.x = xb_xcc_id(); b.st = st;
    if (threadIdx.x == 0) (void)xb_add(&bar[XB_XCNT(b.x)], 1u);
    return b;
}
__device__ __forceinline__ void xcd_barrier_complete(unsigned* bar, unsigned x, unsigned& nloc, unsigned& nx) {
    const unsigned G = gridDim.x * gridDim.y * gridDim.z;
    unsigned sum, cnt, mine, sp = 0u;
    for (;;) {
        sum = 0u; cnt = 0u; mine = 0u;
#pragma unroll
        for (unsigned j = 0; j < 16; ++j) { const unsigned c = xb_ld(&bar[XB_XCNT(j)]); sum += c; cnt += (c > 0u) ? 1u : 0u; mine = (j == x) ? c : mine; }
        if (sum == G) break;
        __builtin_amdgcn_s_sleep(1);
        if ((++sp & 255u) == 0u) { if (xb_ld(&bar[XB_TMO])) break; if (sp > XB_SPIN_CAP) { atomicAdd(&bar[XB_TMO], 1u); break; } }
    }
    nloc = mine > 0u ? mine : 1u; nx = cnt > 0u ? cnt : 1u;
}

__device__ __forceinline__ void xcd_barrier(const XcdBarrier& b) {
    asm volatile("s_waitcnt vmcnt(0)" ::: "memory");
    __syncthreads();
    if (threadIdx.x == 0) {
        unsigned* bar = b.bar;
        __builtin_amdgcn_s_waitcnt(0);
        unsigned nloc = b.st[0], nx = b.st[1];
        if (nloc == 0u) { xcd_barrier_complete(bar, b.x, nloc, nx); b.st[0] = nloc; b.st[1] = nx; }
        const unsigned old = xb_add(&bar[XB_XSUB(b.x)], 1u);
        const unsigned gen = old / nloc;
        if (old + 1u == (gen + 1u) * nloc) {
            __builtin_amdgcn_fence(__ATOMIC_RELEASE, "agent");
            asm volatile("s_waitcnt vmcnt(0)" ::: "memory");
            const unsigned og = xb_add(&bar[XB_TOP], 1u);
            const unsigned tg = og / nx;
            if (og + 1u == (tg + 1u) * nx) xb_add(&bar[XB_TOPGEN], 1u);
            else XB_SPIN(xb_ld(&bar[XB_TOPGEN]) == tg, bar);
            __builtin_amdgcn_fence(__ATOMIC_ACQUIRE, "agent");
            xb_add(&bar[XB_XGEN(b.x)], 1u);
            asm volatile("s_waitcnt vmcnt(0)" ::: "memory");
        } else {
            XB_SPIN(xb_ld(&bar[XB_XGEN(b.x)]) == gen, bar);
            __builtin_amdgcn_fence(__ATOMIC_ACQUIRE, "agent");
            asm volatile("s_waitcnt vmcnt(0)" ::: "memory");
        }
    }
    __syncthreads();
}

struct Args {
    const float *x_prompt, *x_sample, *norm_ffn1, *w1_gate, *w1_up, *w1_down, *norm_mix, *w_in, *sink, *vgain, *w_sp, *b_sp, *w_out, *norm_ffn2, *w2_gate, *w2_up, *w2_down, *norm_final;
    float* out; unsigned char* ws;
};

typedef const __attribute__((address_space(4))) Args* KArgs;
__device__ __forceinline__ KArgs kargs() { const __attribute__((address_space(4))) void* p = (const __attribute__((address_space(4))) void*)__builtin_amdgcn_kernarg_segment_ptr(); asm volatile("" : "+s"(p)); return (KArgs)p; }
__device__ __forceinline__ void conv_item(const float* W, int ldn, int K, const float* gain, bf16* WT, int dst_row0, int src_col0, int k0, LAS float* scr, int lane) {
    f32x4 v[8]; float g[8];
#pragma unroll
    for (int i = 0; i < 8; ++i) { const int kk = 8 * i + (lane >> 3); v[i] = *(const f32x4*)(W + (size_t)(k0 + kk) * ldn + src_col0 + 4 * (lane & 7)); g[i] = gain ? gain[k0 + kk] : 1.0f; }
#pragma unroll
    for (int i = 0; i < 8; ++i) { const int kk = 8 * i + (lane >> 3); LAS float* s = scr + kk * 33 + 4 * (lane & 7); s[0] = v[i][0] * g[i]; s[1] = v[i][1] * g[i]; s[2] = v[i][2] * g[i]; s[3] = v[i][3] * g[i]; }
    LDS_WAIT(); asm volatile("" ::: "memory");
    const int c = lane & 7;
#pragma unroll
    for (int j = 0; j < 4; ++j) { const int n = (lane >> 3) + 8 * j; const LAS float* s = scr + (8 * c) * 33 + n;
        v4u o; o.x = pk2(s[0 * 33], s[1 * 33]); o.y = pk2(s[2 * 33], s[3 * 33]); o.z = pk2(s[4 * 33], s[5 * 33]); o.w = pk2(s[6 * 33], s[7 * 33]);
        *(v4u*)(WT + (size_t)(dst_row0 + n) * K + k0 + 8 * c) = o; }
    LDS_WAIT(); asm volatile("" ::: "memory");
}
__device__ __forceinline__ void convert_layer(KArgs a, int l, LAS unsigned char* lds, int gw, int NGW, int wave, int lane, int it_lo, int it_hi) {
    LAS float* scr = (LAS float*)(lds + wave * 16384);
    bf16* Wb = l == 0 ? (bf16*)(a->ws + WS_W) : (bf16*)a->out;
    constexpr int I_GU = (2 * FF / 32) * (DM / 64), I_D = (DM / 32) * (FF / 64), I_IN = (NIN / 32) * (DM / 64), I_OUT = (DM / 32) * (DM / 64);
    constexpr int NITEMS = 2 * I_GU + 2 * I_D + I_IN + I_OUT;
    const int it_end = it_hi < NITEMS ? it_hi : NITEMS;
    for (int it = it_lo + gw; it < it_end; it += NGW) {
        int r = it; const float* src; const float* gain = nullptr; int ldn, K, nblk; size_t dsto; int kind;
        const float *gsrc = nullptr, *usrc = nullptr;
        if (r < I_GU) { kind = 1; gsrc = a->w1_gate + (size_t)l * DM * FF; usrc = a->w1_up + (size_t)l * DM * FF; gain = a->norm_ffn1 + l * DM; ldn = FF; K = DM; nblk = 2 * FF / 32; dsto = W_GU1; }
        else if ((r -= I_GU) < I_D) { kind = 0; gsrc = a->w1_down + (size_t)l * DM * FF; ldn = DM; K = FF; nblk = DM / 32; dsto = W_D1; }
        else if ((r -= I_D) < I_IN) { kind = 2; gsrc = a->w_in + (size_t)l * DM * NIN; gain = a->norm_mix + l * DM; ldn = NIN; K = DM; nblk = NIN / 32; dsto = W_IN; }
        else if ((r -= I_IN) < I_OUT) { kind = 0; gsrc = a->w_out + (size_t)l * DM * DM; ldn = DM; K = DM; nblk = DM / 32; dsto = W_OUT; }
        else if ((r -= I_OUT) < I_GU) { kind = 1; gsrc = a->w2_gate + (size_t)l * DM * FF; usrc = a->w2_up + (size_t)l * DM * FF; gain = a->norm_ffn2 + l * DM; ldn = FF; K = DM; nblk = 2 * FF / 32; dsto = W_GU2; }
        else { r -= I_GU; kind = 0; gsrc = a->w2_down + (size_t)l * DM * FF; ldn = DM; K = FF; nblk = DM / 32; dsto = W_D2; }
        const int kb = r / nblk, nb = r % nblk; int sc0 = 32 * nb; src = gsrc;
        if (kind == 1) { const int pn = nb >> 3, lb = nb & 7; src = lb < 4 ? gsrc : usrc; sc0 = 128 * pn + 32 * (lb & 3); }
        else if (kind == 2 && nb >= 40) { const int t = nb - 40, pnl = t >> 3, lb = t & 7, bj = lb >> 2, wc = lb & 3; sc0 = 1280 + 64 * (4 * pnl + wc) + 32 * bj; }
        conv_item(src, ldn, K, gain, (bf16*)((unsigned char*)Wb + dsto), 32 * nb, sc0, 64 * kb, scr, lane);
    }
}

constexpr int KS_STRIDE = 144;
constexpr int KS_BYTES = 384 * KS_STRIDE;
constexpr int TAB_OFF = 2 * KS_BYTES, TAB_N = 388, TAB_ZERO = 196;
static_assert(TAB_OFF + 4 * 4 * TAB_N * 4 <= LDSCTL_OFF, "LDS map");
constexpr float DEFER_THR = 10.0f;
constexpr int GS_STRIDE = 1040;
static_assert(128 * GS_STRIDE <= LDSCTL_OFF, "LDS map");
__device__ __forceinline__ void mixer_phase(KArgs a, int l, LAS unsigned char* lds, int G, int bid, int tid, int wave, int lane) {
    const bf16* Z = (const bf16*)(a->ws + WS_Z); bf16* MIX = (bf16*)(a->ws + WS_MIX);
    const int fr = lane & 15, fq = lane >> 4, tq = fr >> 2, tp = fr & 3;
    LAS unsigned char* Ks = lds; LAS unsigned char* Vs = lds + KS_BYTES; LAS unsigned char* Gs = lds;
#pragma unroll 1
    for (int blk = bid; blk < NBLK; blk += G) {
        const int sb = blk < 128 ? (blk & ~63) : (blk & ~15), se = sb + (blk < 128 ? 64 : 16);
        const bool has_prev = blk > sb, has_next = blk + 1 < se;
#ifndef MIX_NO_ATT
#ifndef REP_ATT
#define REP_ATT 1
#endif
#pragma unroll 1
        for (int kvh2 = 0; kvh2 < 2 * REP_ATT; ++kvh2) { const int kvh = kvh2 & 1;
            __syncthreads();
#pragma unroll
            for (int i = 0; i < 6; ++i) {
                const int id = tid + 512 * i, kj = id >> 3, c = id & 7, kb = kj >> 7;
                const bool ok = kb == 1 || (kb == 0 ? has_prev : has_next);
                v4u kv = (v4u){0u, 0u, 0u, 0u}, vv = (v4u){0u, 0u, 0u, 0u};
                if (ok) { const bf16* zr = Z + (size_t)(128 * (blk - 1) + kj) * NIN + 64 * kvh + 8 * c; kv = *(const v4u*)(zr + 512); vv = *(const v4u*)(zr + 640); }
                *(LAS v4u*)(Ks + kj * KS_STRIDE + c * 16) = kv; *(LAS v4u*)(Vs + kj * KS_STRIDE + c * 16) = vv;
            }
            for (int e = tid; e < 4 * 4 * TAB_N; e += 512) {
                const int hd = e / (4 * TAB_N), k = (e / TAB_N) & 3, i = e % TAB_N, rel = i + k - TAB_ZERO, ad = rel < 0 ? -rel : rel;
                const float sl = __builtin_amdgcn_exp2f(-(float)(kvh * 4 + hd + 1)) * pg8::K_LOG2E;
                ((LAS float*)(lds + TAB_OFF))[e] = ad <= 128 ? -sl * (float)ad : -INFINITY;
            }
            __syncthreads();
            {
                const int hq = kvh * 4 + (wave >> 1), half = wave & 1;
                const float sinkl = a->sink[l * 8 + hq] * pg8::K_LOG2E;
                bf16x8 qf[4][2];
#pragma unroll
                for (int qg = 0; qg < 4; ++qg)
#pragma unroll
                    for (int dk = 0; dk < 2; ++dk) qf[qg][dk] = *(const bf16x8*)(Z + (size_t)(128 * blk + 64 * half + 16 * qg + fr) * NIN + hq * 64 + 32 * dk + 8 * fq);
                f32x4 o[4][4];
#pragma unroll
                for (int db = 0; db < 4; ++db)
#pragma unroll
                    for (int qg = 0; qg < 4; ++qg) o[db][qg] = (f32x4){0.f, 0.f, 0.f, 0.f};
                float mrow[4], lsum[4];
#pragma unroll
                for (int qg = 0; qg < 4; ++qg) { mrow[qg] = sinkl; lsum[qg] = 0.f; }
                const int dl0 = 4 * fq - fr, kcp = dl0 & 3;
                const LAS unsigned char* tbl = lds + TAB_OFF + ((wave >> 1) * 4 + kcp) * (TAB_N * 4) + 4 * (dl0 - kcp + TAB_ZERO - 128 - 48);
#pragma unroll 2
                for (int kt = 0; kt < 10; ++kt) {
                    const int key0 = 64 * half + 32 * kt, tb = key0 >> 7;
                    if ((tb == 0 && !has_prev) || (tb == 2 && !has_next)) continue;
                    f32x4 s[2][4];
#pragma unroll
                    for (int kb = 0; kb < 2; ++kb)
#pragma unroll
                        for (int qg = 0; qg < 4; ++qg) s[kb][qg] = (f32x4){0.f, 0.f, 0.f, 0.f};
#pragma unroll
                    for (int kb = 0; kb < 2; ++kb)
#pragma unroll
                        for (int dk = 0; dk < 2; ++dk) {
                            const bf16x8 kf = *(const LAS bf16x8*)(Ks + (key0 + 16 * kb + fr) * KS_STRIDE + 64 * dk + 16 * fq);
#pragma unroll
                            for (int qg = 0; qg < 4; ++qg) s[kb][qg] = __builtin_amdgcn_mfma_f32_16x16x32_bf16(kf, qf[qg][dk], s[kb][qg], 0, 0, 0);
                        }
                    bf16x8 pb[4];
                    const LAS unsigned char* tbp = tbl + 128 * kt;
                    bool need = false;
#pragma unroll
                    for (int qg = 0; qg < 4; ++qg) {
#pragma unroll
                        for (int kb = 0; kb < 2; ++kb) s[kb][qg] = s[kb][qg] + *(const LAS f32x4*)(tbp + 64 * (kb - qg + 3));
                        const float lm = fmaxf(fmaxf(fmaxf(s[0][qg][0], s[0][qg][1]), fmaxf(s[0][qg][2], s[0][qg][3])), fmaxf(fmaxf(s[1][qg][0], s[1][qg][1]), fmaxf(s[1][qg][2], s[1][qg][3])));
                        need |= lm > mrow[qg] + DEFER_THR;
                    }
                    if (__builtin_amdgcn_readfirstlane(__any(need))) {
#pragma unroll
                        for (int qg = 0; qg < 4; ++qg) {
                            float mx = fmaxf(fmaxf(fmaxf(s[0][qg][0], s[0][qg][1]), fmaxf(s[0][qg][2], s[0][qg][3])), fmaxf(fmaxf(s[1][qg][0], s[1][qg][1]), fmaxf(s[1][qg][2], s[1][qg][3])));
                            mx = fmaxf(mx, mrow[qg]);
                            mx = fmaxf(mx, __shfl_xor(mx, 16)); mx = fmaxf(mx, __shfl_xor(mx, 32));
                            const float alpha = __builtin_amdgcn_exp2f(mrow[qg] - mx); mrow[qg] = mx;
                            lsum[qg] = lsum[qg] * alpha;
#pragma unroll
                            for (int db = 0; db < 4; ++db) o[db][qg] = o[db][qg] * alpha;
                        }
                    }
#pragma unroll
                    for (int qg = 0; qg < 4; ++qg) {
                        const float mx = mrow[qg];
                        float ps = 0.f;
#pragma unroll
                        for (int kb = 0; kb < 2; ++kb)
#pragma unroll
                            for (int j = 0; j < 4; ++j) { const float p = __builtin_amdgcn_exp2f(s[kb][qg][j] - mx); s[kb][qg][j] = p; ps += p; }
                        lsum[qg] += ps;
                        v4u w; w.x = pk2(s[0][qg][0], s[0][qg][1]); w.y = pk2(s[0][qg][2], s[0][qg][3]); w.z = pk2(s[1][qg][0], s[1][qg][1]); w.w = pk2(s[1][qg][2], s[1][qg][3]);
                        pb[qg] = __builtin_bit_cast(bf16x8, w);
                    }
#pragma unroll
                    for (int db = 0; db < 4; ++db) {
                        const LAS unsigned char* vp = Vs + (key0 + 4 * fq + tq) * KS_STRIDE + (16 * db + 4 * tp) * 2;
                        const s16x4 lo = vtr(vp), hi = vtr(vp + 16 * KS_STRIDE);
                        const bf16x8 vf = (bf16x8){lo[0], lo[1], lo[2], lo[3], hi[0], hi[1], hi[2], hi[3]};
#pragma unroll
                        for (int qg = 0; qg < 4; ++qg) o[db][qg] = __builtin_amdgcn_mfma_f32_16x16x32_bf16(vf, pb[qg], o[db][qg], 0, 0, 0);
                    }
                }
#pragma unroll
                for (int qg = 0; qg < 4; ++qg) {
                    float lt = lsum[qg]; lt += __shfl_xor(lt, 16); lt += __shfl_xor(lt, 32); lt += __builtin_amdgcn_exp2f(sinkl - mrow[qg]);
                    const float inv = 1.0f / lt;
                    bf16* op = MIX + (size_t)(128 * blk + 64 * half + 16 * qg + fr) * DM + hq * 64 + 4 * fq;
#pragma unroll
                    for (int db = 0; db < 4; ++db) { const f32x4 v = o[db][qg] * inv; v2u w; w.x = pk2(v[0], v[1]); w.y = pk2(v[2], v[3]); *(v2u*)(op + 16 * db) = w; }
                }
            }
        }
#endif
        {
            const int tidg = pg8::opaque_v(tid);
            const int h = wave;
            const v4u* wsb = (const v4u*)(a->ws + WS_WSB) + ((size_t)(l * 8 + h) * 32) * 64 + lane;
            v4u gl[16];
#pragma unroll
            for (int i = 0; i < 16; ++i) { const int id = tidg + 512 * i, srow = id >> 6, c = id & 63; gl[i] = *(const v4u*)(Z + (size_t)(128 * blk + srow) * NIN + 1280 + 8 * c); }
            __syncthreads();
#pragma unroll
            for (int i = 0; i < 16; ++i) { const int id = tidg + 512 * i, srow = id >> 6, c = id & 63; *(LAS v4u*)(Gs + srow * GS_STRIDE + c * 16) = gl[i]; }
#pragma unroll 1
            for (int th = 0; th < 2; ++th) {
                const int tbase = 64 * th;
                v4u wf[4][4]; v2u uu[4][4]; float bias[4];
#pragma unroll
                for (int tb = 0; tb < 4; ++tb) { const size_t row = (size_t)128 * blk + tbase + 16 * tb + fr; bias[tb] = a->b_sp[(l * 8 + h) * 128 + tbase + 16 * tb + fr];
#pragma unroll
                    for (int c = 0; c < 4; ++c) wf[tb][c] = wsb[((4 * th + tb) * 4 + c) * 64];
#pragma unroll
                    for (int db = 0; db < 4; ++db) uu[tb][db] = *(const v2u*)(Z + row * NIN + 768 + 64 * h + 16 * db + 4 * fq); }
                if (th == 0) __syncthreads();
                f32x4 d[4][4];
#pragma unroll
                for (int tb = 0; tb < 4; ++tb)
#pragma unroll
                    for (int db = 0; db < 4; ++db) d[tb][db] = (f32x4){0.f, 0.f, 0.f, 0.f};
#pragma unroll
                for (int c = 0; c < 4; ++c)
#pragma unroll
                    for (int db = 0; db < 4; ++db) {
                        const LAS unsigned char* gp = Gs + (32 * c + 8 * fq + tq) * GS_STRIDE + (64 * h + 16 * db + 4 * tp) * 2;
                        const s16x4 lo = vtr(gp), hi = vtr(gp + 4 * GS_STRIDE);
                        const bf16x8 af = (bf16x8){lo[0], lo[1], lo[2], lo[3], hi[0], hi[1], hi[2], hi[3]};
#pragma unroll
                        for (int tb = 0; tb < 4; ++tb) d[tb][db] = __builtin_amdgcn_mfma_f32_16x16x32_bf16(af, __builtin_bit_cast(bf16x8, wf[tb][c]), d[tb][db], 0, 0, 0);
                    }
#pragma unroll
                for (int tb = 0; tb < 4; ++tb) { const size_t row = (size_t)128 * blk + tbase + 16 * tb + fr;
#pragma unroll
                    for (int db = 0; db < 4; ++db) {
                        const int d0 = 64 * h + 16 * db + 4 * fq; const v2u u2 = uu[tb][db]; const f32x4 dv = d[tb][db]; const float bs = bias[tb];
                        v2u w; w.x = pk2(bf_lo(u2.x) * (dv[0] + bs), bf_hi(u2.x) * (dv[1] + bs)); w.y = pk2(bf_lo(u2.y) * (dv[2] + bs), bf_hi(u2.y) * (dv[3] + bs));
                        *(v2u*)(MIX + row * DM + 512 + d0) = w;
                    } }
            }
        }
    }
    __syncthreads();
}

#define GRID_SYNC1() do { XcdBarrier b_ = bar; b_.x = (unsigned)opaque((int)bar.x); xcd_barrier(b_); } while (0)
#ifdef DUP_SYNC
#define GRID_SYNC() do { GRID_SYNC1(); GRID_SYNC1(); } while (0)
#else
#define GRID_SYNC() GRID_SYNC1()
#endif
__global__ void __launch_bounds__(NWAVES * 64, 2) fwd_megakernel(Args a) {
    extern __shared__ __attribute__((aligned(16))) unsigned char lds_raw[];
    LAS unsigned char* lds = (LAS unsigned char*)lds_raw;
    cg::grid_group grid = cg::this_grid();
    const int tid = threadIdx.x, lane = tid & 63, wave = __builtin_amdgcn_readfirstlane(tid >> 6);
    const int G = gridDim.x, bid = blockIdx.x;
    const int vcu = (G % 8 == 0) ? (bid % 8) * (G / 8) + bid / 8 : bid;
    const int gw = vcu * NWAVES + wave, NGW = G * NWAVES;
    if (tid < 64) ((LAS unsigned*)(lds + LDSCTL_OFF))[tid] = 0u;
    __syncthreads();
    const XcdBarrier bar = xcd_barrier_post((unsigned*)(kargs()->ws + WS_BAR), (volatile LAS unsigned*)(lds + LDSCTL_OFF));
    grid.sync();
#define KA (kargs())
#define X (KA->out)
#define SS ((pg8::ss_t*)(KA->ws + WS_SS))
#define XB ((bf16*)(KA->ws + WS_XB))
#define Wb (l == 0 ? (bf16*)(KA->ws + WS_W) : (bf16*)KA->out)
#define Hb ((bf16*)(KA->ws + WS_H))
#define Zb ((bf16*)(KA->ws + WS_Z))
#define MIXb ((bf16*)(KA->ws + WS_MIX))

    { bf16* xb_ = XB; pg8::ss_t* ss_ = SS; const float* xp_ = KA->x_prompt; const float* xs_ = KA->x_sample;
    for (int r0 = gw; r0 < TOK; r0 += 4 * NGW) {
        f32x4 v[4][4];
#pragma unroll
        for (int q = 0; q < 4; ++q) { const int r = r0 + q * NGW; const float* src = r < TOKP ? xp_ + (size_t)r * DM : xs_ + (size_t)(r - TOKP) * DM;
#pragma unroll
            for (int j = 0; j < 4; ++j) v[q][j] = *(const f32x4*)(src + 256 * j + 4 * lane); }
#pragma unroll
        for (int q = 0; q < 4; ++q) { const int r = r0 + q * NGW; float s = 0.f;
#pragma unroll
            for (int j = 0; j < 4; ++j) { const f32x4 x = v[q][j]; v2u w; w.x = pk2(x[0], x[1]); w.y = pk2(x[2], x[3]); *(v2u*)(xb_ + (size_t)r * DM + 256 * j + 4 * lane) = w;
                s += (x[0] * x[0] + x[1] * x[1]) + (x[2] * x[2] + x[3] * x[3]); }
            s = wave_sum(s);
            if (lane == 0) ss_[r] = pg8::ss_fix(s); }
    }
    for (int i = bid * 512 + tid; i < 6 * TOK; i += G * 512) ss_[TOK + i] = 0ull; }
    {
        const float* wsp_ = KA->w_sp; v4u* wsb_ = (v4u*)(KA->ws + WS_WSB);
        for (int e = bid * 512 + tid; e < NLAYER * 8 * 32 * 64; e += G * 512) {
            const int ln = e & 63, f = e >> 6, c = f & 3, tb = (f >> 2) & 7, lh = f >> 5;
            const float* wp = wsp_ + ((size_t)lh * 128 + 16 * tb + (ln & 15)) * 128 + 32 * c + 8 * (ln >> 4);
            const f32x4 w0 = *(const f32x4*)wp, w1 = *(const f32x4*)(wp + 4);
            v4u o; o.x = pk2(w0[0], w0[1]); o.y = pk2(w0[2], w0[3]); o.z = pk2(w1[0], w1[1]); o.w = pk2(w1[2], w1[3]);
            wsb_[e] = o;
        }
    }
    const int l1_cut = (G == 256) ? L1_CUT : 0;
    convert_layer(kargs(), 0, lds, gw, NGW, wave, lane, 0, 1 << 30);
    convert_layer(kargs(), 1, lds, gw, NGW, wave, lane, l1_cut, 1 << 30);
    GRID_SYNC();

    for (int l = 0; l < NLAYER; ++l) {
        #define ssA (SS + (size_t)(3 * l) * TOK)
#define ssB (SS + (size_t)(3 * l + 1) * TOK)
#define ssC (SS + (size_t)(3 * l + 2) * TOK)
#define ssD (SS + (size_t)(3 * l + 3) * TOK)
        if (PH_MASK & 1) { pg8::Gemm g{XB, (const bf16*)((unsigned char*)Wb + W_GU1), TOK, 2 * FF, DM}; pg8::StaticOrder S; S.init(TOK, 2 * FF, G, opaque(bid));
          pg8::EpiSwiglu E{Hb, FF, ssA};
#ifdef DUP_PA
          pg8::gemm_phase<pg8::EpiSwiglu, pg8::StaticOrder, true, true>(lds, g, S, E); __syncthreads();
#endif
          pg8::gemm_phase<pg8::EpiSwiglu, pg8::StaticOrder, true, true>(lds, g, S, E); }
        GRID_SYNC();
        if (PH_MASK & 2) { pg8::Gemm g{Hb, (const bf16*)((unsigned char*)Wb + W_D1), TOK, DM, FF}; pg8::StaticOrder S; S.init(TOK, DM, G, opaque(bid));
          pg8::EpiResid E{XB, ssB, 0.5f};
#ifdef DUP_PB
          { pg8::EpiResid E0{XB, nullptr, 0.0f}; pg8::gemm_phase<pg8::EpiResid, pg8::StaticOrder, true, true>(lds, g, S, E0); __syncthreads(); }
#endif
          pg8::gemm_phase<pg8::EpiResid, pg8::StaticOrder, true, true>(lds, g, S, E); }
        GRID_SYNC();
        if (PH_MASK & 4) { pg8::Gemm g{XB, (const bf16*)((unsigned char*)Wb + W_IN), TOK, NIN, DM}; pg8::StaticOrder S; S.init(TOK, NIN, G, opaque(bid));
          pg8::EpiInProj E{Zb, ssB, KA->vgain + l * 512};
          pg8::gemm_phase<pg8::EpiInProj, pg8::StaticOrder, true, true>(lds, g, S, E); }
        if (l == 0 && G == 256 && bid >= 128) {
          const int t_ = pg8::opaque_v((int)threadIdx.x), w_ = __builtin_amdgcn_readfirstlane(t_ >> 6);
          convert_layer(kargs(), 1, lds, (opaque(bid) - 128) * NWAVES + w_, 128 * NWAVES, w_, t_ & 63, 0, L1_CUT); }
        GRID_SYNC();
#ifdef MIXER_COPY
        if (PH_MASK & 8) { for (size_t i = (size_t)bid * 512 + threadIdx.x; i < (size_t)TOK * 128; i += (size_t)G * 512) { const size_t r = i >> 7, c = i & 127; *(v4u*)(MIXb + r * DM + 8 * c) = *(const v4u*)(Zb + r * NIN + 8 * c); } }
#else
        if (PH_MASK & 8) { const int t_ = pg8::opaque_v((int)threadIdx.x); mixer_phase(kargs(), l, lds, G, opaque(vcu), t_, __builtin_amdgcn_readfirstlane(t_ >> 6), t_ & 63); }
#ifdef DUP_PD
        { const int t_ = pg8::opaque_v((int)threadIdx.x); mixer_phase(kargs(), l, lds, G, opaque(vcu), t_, __builtin_amdgcn_readfirstlane(t_ >> 6), t_ & 63); }
#endif
#endif
        GRID_SYNC();
        if (PH_MASK & 16) { pg8::Gemm g{MIXb, (const bf16*)((unsigned char*)Wb + W_OUT), TOK, DM, DM}; pg8::StaticOrder S; S.init(TOK, DM, G, opaque(bid));
          pg8::EpiResid E{XB, ssC, 1.0f};
#ifdef DUP_PB
          { pg8::EpiResid E0{XB, nullptr, 0.0f}; pg8::gemm_phase<pg8::EpiResid, pg8::StaticOrder, true, true>(lds, g, S, E0); __syncthreads(); }
#endif
          pg8::gemm_phase<pg8::EpiResid, pg8::StaticOrder, true, true>(lds, g, S, E); }
        GRID_SYNC();
        if (PH_MASK & 32) { pg8::Gemm g{XB, (const bf16*)((unsigned char*)Wb + W_GU2), TOK, 2 * FF, DM}; pg8::StaticOrder S; S.init(TOK, 2 * FF, G, opaque(bid));
          pg8::EpiSwiglu E{Hb, FF, ssC};
#ifdef DUP_PA
          pg8::gemm_phase<pg8::EpiSwiglu, pg8::StaticOrder, true, true>(lds, g, S, E); __syncthreads();
#endif
          pg8::gemm_phase<pg8::EpiSwiglu, pg8::StaticOrder, true, true>(lds, g, S, E); }
        GRID_SYNC();
        if (PH_MASK & 64) { pg8::Gemm g{Hb, (const bf16*)((unsigned char*)Wb + W_D2), TOK, DM, FF}; pg8::StaticOrder S; S.init(TOK, DM, G, opaque(bid));
          pg8::EpiResid E{XB, ssD, 0.5f};
#ifdef DUP_PB
          { pg8::EpiResid E0{XB, nullptr, 0.0f}; pg8::gemm_phase<pg8::EpiResid, pg8::StaticOrder, true, true>(lds, g, S, E0); __syncthreads(); }
#endif
          pg8::gemm_phase<pg8::EpiResid, pg8::StaticOrder, true, true>(lds, g, S, E); }
        GRID_SYNC();
    }
    {
        const int t_ = pg8::opaque_v((int)threadIdx.x), lane = t_ & 63, gw = opaque(vcu) * NWAVES + __builtin_amdgcn_readfirstlane(t_ >> 6);
        const pg8::ss_t* ssF = SS + (size_t)6 * TOK; const bf16* xb_ = XB; float* out_ = X;
        f32x4 gn[4];
#pragma unroll
        for (int j = 0; j < 4; ++j) gn[j] = *(const f32x4*)(KA->norm_final + 256 * j + 4 * lane);
        for (int r0 = gw; r0 < TOK; r0 += 4 * NGW) {
            v2u w[4][4]; pg8::ss_t sv[4];
#pragma unroll
            for (int q = 0; q < 4; ++q) { const int r = r0 + q * NGW; sv[q] = ssF[r];
#pragma unroll
                for (int j = 0; j < 4; ++j) w[q][j] = *(const v2u*)(xb_ + (size_t)r * DM + 256 * j + 4 * lane); }
#pragma unroll
            for (int q = 0; q < 4; ++q) { const int r = r0 + q * NGW; const float rs = pg8::rs_of(sv[q]);
#pragma unroll
                for (int j = 0; j < 4; ++j) { const f32x4 v = (f32x4){bf_lo(w[q][j].x), bf_hi(w[q][j].x), bf_lo(w[q][j].y), bf_hi(w[q][j].y)}; *(f32x4*)(out_ + (size_t)r * DM + 256 * j + 4 * lane) = v * rs * gn[j]; } }
        }
    }
}
#undef KA
#undef X
#undef SS
#undef XB
#undef Wb
#undef Hb
#undef Zb
#undef MIXb
#undef ssA
#undef ssB
#undef ssC
#undef ssD

extern "C" void kernel_launch(void* const* d_in, const int* in_sizes, int n_in, void* d_out, int out_size, void* d_ws, size_t ws_size, hipStream_t stream) {
    static int grid = 0;
    if (grid == 0) {
        if (n_in != 18 || out_size != TOK * DM || ws_size < WS_END) { fprintf(stderr, "kernel_launch: unexpected shapes (n_in %d out %d ws %zu, need %zu)\n", n_in, out_size, ws_size, (size_t)WS_END); grid = -1; return; }
        int dev = 0, cus = 0, per_cu = 0;
        if (hipGetDevice(&dev) != hipSuccess || hipDeviceGetAttribute(&cus, hipDeviceAttributeMultiprocessorCount, dev) != hipSuccess) { grid = -1; return; }
        if (hipFuncSetAttribute((const void*)fwd_megakernel, hipFuncAttributeMaxDynamicSharedMemorySize, LDS_BYTES) != hipSuccess) { fprintf(stderr, "kernel_launch: hipFuncSetAttribute failed\n"); grid = -1; return; }
        if (hipOccupancyMaxActiveBlocksPerMultiprocessor(&per_cu, (const void*)fwd_megakernel, NWAVES * 64, LDS_BYTES) != hipSuccess || per_cu < 1) { fprintf(stderr, "kernel_launch: occupancy query says %d\n", per_cu); per_cu = 1; }
        (void)hipGetLastError();
        grid = cus;
    }
    if (grid < 0) return;
    if (hipMemsetAsync((char*)d_ws + WS_BAR, 0, WS_BAR_BYTES, stream) != hipSuccess) { fprintf(stderr, "kernel_launch: memset failed\n"); return; }
    Args a{};
    const float** f = (const float**)&a;
    for (int i = 0; i < 18; ++i) f[i] = (const float*)d_in[i];
    a.out = (float*)d_out; a.ws = (unsigned char*)d_ws;
    void* args[] = {&a};
    hipError_t e = hipLaunchCooperativeKernel((const void*)fwd_megakernel, dim3(grid), dim3(NWAVES * 64), args, LDS_BYTES, stream);
    if (e != hipSuccess) fprintf(stderr, "kernel_launch: cooperative launch failed: %s (grid %d)\n", hipGetErrorString(e), grid);
}
```

```cpp
#include <hip/hip_runtime.h>
#include <hip/hip_cooperative_groups.h>
#include <cstdio>
#include <cstdint>
#include <cmath>
namespace cg = cooperative_groups;
namespace pg8 {
#define PG8_LAS __attribute__((address_space(3)))
typedef unsigned short bf16_t;
typedef short bf16x8 __attribute__((ext_vector_type(8)));
typedef float f32x4 __attribute__((ext_vector_type(4)));
typedef unsigned u32x4 __attribute__((ext_vector_type(4)));
constexpr int BM = 256, BK = 64, HALF = 128, HTB = HALF * BK * 2  , STAGE_BYTES = 8 * HTB, NXCD = 8, WGM = 8;

__host__ __device__ __forceinline__ int lds_byte(int r, int c) { const int st = (r >> 4) * 2 + (c >> 5), rr = r & 15, cc = c & 31, ob = rr * 64 + cc * 2; return st * 1024 + (ob ^ (((ob >> 9) & 1) << 5)); }
__host__ __device__ __forceinline__ void stage_rc(int b, int& R, int& C) { const int st = b / 1024, sb = b % 1024, swz = sb ^ (((sb >> 9) & 1) << 5); R = (st >> 1) * 16 + swz / 64; C = (st & 1) * 32 + (swz % 64) / 2; }
__host__ __device__ __forceinline__ int perm32(int rho) { const int n = rho >> 4, i = rho & 15; return 8 * (i >> 2) + 4 * n + (i & 3); }

struct Unit { int pm, pn; };
struct Gemm { const bf16_t* A; const bf16_t* Bt; int M, N, K; };

struct StaticOrder {
    int nM, nN, nwg, G, c;
    __host__ __device__ void init(int M, int N, int G_, int c_) { nM = M / BM; nN = N / BM; nwg = nM * nN; G = G_; c = c_; }
    __host__ __device__ bool next(int i, Unit& u) const {
        const long L = (long)i * G + c; if (L >= nwg) return false;
        int wgid = (int)L; { const int q = nwg / NXCD, r = nwg % NXCD, xcd = wgid % NXCD, off = wgid / NXCD; wgid = (xcd < r ? xcd * (q + 1) : r * (q + 1) + (xcd - r) * q) + off; }
        const int nig = WGM * nN, gid = wgid / nig, fm = gid * WGM, gsz = (nM - fm) < WGM ? (nM - fm) : WGM;
        u.pm = fm + ((wgid % nig) % gsz); u.pn = (wgid % nig) / gsz; return true;
    }
    __device__ __forceinline__ void a_ready(const Unit&) const {}
    __device__ __forceinline__ void done(const Unit&) const {}
};

__device__ __forceinline__ unsigned cvt_pk_bf16(float lo, float hi) { unsigned r; asm volatile("v_cvt_pk_bf16_f32 %0, %1, %2" : "=v"(r) : "v"(lo), "v"(hi)); return r; }
typedef float f32x2 __attribute__((ext_vector_type(2)));
constexpr float RMS_EPS = 1e-6f;
__device__ __forceinline__ int opaque_v(int v) { asm volatile("" : "+v"(v)); return v; }
constexpr float K_LOG2E = 1.4426950408889634f;
__device__ __forceinline__ float fast_exp2(float x) { return __builtin_amdgcn_exp2f(x); }
__device__ __forceinline__ float fast_rcp(float x) { return __builtin_amdgcn_rcpf(x); }
__device__ __forceinline__ float silu_f(float g) { return g * fast_rcp(1.0f + fast_exp2(-K_LOG2E * g)); }
__device__ __forceinline__ float gelu_tanh_f(float v) { const float t = v * (1.0f + 0.044715f * v * v); return v * fast_rcp(1.0f + fast_exp2(-2.3022081978f * t)); }
typedef unsigned long long ss_t;
constexpr float SS_SCALE = 1048576.0f;
__device__ __forceinline__ ss_t ss_fix(float s) { return (ss_t)(s * SS_SCALE + 0.5f); }
__device__ __forceinline__ float rs_of(ss_t v) { return __builtin_amdgcn_rsqf((float)v * (1.0f / (1024.0f * SS_SCALE)) + RMS_EPS); }
__device__ __forceinline__ float row_rs(const ss_t* ss, int row) { return __builtin_amdgcn_rsqf((float)ss[row] * (1.0f / (1024.0f * SS_SCALE)) + RMS_EPS); }

__device__ __forceinline__ f32x2 swiglu_pk(f32x2 ag, f32x2 au, float rsn, float rs2) {
    const f32x2 t = ag * rsn; f32x2 e; e.x = fast_exp2(t.x); e.y = fast_exp2(t.y);
    const f32x2 den = e + 1.0f; f32x2 r; r.x = fast_rcp(den.x); r.y = fast_rcp(den.y);
    return ((ag * au) * rs2) * r;
}
struct EpiSwiglu {
    static constexpr bool PERM = true, AFTER_DRAIN = false;
    bf16_t* H; int ldh; const ss_t* ss;
    __device__ __forceinline__ void operator()(const f32x4 (&acc)[2][2][4][2], const Unit& u, int wr, int wc, int fr, int fq) const {
        const int row0 = u.pm * BM + wr * 64 + fr, col0 = u.pn * HALF + wc * 32 + 8 * fq;
        ss_t sv[2][4];
#pragma unroll
        for (int ai = 0; ai < 2; ++ai)
#pragma unroll
            for (int m = 0; m < 4; ++m) sv[ai][m] = ss[row0 + ai * HALF + m * 16];
#pragma unroll
        for (int ai = 0; ai < 2; ++ai)
#pragma unroll
            for (int m = 0; m < 4; ++m) {
                const int row = row0 + ai * HALF + m * 16; const float rs = rs_of(sv[ai][m]), rsn = -K_LOG2E * rs, rs2 = rs * rs;
                const f32x4 ag0 = acc[ai][0][m][0], ag1 = acc[ai][0][m][1], au0 = acc[ai][1][m][0], au1 = acc[ai][1][m][1];
                const f32x2 h0 = swiglu_pk((f32x2){ag0[0], ag0[1]}, (f32x2){au0[0], au0[1]}, rsn, rs2), h1 = swiglu_pk((f32x2){ag0[2], ag0[3]}, (f32x2){au0[2], au0[3]}, rsn, rs2);
                const f32x2 h2 = swiglu_pk((f32x2){ag1[0], ag1[1]}, (f32x2){au1[0], au1[1]}, rsn, rs2), h3 = swiglu_pk((f32x2){ag1[2], ag1[3]}, (f32x2){au1[2], au1[3]}, rsn, rs2);
                u32x4 w; w.x = cvt_pk_bf16(h0.x, h0.y); w.y = cvt_pk_bf16(h1.x, h1.y); w.z = cvt_pk_bf16(h2.x, h2.y); w.w = cvt_pk_bf16(h3.x, h3.y);
                *(u32x4*)(H + (size_t)row * ldh + col0) = w;
                asm volatile("" ::: "memory");
            }
    }
};
__device__ __forceinline__ float bfl(unsigned w) { return __builtin_bit_cast(float, w << 16); }
__device__ __forceinline__ float bfh(unsigned w) { return __builtin_bit_cast(float, w & 0xffff0000u); }
struct EpiResid {
    static constexpr bool PERM = true, AFTER_DRAIN = false;
    bf16_t* XB; ss_t* ssn; float scale;
    __device__ __forceinline__ void operator()(const f32x4 (&acc)[2][2][4][2], const Unit& u, int wr, int wc, int fr, int fq) const {
        const int row0 = u.pm * BM + wr * 64 + fr, col0 = u.pn * BM + wc * 32 + 8 * fq;
#pragma unroll
        for (int ai = 0; ai < 2; ++ai) {
            u32x4 xw[4][2];
#pragma unroll
            for (int m = 0; m < 4; ++m)
#pragma unroll
                for (int bj = 0; bj < 2; ++bj) xw[m][bj] = *(const u32x4*)(XB + (size_t)(row0 + ai * HALF + m * 16) * 1024 + col0 + bj * HALF);
#pragma unroll
            for (int m = 0; m < 4; ++m) {
                const int row = row0 + ai * HALF + m * 16; float s = 0.f;
#pragma unroll
                for (int bj = 0; bj < 2; ++bj) {
                    bf16_t* xp = XB + (size_t)row * 1024 + col0 + bj * HALF;
                    const u32x4 w0 = xw[m][bj];
                    f32x4 x0 = (f32x4){bfl(w0.x), bfh(w0.x), bfl(w0.y), bfh(w0.y)}, x1 = (f32x4){bfl(w0.z), bfh(w0.z), bfl(w0.w), bfh(w0.w)};
                    x0 = x0 + acc[ai][bj][m][0] * scale; x1 = x1 + acc[ai][bj][m][1] * scale;
                    s += (x0[0] * x0[0] + x0[1] * x0[1]) + (x0[2] * x0[2] + x0[3] * x0[3]) + (x1[0] * x1[0] + x1[1] * x1[1]) + (x1[2] * x1[2] + x1[3] * x1[3]);
                    u32x4 w; w.x = cvt_pk_bf16(x0[0], x0[1]); w.y = cvt_pk_bf16(x0[2], x0[3]); w.z = cvt_pk_bf16(x1[0], x1[1]); w.w = cvt_pk_bf16(x1[2], x1[3]);
                    *(u32x4*)xp = w;
                }
                s += __shfl_xor(s, 16); s += __shfl_xor(s, 32);
                if (fq == 0 && ssn) atomicAdd(ssn + row, ss_fix(s));
            }
            asm volatile("" ::: "memory");
        }
    }
};
struct EpiInProj {
    static constexpr bool PERM = true, AFTER_DRAIN = false;
    bf16_t* Z; const ss_t* ss; const float* vgain;
    __device__ __forceinline__ void operator()(const f32x4 (&acc)[2][2][4][2], const Unit& u, int wr, int wc, int fr, int fq) const {
        const int row0 = u.pm * BM + wr * 64 + fr, pn = u.pn;
        const int mode = pn < 2 ? 0 : (pn == 2 ? 1 : (pn < 5 ? 2 : 3));
        int colb[2]; f32x4 gv[2][2];
#pragma unroll
        for (int bj = 0; bj < 2; ++bj) {
            colb[bj] = mode == 3 ? 1280 + 64 * (4 * (pn - 5) + wc) + 32 * bj + 8 * fq : 256 * pn + 128 * bj + 32 * wc + 8 * fq;
#pragma unroll
            for (int n = 0; n < 2; ++n) gv[bj][n] = mode == 3 ? *(const f32x4*)(vgain + (colb[bj] - 1280) + 4 * n) : (f32x4){1.f, 1.f, 1.f, 1.f};
        }
        ss_t sv[2][4];
#pragma unroll
        for (int ai = 0; ai < 2; ++ai)
#pragma unroll
            for (int m = 0; m < 4; ++m) sv[ai][m] = ss[row0 + ai * HALF + m * 16];
#pragma unroll
        for (int ai = 0; ai < 2; ++ai)
#pragma unroll
            for (int m = 0; m < 4; ++m) {
                const int row = row0 + ai * HALF + m * 16; const float rs = rs_of(sv[ai][m]);
                f32x4 v[2][2];
#pragma unroll
                for (int bj = 0; bj < 2; ++bj)
#pragma unroll
                    for (int n = 0; n < 2; ++n) v[bj][n] = acc[ai][bj][m][n] * rs;
                if (mode == 0) {
#pragma unroll
                    for (int bj = 0; bj < 2; ++bj)
#pragma unroll
                        for (int n = 0; n < 2; ++n) v[bj][n] = v[bj][n] * (0.125f * K_LOG2E);
                } else if (mode >= 2) {
#pragma unroll
                    for (int bj = 0; bj < 2; ++bj)
#pragma unroll
                        for (int n = 0; n < 2; ++n)
#pragma unroll
                            for (int e = 0; e < 4; ++e) v[bj][n][e] = gelu_tanh_f(v[bj][n][e]);
                    if (mode == 3) {
                        float q = 0.f;
#pragma unroll
                        for (int bj = 0; bj < 2; ++bj)
#pragma unroll
                            for (int n = 0; n < 2; ++n) q += (v[bj][n][0] * v[bj][n][0] + v[bj][n][1] * v[bj][n][1]) + (v[bj][n][2] * v[bj][n][2] + v[bj][n][3] * v[bj][n][3]);
                        q += __shfl_xor(q, 16); q += __shfl_xor(q, 32);
                        const float r2 = __builtin_amdgcn_rsqf(q * (1.0f / 64.0f) + RMS_EPS);
#pragma unroll
                        for (int bj = 0; bj < 2; ++bj)
#pragma unroll
                            for (int n = 0; n < 2; ++n) v[bj][n] = v[bj][n] * r2 * gv[bj][n];
                    }
                }
#pragma unroll
                for (int bj = 0; bj < 2; ++bj) {
                    u32x4 w; w.x = cvt_pk_bf16(v[bj][0][0], v[bj][0][1]); w.y = cvt_pk_bf16(v[bj][0][2], v[bj][0][3]); w.z = cvt_pk_bf16(v[bj][1][0], v[bj][1][1]); w.w = cvt_pk_bf16(v[bj][1][2], v[bj][1][3]);
                    *(u32x4*)(Z + (size_t)row * 1792 + colb[bj]) = w;
                }
                asm volatile("" ::: "memory");
            }
    }
};

template <class Epi, class Sched, bool ALIGN_EPI = false, bool SP2 = false>
__device__ __forceinline__ void gemm_phase(PG8_LAS unsigned char* lds, const Gemm g, const Sched& S, const Epi& E) {
    const int tid = opaque_v((int)threadIdx.x), wid = __builtin_amdgcn_readfirstlane(tid >> 6), lane = tid & 63, wr = wid >> 2, wc = wid & 3, fr = lane & 15, fq = lane >> 4;
    const int K = g.K, nt = K / BK;
    unsigned voffA[2], voffB[2];
#pragma unroll
    for (int i = 0; i < 2; ++i) { int R, C; stage_rc(tid * 16 + i * 8192, R, C); const int Rb = Epi::PERM ? ((R & ~31) + perm32(R & 31)) : R;
        voffA[i] = (unsigned)(R * K + C) * 2u; voffB[i] = (unsigned)(Rb * K + C) * 2u; }
    const size_t kstep = (size_t)(BK * 2);
    const size_t hstep = (size_t)HALF * K * 2;
    const size_t tstep = 2 * hstep;
    const unsigned ldsw = (unsigned)wid * 1024u;
    const int aoff = lds_byte(wr * 64 + fr, fq * 8), boff = lds_byte(wc * 32 + fr, fq * 8);
#define PG8_SA(b, h) (((b) * 2 + (h)) * HTB)
#define PG8_SB(b, h) ((4 + (b) * 2 + (h)) * HTB)
#define PG8_STAGE(bufoff, gbase, voff) do { _Pragma("unroll") for (int _i = 0; _i < 2; ++_i) \
        __builtin_amdgcn_global_load_lds((const unsigned*)((const char*)(gbase) + (voff)[_i]), (PG8_LAS unsigned*)(lds + (bufoff) + ldsw + _i * 8192), 16, 0, 0); } while (0)
#define PG8_LDA(dst, b, h) do { _Pragma("unroll") for (int m = 0; m < 4; ++m) _Pragma("unroll") for (int k = 0; k < 2; ++k) dst[m][k] = *(const PG8_LAS bf16x8*)(lds + PG8_SA(b, h) + aoff + m * 2048 + k * 1024); } while (0)
#define PG8_LDB(dst, b, h) do { _Pragma("unroll") for (int n = 0; n < 2; ++n) _Pragma("unroll") for (int k = 0; k < 2; ++k) dst[n][k] = *(const PG8_LAS bf16x8*)(lds + PG8_SB(b, h) + boff + n * 2048 + k * 1024); } while (0)
#define PG8_MMA(ai, bj, At, Bt) do { __builtin_amdgcn_s_setprio(1); _Pragma("unroll") for (int m = 0; m < 4; ++m) _Pragma("unroll") for (int n = 0; n < 2; ++n) _Pragma("unroll") for (int k = 0; k < 2; ++k) \
        acc[ai][bj][m][n] = __builtin_amdgcn_mfma_f32_16x16x32_bf16(Bt[n][k], At[m][k], acc[ai][bj][m][n], 0, 0, 0); __builtin_amdgcn_s_setprio(0); } while (0)
#define PG8_WAIT_V(n) asm volatile("s_waitcnt vmcnt(" #n ")" ::: "memory")
#define PG8_WAIT_L(n) asm volatile("s_waitcnt lgkmcnt(" #n ")" ::: "memory")
#define PG8_BAR __builtin_amdgcn_s_barrier()
#define PG8_SCHED __builtin_amdgcn_sched_barrier(0)
    Unit cur, nxt; int ui = 0;
    if (!S.next(0, cur)) return;
    f32x4 acc[2][2][4][2];
#pragma unroll
    for (int a = 0; a < 2; ++a)
#pragma unroll
        for (int b = 0; b < 2; ++b)
#pragma unroll
            for (int m = 0; m < 4; ++m)
#pragma unroll
                for (int n = 0; n < 2; ++n) acc[a][b][m][n] = (f32x4){0.f, 0.f, 0.f, 0.f};
    bf16x8 At[4][2], B0[2][2], B1[2][2];
    const char* cA = (const char*)g.A + (size_t)cur.pm * tstep; const char* cB = (const char*)g.Bt + (size_t)cur.pn * tstep;
    S.a_ready(cur);
    if constexpr (SP2) {
        PG8_STAGE(PG8_SB(0, 0), cB, voffB); PG8_STAGE(PG8_SB(0, 1), cB + hstep, voffB); PG8_STAGE(PG8_SA(0, 0), cA, voffA); PG8_STAGE(PG8_SA(0, 1), cA + hstep, voffA);
        if (wr == 1) PG8_BAR;
        PG8_WAIT_V(2); PG8_BAR;
        PG8_STAGE(PG8_SB(1, 0), cB + kstep, voffB); PG8_STAGE(PG8_SA(1, 0), cA + kstep, voffA); PG8_STAGE(PG8_SB(1, 1), cB + hstep + kstep, voffB);
        PG8_WAIT_V(6); PG8_BAR;
    } else {
        PG8_STAGE(PG8_SB(0, 0), cB, voffB); PG8_STAGE(PG8_SA(0, 0), cA, voffA); PG8_STAGE(PG8_SB(0, 1), cB + hstep, voffB); PG8_STAGE(PG8_SA(0, 1), cA + hstep, voffA);
        if (wr == 1) PG8_BAR;
        PG8_WAIT_V(4); PG8_BAR;
        PG8_STAGE(PG8_SB(1, 0), cB + kstep, voffB); PG8_STAGE(PG8_SA(1, 0), cA + kstep, voffA); PG8_STAGE(PG8_SB(1, 1), cB + hstep + kstep, voffB);
        PG8_WAIT_V(6); PG8_BAR;
    }
    for (;;) {
        const bool has_next = S.next(ui + 1, nxt);
        const char* nA = has_next ? (const char*)g.A + (size_t)nxt.pm * tstep : cA; const char* nB = has_next ? (const char*)g.Bt + (size_t)nxt.pn * tstep : cB;
        for (int t = 0; t < nt; t += 2) {
            const bool last = (t == nt - 2);
            const char* a1 = cA + (size_t)(t + 1) * kstep;
            const char* a2 = last ? nA : cA + (size_t)(t + 2) * kstep; const char* b2 = last ? nB : cB + (size_t)(t + 2) * kstep;
            const char* a3 = a2 + kstep; const char* b3 = b2 + kstep;
            if (last && has_next) S.a_ready(nxt);
            if constexpr (SP2) {
            PG8_LDB(B0, 0, 0); PG8_LDB(B1, 0, 1); PG8_SCHED; PG8_LDA(At, 0, 0); PG8_STAGE(PG8_SA(1, 1), a1 + hstep, voffA);
            PG8_WAIT_V(8); PG8_WAIT_L(0); PG8_BAR; PG8_MMA(0, 0, At, B0); PG8_MMA(0, 1, At, B1); PG8_BAR; PG8_SCHED;
            PG8_LDA(At, 0, 1); PG8_STAGE(PG8_SB(0, 0), b2, voffB); PG8_STAGE(PG8_SB(0, 1), b2 + hstep, voffB); PG8_STAGE(PG8_SA(0, 0), a2, voffA);
            PG8_WAIT_V(8); PG8_WAIT_L(0); PG8_BAR; PG8_MMA(1, 0, At, B0); PG8_MMA(1, 1, At, B1); PG8_BAR; PG8_SCHED;
            PG8_LDB(B0, 1, 0); PG8_LDB(B1, 1, 1); PG8_SCHED; PG8_LDA(At, 1, 0); PG8_STAGE(PG8_SA(0, 1), a2 + hstep, voffA);
            PG8_WAIT_V(8); PG8_WAIT_L(0); PG8_BAR; PG8_MMA(0, 0, At, B0); PG8_MMA(0, 1, At, B1); PG8_BAR; PG8_SCHED;
            PG8_LDA(At, 1, 1); PG8_STAGE(PG8_SB(1, 0), b3, voffB); PG8_STAGE(PG8_SB(1, 1), b3 + hstep, voffB); PG8_STAGE(PG8_SA(1, 0), a3, voffA);
            PG8_WAIT_V(8); PG8_WAIT_L(0); PG8_BAR; PG8_MMA(1, 0, At, B0); PG8_MMA(1, 1, At, B1); PG8_BAR; PG8_SCHED;
            } else {
            PG8_LDB(B0, 0, 0); PG8_SCHED; PG8_LDA(At, 0, 0); PG8_STAGE(PG8_SA(1, 1), a1 + hstep, voffA);
            PG8_WAIT_L(8); PG8_BAR; PG8_WAIT_L(0); PG8_MMA(0, 0, At, B0); PG8_BAR; PG8_SCHED;
            PG8_LDB(B1, 0, 1); PG8_STAGE(PG8_SB(0, 0), b2, voffB);
            PG8_BAR; PG8_WAIT_L(0); PG8_MMA(0, 1, At, B1); PG8_BAR;
            PG8_LDA(At, 0, 1); PG8_STAGE(PG8_SA(0, 0), a2, voffA);
            PG8_BAR; PG8_WAIT_L(0); PG8_MMA(1, 0, At, B0); PG8_BAR; PG8_SCHED;
            PG8_STAGE(PG8_SB(0, 1), b2 + hstep, voffB);
            PG8_WAIT_V(6); PG8_BAR; PG8_MMA(1, 1, At, B1); PG8_BAR;
            PG8_LDB(B0, 1, 0); PG8_SCHED; PG8_LDA(At, 1, 0); PG8_STAGE(PG8_SA(0, 1), a2 + hstep, voffA);
            PG8_WAIT_L(8); PG8_BAR; PG8_WAIT_L(0); PG8_MMA(0, 0, At, B0); PG8_BAR; PG8_SCHED;
            PG8_LDB(B1, 1, 1); PG8_STAGE(PG8_SB(1, 0), b3, voffB);
            PG8_BAR; PG8_WAIT_L(0); PG8_MMA(0, 1, At, B1); PG8_BAR;
            PG8_LDA(At, 1, 1); PG8_STAGE(PG8_SA(1, 0), a3, voffA);
            PG8_BAR; PG8_WAIT_L(0); PG8_MMA(1, 0, At, B0); PG8_BAR; PG8_SCHED;
            PG8_STAGE(PG8_SB(1, 1), b3 + hstep, voffB);
            PG8_WAIT_V(6); PG8_BAR; PG8_MMA(1, 1, At, B1); PG8_BAR;
            }
        }
        if constexpr (ALIGN_EPI) { if (wr == 0) PG8_BAR; }
        if constexpr (!Epi::AFTER_DRAIN) { E(acc, cur, wr, wc, fr, fq); S.done(cur); }
        if (!has_next) break;
#pragma unroll
        for (int a = 0; a < 2; ++a)
#pragma unroll
            for (int b = 0; b < 2; ++b)
#pragma unroll
                for (int m = 0; m < 4; ++m)
#pragma unroll
                    for (int n = 0; n < 2; ++n) acc[a][b][m][n] = (f32x4){0.f, 0.f, 0.f, 0.f};
        cur = nxt; cA = nA; cB = nB; ++ui;
        if constexpr (ALIGN_EPI) { if (wr == 1) PG8_BAR; }
    }
    PG8_WAIT_V(0);
    if constexpr (!ALIGN_EPI) { if (wr == 0) PG8_BAR; }
    PG8_BAR;
    if constexpr (Epi::AFTER_DRAIN) { E.fused(acc, cur, wr, wc, fr, fq, lds, wid, lane); S.done(cur); }
#undef PG8_SA
#undef PG8_SB
#undef PG8_STAGE
#undef PG8_LDA
#undef PG8_LDB
#undef PG8_MMA
#undef PG8_WAIT_V
#undef PG8_WAIT_L
#undef PG8_BAR
#undef PG8_SCHED
}
}

#ifndef PH_MASK
#define PH_MASK 127
#endif
#ifndef N_LAYER
#define N_LAYER 2
#endif
constexpr int NWAVES = 8;
#ifndef L1_CUT
#define L1_CUT 7168
#endif
constexpr int TOK = 32768, TOKP = 16384, DM = 1024, FF = 2816, NIN = 1792, NLAYER = N_LAYER, NBLK = TOK / 128;
constexpr size_t WS_SS = 0;
constexpr size_t WS_W = 2u << 20;
constexpr size_t W_GU1 = 0, W_D1 = W_GU1 + (size_t)2 * FF * DM * 2, W_IN = W_D1 + (size_t)DM * FF * 2, W_OUT = W_IN + (size_t)NIN * DM * 2,
                 W_GU2 = W_OUT + (size_t)DM * DM * 2, W_D2 = W_GU2 + (size_t)2 * FF * DM * 2, W_BYTES = W_D2 + (size_t)DM * FF * 2;
constexpr size_t WS_XB = WS_W + W_BYTES;
constexpr size_t WS_R1 = WS_XB + (size_t)TOK * DM * 2;
constexpr size_t WS_Z = WS_R1, WS_MIX = WS_R1 + (size_t)TOK * NIN * 2, WS_H = WS_R1;
constexpr size_t WS_WSB = WS_R1 + (size_t)TOK * FF * 2;
constexpr size_t WS_TAB = WS_WSB + (size_t)NLAYER * 8 * 128 * 128 * 2;
constexpr size_t WS_END = WS_TAB + (size_t)8 * 4 * 388 * 4;
static_assert(WS_MIX + (size_t)TOK * DM * 2 == WS_WSB && WS_XB % 256 == 0 && WS_R1 % 256 == 0, "d_ws map");
constexpr int LDSCTL_OFF = 147456 - 256;
constexpr size_t WS_BAR = 0x1D0000, WS_BAR_BYTES = 16384;
constexpr int LDS_BYTES = 147456;

#define LAS __attribute__((address_space(3)))
typedef unsigned short bf16;
typedef unsigned v4u __attribute__((ext_vector_type(4)));
typedef unsigned v2u __attribute__((ext_vector_type(2)));
typedef float f32x4 __attribute__((ext_vector_type(4)));
typedef short bf16x8 __attribute__((ext_vector_type(8)));
typedef short s16x4 __attribute__((ext_vector_type(4)));
typedef short v4i16_t __attribute__((ext_vector_type(4)));
#define LDS_WAIT() asm volatile("s_waitcnt lgkmcnt(0)" ::: "memory")
typedef float f32x2_t __attribute__((ext_vector_type(2)));
typedef __bf16 bf16x2_t __attribute__((ext_vector_type(2)));
__device__ __forceinline__ unsigned pk2(float lo, float hi) { f32x2_t v = {lo, hi}; bf16x2_t b = __builtin_convertvector(v, bf16x2_t); return __builtin_bit_cast(unsigned, b); }
__device__ __forceinline__ float bf_lo(unsigned w) { return __builtin_bit_cast(float, w << 16); }
__device__ __forceinline__ float bf_hi(unsigned w) { return __builtin_bit_cast(float, w & 0xffff0000u); }
__device__ __forceinline__ s16x4 vtr(const LAS unsigned char* p) { return __builtin_bit_cast(s16x4, __builtin_amdgcn_ds_read_tr16_b64_v4i16((LAS v4i16_t*)p)); }
__device__ __forceinline__ int opaque(int v) { asm volatile("" : "+s"(v)); return v; }
__device__ __forceinline__ float wave_sum(float v) {
#pragma unroll
    for (int o = 1; o < 64; o <<= 1) v += __shfl_xor(v, o);
    return v;
}

#define XB_TMO      128
#define XB_XCNT(j)  (256  + 64 * (j))
#define XB_XSUB(j)  (1280 + 64 * (j))
#define XB_XGEN(j)  (2304 + 64 * (j))
#define XB_TOP      3328
#define XB_TOPGEN   3392
#define XCD_BAR_WORDS 3456
#define XB_SPIN_CAP (1u << 18)

__device__ __forceinline__ unsigned xb_ld(unsigned* p)              { return __hip_atomic_load(p, __ATOMIC_RELAXED, __HIP_MEMORY_SCOPE_AGENT); }
__device__ __forceinline__ unsigned xb_add(unsigned* p, unsigned v) { return __hip_atomic_fetch_add(p, v, __ATOMIC_RELAXED, __HIP_MEMORY_SCOPE_AGENT); }
__device__ __forceinline__ unsigned xb_xcc_id() { return (unsigned)__builtin_amdgcn_s_getreg((3 << 11) | 20) & 0xFu; }
#define XB_SPIN(cond, bar) do { unsigned _sp = 0; while (cond) { __builtin_amdgcn_s_sleep(1); \
    if ((++_sp & 255u) == 0u) { if (xb_ld(&(bar)[XB_TMO])) break; if (_sp > XB_SPIN_CAP) { atomicAdd(&(bar)[XB_TMO], 1u); break; } } } } while (0)

struct XcdBarrier {
    unsigned* bar; unsigned x;
    volatile LAS unsigned* st;
};

__device__ __forceinline__ XcdBarrier xcd_barrier_post(unsigned* bar, volatile LAS unsigned* st) {
    XcdBarrier b; b.bar = bar; b.x = xb_xcc_id(); b.st = st;
    if (threadIdx.x == 0) (void)xb_add(&bar[XB_XCNT(b.x)], 1u);
    return b;
}
__device__ __forceinline__ void xcd_barrier_complete(unsigned* bar, unsigned x, unsigned& nloc, unsigned& nx) {
    const unsigned G = gridDim.x * gridDim.y * gridDim.z;
    unsigned sum, cnt, mine, sp = 0u;
    for (;;) {
        sum = 0u; cnt = 0u; mine = 0u;
#pragma unroll
        for (unsigned j = 0; j < 16; ++j) { const unsigned c = xb_ld(&bar[XB_XCNT(j)]); sum += c; cnt += (c > 0u) ? 1u : 0u; mine = (j == x) ? c : mine; }
        if (sum == G) break;
        __builtin_amdgcn_s_sleep(1);
        if ((++sp & 255u) == 0u) { if (xb_ld(&bar[XB_TMO])) break; if (sp > XB_SPIN_CAP) { atomicAdd(&bar[XB_TMO], 1u); break; } }
    }
    nloc = mine > 0u ? mine : 1u; nx = cnt > 0u ? cnt : 1u;
}

__device__ __forceinline__ void xcd_barrier(const XcdBarrier& b) {
    asm volatile("s_waitcnt vmcnt(0)" ::: "memory");
    __syncthreads();
    if (threadIdx.x == 0) {
        unsigned* bar = b.bar;
        __builtin_amdgcn_s_waitcnt(0);
        unsigned nloc = b.st[0], nx = b.st[1];
        if (nloc == 0u) { xcd_barrier_complete(bar, b.x, nloc, nx); b.st[0] = nloc; b.st[1] = nx; }
        const unsigned old = xb_add(&bar[XB_XSUB(b.x)], 1u);
        const unsigned gen = old / nloc;
        if (old + 1u == (gen + 1u) * nloc) {
            __builtin_amdgcn_fence(__ATOMIC_RELEASE, "agent");
            asm volatile("s_waitcnt vmcnt(0)" ::: "memory");
            const unsigned og = xb_add(&bar[XB_TOP], 1u);
            const unsigned tg = og / nx;
            if (og + 1u == (tg + 1u) * nx) xb_add(&bar[XB_TOPGEN], 1u);
            else XB_SPIN(xb_ld(&bar[XB_TOPGEN]) == tg, bar);
            __builtin_amdgcn_fence(__ATOMIC_ACQUIRE, "agent");
            xb_add(&bar[XB_XGEN(b.x)], 1u);
            asm volatile("s_waitcnt vmcnt(0)" ::: "memory");
        } else {
            XB_SPIN(xb_ld(&bar[XB_XGEN(b.x)]) == gen, bar);
            __builtin_amdgcn_fence(__ATOMIC_ACQUIRE, "agent");
            asm volatile("s_waitcnt vmcnt(0)" ::: "memory");
        }
    }
    __syncthreads();
}

struct Args {
    const float *x_prompt, *x_sample, *norm_ffn1, *w1_gate, *w1_up, *w1_down, *norm_mix, *w_in, *sink, *vgain, *w_sp, *b_sp, *w_out, *norm_ffn2, *w2_gate, *w2_up, *w2_down, *norm_final;
    float* out; unsigned char* ws;
};

typedef const __attribute__((address_space(4))) Args* KArgs;
__device__ __forceinline__ KArgs kargs() { const __attribute__((address_space(4))) void* p = (const __attribute__((address_space(4))) void*)__builtin_amdgcn_kernarg_segment_ptr(); asm volatile("" : "+s"(p)); return (KArgs)p; }
__device__ __forceinline__ void conv_item(const float* W, int ldn, int K, const float* gain, bf16* WT, int dst_row0, int src_col0, int k0, LAS float* scr, int lane) {
    f32x4 v[8]; float g[8];
#pragma unroll
    for (int i = 0; i < 8; ++i) { const int kk = 8 * i + (lane >> 3); v[i] = *(const f32x4*)(W + (size_t)(k0 + kk) * ldn + src_col0 + 4 * (lane & 7)); g[i] = gain ? gain[k0 + kk] : 1.0f; }
#pragma unroll
    for (int i = 0; i < 8; ++i) { const int kk = 8 * i + (lane >> 3); LAS float* s = scr + kk * 33 + 4 * (lane & 7); s[0] = v[i][0] * g[i]; s[1] = v[i][1] * g[i]; s[2] = v[i][2] * g[i]; s[3] = v[i][3] * g[i]; }
    LDS_WAIT(); asm volatile("" ::: "memory");
    const int c = lane & 7;
#pragma unroll
    for (int j = 0; j < 4; ++j) { const int n = (lane >> 3) + 8 * j; const LAS float* s = scr + (8 * c) * 33 + n;
        v4u o; o.x = pk2(s[0 * 33], s[1 * 33]); o.y = pk2(s[2 * 33], s[3 * 33]); o.z = pk2(s[4 * 33], s[5 * 33]); o.w = pk2(s[6 * 33], s[7 * 33]);
        *(v4u*)(WT + (size_t)(dst_row0 + n) * K + k0 + 8 * c) = o; }
    LDS_WAIT(); asm volatile("" ::: "memory");
}
__device__ __forceinline__ void convert_layer(KArgs a, int l, LAS unsigned char* lds, int gw, int NGW, int wave, int lane, int it_lo, int it_hi) {
    LAS float* scr = (LAS float*)(lds + wave * 16384);
    bf16* Wb = l == 0 ? (bf16*)(a->ws + WS_W) : (bf16*)a->out;
    constexpr int I_GU = (2 * FF / 32) * (DM / 64), I_D = (DM / 32) * (FF / 64), I_IN = (NIN / 32) * (DM / 64), I_OUT = (DM / 32) * (DM / 64);
    constexpr int NITEMS = 2 * I_GU + 2 * I_D + I_IN + I_OUT;
    const int it_end = it_hi < NITEMS ? it_hi : NITEMS;
    for (int it = it_lo + gw; it < it_end; it += NGW) {
        int r = it; const float* src; const float* gain = nullptr; int ldn, K, nblk; size_t dsto; int kind;
        const float *gsrc = nullptr, *usrc = nullptr;
        if (r < I_GU) { kind = 1; gsrc = a->w1_gate + (size_t)l * DM * FF; usrc = a->w1_up + (size_t)l * DM * FF; gain = a->norm_ffn1 + l * DM; ldn = FF; K = DM; nblk = 2 * FF / 32; dsto = W_GU1; }
        else if ((r -= I_GU) < I_D) { kind = 0; gsrc = a->w1_down + (size_t)l * DM * FF; ldn = DM; K = FF; nblk = DM / 32; dsto = W_D1; }
        else if ((r -= I_D) < I_IN) { kind = 2; gsrc = a->w_in + (size_t)l * DM * NIN; gain = a->norm_mix + l * DM; ldn = NIN; K = DM; nblk = NIN / 32; dsto = W_IN; }
        else if ((r -= I_IN) < I_OUT) { kind = 0; gsrc = a->w_out + (size_t)l * DM * DM; ldn = DM; K = DM; nblk = DM / 32; dsto = W_OUT; }
        else if ((r -= I_OUT) < I_GU) { kind = 1; gsrc = a->w2_gate + (size_t)l * DM * FF; usrc = a->w2_up + (size_t)l * DM * FF; gain = a->norm_ffn2 + l * DM; ldn = FF; K = DM; nblk = 2 * FF / 32; dsto = W_GU2; }
        else { r -= I_GU; kind = 0; gsrc = a->w2_down + (size_t)l * DM * FF; ldn = DM; K = FF; nblk = DM / 32; dsto = W_D2; }
        const int kb = r / nblk, nb = r % nblk; int sc0 = 32 * nb; src = gsrc;
        if (kind == 1) { const int pn = nb >> 3, lb = nb & 7; src = lb < 4 ? gsrc : usrc; sc0 = 128 * pn + 32 * (lb & 3); }
        else if (kind == 2 && nb >= 40) { const int t = nb - 40, pnl = t >> 3, lb = t & 7, bj = lb >> 2, wc = lb & 3; sc0 = 1280 + 64 * (4 * pnl + wc) + 32 * bj; }
        conv_item(src, ldn, K, gain, (bf16*)((unsigned char*)Wb + dsto), 32 * nb, sc0, 64 * kb, scr, lane);
    }
}

constexpr int KS_STRIDE = 144;
constexpr int KS_BYTES = 384 * KS_STRIDE;
constexpr int TAB_OFF = 2 * KS_BYTES, TAB_N = 388, TAB_ZERO = 196;
static_assert(TAB_OFF + 4 * 4 * TAB_N * 4 <= LDSCTL_OFF, "LDS map");
constexpr float DEFER_THR = 10.0f;
constexpr int GS_STRIDE = 1040;
static_assert(128 * GS_STRIDE <= LDSCTL_OFF, "LDS map");
__device__ __forceinline__ void mixer_phase(KArgs a, int l, LAS unsigned char* lds, int G, int bid, int tid, int wave, int lane) {
    const bf16* Z = (const bf16*)(a->ws + WS_Z); bf16* MIX = (bf16*)(a->ws + WS_MIX);
    const int fr = lane & 15, fq = lane >> 4, tq = fr >> 2, tp = fr & 3;
    LAS unsigned char* Ks = lds; LAS unsigned char* Vs = lds + KS_BYTES; LAS unsigned char* Gs = lds;
#pragma unroll 1
    for (int blk = bid; blk < NBLK; blk += G) {
        const int sb = blk < 128 ? (blk & ~63) : (blk & ~15), se = sb + (blk < 128 ? 64 : 16);
        const bool has_prev = blk > sb, has_next = blk + 1 < se;
#ifndef MIX_NO_ATT
#ifndef REP_ATT
#define REP_ATT 1
#endif
#pragma unroll 1
        for (int kvh2 = 0; kvh2 < 2 * REP_ATT; ++kvh2) { const int kvh = kvh2 & 1;
            __syncthreads();
#pragma unroll
            for (int i = 0; i < 6; ++i) {
                const int id = tid + 512 * i, kj = id >> 3, c = id & 7, kb = kj >> 7;
                const bool ok = kb == 1 || (kb == 0 ? has_prev : has_next);
                v4u kv = (v4u){0u, 0u, 0u, 0u}, vv = (v4u){0u, 0u, 0u, 0u};
                if (ok) { const bf16* zr = Z + (size_t)(128 * (blk - 1) + kj) * NIN + 64 * kvh + 8 * c; kv = *(const v4u*)(zr + 512); vv = *(const v4u*)(zr + 640); }
                *(LAS v4u*)(Ks + kj * KS_STRIDE + c * 16) = kv; *(LAS v4u*)(Vs + kj * KS_STRIDE + c * 16) = vv;
            }
            {
                const v4u* tsrc = (const v4u*)(a->ws + WS_TAB) + kvh * (4 * TAB_N);
                if (tid < TAB_N) {
#pragma unroll
                    for (int i = 0; i < 4; ++i) *(LAS v4u*)(lds + TAB_OFF + 64 * tid + 16 * i) = tsrc[4 * tid + i];
                }
            }
            __syncthreads();
            {
                const int hq = kvh * 4 + (wave >> 1), half = wave & 1;
                const float sinkl = a->sink[l * 8 + hq] * pg8::K_LOG2E;
                bf16x8 qf[4][2];
#pragma unroll
                for (int qg = 0; qg < 4; ++qg)
#pragma unroll
                    for (int dk = 0; dk < 2; ++dk) qf[qg][dk] = *(const bf16x8*)(Z + (size_t)(128 * blk + 64 * half + 16 * qg + fr) * NIN + hq * 64 + 32 * dk + 8 * fq);
                f32x4 o[4][4];
#pragma unroll
                for (int db = 0; db < 4; ++db)
#pragma unroll
                    for (int qg = 0; qg < 4; ++qg) o[db][qg] = (f32x4){0.f, 0.f, 0.f, 0.f};
                float mrow[4], lsum[4];
#pragma unroll
                for (int qg = 0; qg < 4; ++qg) { mrow[qg] = sinkl; lsum[qg] = 0.f; }
                const int dl0 = 4 * fq - fr, kcp = dl0 & 3;
                const LAS unsigned char* tbl = lds + TAB_OFF + ((wave >> 1) * 4 + kcp) * (TAB_N * 4) + 4 * (dl0 - kcp + TAB_ZERO - 128 - 48);
#pragma unroll 2
                for (int kt = 0; kt < 10; ++kt) {
                    const int key0 = 64 * half + 32 * kt, tb = key0 >> 7;
                    if ((tb == 0 && !has_prev) || (tb == 2 && !has_next)) continue;
                    f32x4 s[2][4];
#pragma unroll
                    for (int kb = 0; kb < 2; ++kb)
#pragma unroll
                        for (int qg = 0; qg < 4; ++qg) s[kb][qg] = (f32x4){0.f, 0.f, 0.f, 0.f};
#pragma unroll
                    for (int kb = 0; kb < 2; ++kb)
#pragma unroll
                        for (int dk = 0; dk < 2; ++dk) {
                            const bf16x8 kf = *(const LAS bf16x8*)(Ks + (key0 + 16 * kb + fr) * KS_STRIDE + 64 * dk + 16 * fq);
#pragma unroll
                            for (int qg = 0; qg < 4; ++qg) s[kb][qg] = __builtin_amdgcn_mfma_f32_16x16x32_bf16(kf, qf[qg][dk], s[kb][qg], 0, 0, 0);
                        }
                    bf16x8 pb[4];
                    const LAS unsigned char* tbp = tbl + 128 * kt;
                    bool need = false;
#pragma unroll
                    for (int qg = 0; qg < 4; ++qg) {
#pragma unroll
                        for (int kb = 0; kb < 2; ++kb) s[kb][qg] = s[kb][qg] + *(const LAS f32x4*)(tbp + 64 * (kb - qg + 3));
                        const float lm = fmaxf(fmaxf(fmaxf(s[0][qg][0], s[0][qg][1]), fmaxf(s[0][qg][2], s[0][qg][3])), fmaxf(fmaxf(s[1][qg][0], s[1][qg][1]), fmaxf(s[1][qg][2], s[1][qg][3])));
                        need |= lm > mrow[qg] + DEFER_THR;
                    }
                    if (__builtin_amdgcn_readfirstlane(__any(need))) {
#pragma unroll
                        for (int qg = 0; qg < 4; ++qg) {
                            float mx = fmaxf(fmaxf(fmaxf(s[0][qg][0], s[0][qg][1]), fmaxf(s[0][qg][2], s[0][qg][3])), fmaxf(fmaxf(s[1][qg][0], s[1][qg][1]), fmaxf(s[1][qg][2], s[1][qg][3])));
                            mx = fmaxf(mx, mrow[qg]);
                            mx = fmaxf(mx, __shfl_xor(mx, 16)); mx = fmaxf(mx, __shfl_xor(mx, 32));
                            const float alpha = __builtin_amdgcn_exp2f(mrow[qg] - mx); mrow[qg] = mx;
                            lsum[qg] = lsum[qg] * alpha;
#pragma unroll
                            for (int db = 0; db < 4; ++db) o[db][qg] = o[db][qg] * alpha;
                        }
                    }
#pragma unroll
                    for (int qg = 0; qg < 4; ++qg) {
                        const float mx = mrow[qg];
                        float ps = 0.f;
#pragma unroll
                        for (int kb = 0; kb < 2; ++kb)
#pragma unroll
                            for (int j = 0; j < 4; ++j) { const float p = __builtin_amdgcn_exp2f(s[kb][qg][j] - mx); s[kb][qg][j] = p; ps += p; }
                        lsum[qg] += ps;
                        v4u w; w.x = pk2(s[0][qg][0], s[0][qg][1]); w.y = pk2(s[0][qg][2], s[0][qg][3]); w.z = pk2(s[1][qg][0], s[1][qg][1]); w.w = pk2(s[1][qg][2], s[1][qg][3]);
                        pb[qg] = __builtin_bit_cast(bf16x8, w);
                    }
#pragma unroll
                    for (int db = 0; db < 4; ++db) {
                        const LAS unsigned char* vp = Vs + (key0 + 4 * fq + tq) * KS_STRIDE + (16 * db + 4 * tp) * 2;
                        const s16x4 lo = vtr(vp), hi = vtr(vp + 16 * KS_STRIDE);
                        const bf16x8 vf = (bf16x8){lo[0], lo[1], lo[2], lo[3], hi[0], hi[1], hi[2], hi[3]};
#pragma unroll
                        for (int qg = 0; qg < 4; ++qg) o[db][qg] = __builtin_amdgcn_mfma_f32_16x16x32_bf16(vf, pb[qg], o[db][qg], 0, 0, 0);
                    }
                }
#pragma unroll
                for (int qg = 0; qg < 4; ++qg) {
                    float lt = lsum[qg]; lt += __shfl_xor(lt, 16); lt += __shfl_xor(lt, 32); lt += __builtin_amdgcn_exp2f(sinkl - mrow[qg]);
                    const float inv = 1.0f / lt;
                    bf16* op = MIX + (size_t)(128 * blk + 64 * half + 16 * qg + fr) * DM + hq * 64 + 4 * fq;
#pragma unroll
                    for (int db = 0; db < 4; ++db) { const f32x4 v = o[db][qg] * inv; v2u w; w.x = pk2(v[0], v[1]); w.y = pk2(v[2], v[3]); *(v2u*)(op + 16 * db) = w; }
                }
            }
        }
#endif
        {
            const int tidg = pg8::opaque_v(tid);
            const int h = wave;
            const v4u* wsb = (const v4u*)(a->ws + WS_WSB) + ((size_t)(l * 8 + h) * 32) * 64 + lane;
            v4u gl[16];
#pragma unroll
            for (int i = 0; i < 16; ++i) { const int id = tidg + 512 * i, srow = id >> 6, c = id & 63; gl[i] = *(const v4u*)(Z + (size_t)(128 * blk + srow) * NIN + 1280 + 8 * c); }
            __syncthreads();
#pragma unroll
            for (int i = 0; i < 16; ++i) { const int id = tidg + 512 * i, srow = id >> 6, c = id & 63; *(LAS v4u*)(Gs + srow * GS_STRIDE + c * 16) = gl[i]; }
#pragma unroll 1
            for (int th = 0; th < 2; ++th) {
                const int tbase = 64 * th;
                v4u wf[4][4]; v2u uu[4][4]; float bias[4];
#pragma unroll
                for (int tb = 0; tb < 4; ++tb) { const size_t row = (size_t)128 * blk + tbase + 16 * tb + fr; bias[tb] = a->b_sp[(l * 8 + h) * 128 + tbase + 16 * tb + fr];
#pragma unroll
                    for (int c = 0; c < 4; ++c) wf[tb][c] = wsb[((4 * th + tb) * 4 + c) * 64];
#pragma unroll
                    for (int db = 0; db < 4; ++db) uu[tb][db] = *(const v2u*)(Z + row * NIN + 768 + 64 * h + 16 * db + 4 * fq); }
                if (th == 0) __syncthreads();
                f32x4 d[4][4];
#pragma unroll
                for (int tb = 0; tb < 4; ++tb)
#pragma unroll
                    for (int db = 0; db < 4; ++db) d[tb][db] = (f32x4){0.f, 0.f, 0.f, 0.f};
#pragma unroll
                for (int c = 0; c < 4; ++c)
#pragma unroll
                    for (int db = 0; db < 4; ++db) {
                        const LAS unsigned char* gp = Gs + (32 * c + 8 * fq + tq) * GS_STRIDE + (64 * h + 16 * db + 4 * tp) * 2;
                        const s16x4 lo = vtr(gp), hi = vtr(gp + 4 * GS_STRIDE);
                        const bf16x8 af = (bf16x8){lo[0], lo[1], lo[2], lo[3], hi[0], hi[1], hi[2], hi[3]};
#pragma unroll
                        for (int tb = 0; tb < 4; ++tb) d[tb][db] = __builtin_amdgcn_mfma_f32_16x16x32_bf16(af, __builtin_bit_cast(bf16x8, wf[tb][c]), d[tb][db], 0, 0, 0);
                    }
#pragma unroll
                for (int tb = 0; tb < 4; ++tb) { const size_t row = (size_t)128 * blk + tbase + 16 * tb + fr;
#pragma unroll
                    for (int db = 0; db < 4; ++db) {
                        const int d0 = 64 * h + 16 * db + 4 * fq; const v2u u2 = uu[tb][db]; const f32x4 dv = d[tb][db]; const float bs = bias[tb];
                        v2u w; w.x = pk2(bf_lo(u2.x) * (dv[0] + bs), bf_hi(u2.x) * (dv[1] + bs)); w.y = pk2(bf_lo(u2.y) * (dv[2] + bs), bf_hi(u2.y) * (dv[3] + bs));
                        *(v2u*)(MIX + row * DM + 512 + d0) = w;
                    } }
            }
        }
    }
    __syncthreads();
}

#define GRID_SYNC1() do { XcdBarrier b_ = bar; b_.x = (unsigned)opaque((int)bar.x); xcd_barrier(b_); } while (0)
#ifdef DUP_SYNC
#define GRID_SYNC() do { GRID_SYNC1(); GRID_SYNC1(); } while (0)
#else
#define GRID_SYNC() GRID_SYNC1()
#endif
__global__ void __launch_bounds__(NWAVES * 64, 2) fwd_megakernel(Args a) {
    extern __shared__ __attribute__((aligned(16))) unsigned char lds_raw[];
    LAS unsigned char* lds = (LAS unsigned char*)lds_raw;
    cg::grid_group grid = cg::this_grid();
    const int tid = threadIdx.x, lane = tid & 63, wave = __builtin_amdgcn_readfirstlane(tid >> 6);
    const int G = gridDim.x, bid = blockIdx.x;
    const int vcu = (G % 8 == 0) ? (bid % 8) * (G / 8) + bid / 8 : bid;
    const int gw = vcu * NWAVES + wave, NGW = G * NWAVES;
    if (tid < 64) ((LAS unsigned*)(lds + LDSCTL_OFF))[tid] = 0u;
    __syncthreads();
    const XcdBarrier bar = xcd_barrier_post((unsigned*)(kargs()->ws + WS_BAR), (volatile LAS unsigned*)(lds + LDSCTL_OFF));
    grid.sync();
#define KA (kargs())
#define X (KA->out)
#define SS ((pg8::ss_t*)(KA->ws + WS_SS))
#define XB ((bf16*)(KA->ws + WS_XB))
#define Wb (l == 0 ? (bf16*)(KA->ws + WS_W) : (bf16*)KA->out)
#define Hb ((bf16*)(KA->ws + WS_H))
#define Zb ((bf16*)(KA->ws + WS_Z))
#define MIXb ((bf16*)(KA->ws + WS_MIX))

    { bf16* xb_ = XB; pg8::ss_t* ss_ = SS; const float* xp_ = KA->x_prompt; const float* xs_ = KA->x_sample;
    for (int r0 = gw; r0 < TOK; r0 += 4 * NGW) {
        f32x4 v[4][4];
#pragma unroll
        for (int q = 0; q < 4; ++q) { const int r = r0 + q * NGW; const float* src = r < TOKP ? xp_ + (size_t)r * DM : xs_ + (size_t)(r - TOKP) * DM;
#pragma unroll
            for (int j = 0; j < 4; ++j) v[q][j] = *(const f32x4*)(src + 256 * j + 4 * lane); }
#pragma unroll
        for (int q = 0; q < 4; ++q) { const int r = r0 + q * NGW; float s = 0.f;
#pragma unroll
            for (int j = 0; j < 4; ++j) { const f32x4 x = v[q][j]; v2u w; w.x = pk2(x[0], x[1]); w.y = pk2(x[2], x[3]); *(v2u*)(xb_ + (size_t)r * DM + 256 * j + 4 * lane) = w;
                s += (x[0] * x[0] + x[1] * x[1]) + (x[2] * x[2] + x[3] * x[3]); }
            s = wave_sum(s);
            if (lane == 0) ss_[r] = pg8::ss_fix(s); }
    }
    for (int i = bid * 512 + tid; i < 6 * TOK; i += G * 512) ss_[TOK + i] = 0ull; }
    {
        float* tab_ = (float*)(KA->ws + WS_TAB);
        for (int e = bid * 512 + tid; e < 8 * 4 * TAB_N; e += G * 512) {
            const int hd = e / (4 * TAB_N), k = (e / TAB_N) & 3, i = e % TAB_N, rel = i + k - TAB_ZERO, ad = rel < 0 ? -rel : rel;
            const float sl = __builtin_amdgcn_exp2f(-(float)(hd + 1)) * pg8::K_LOG2E;
            tab_[e] = ad <= 128 ? -sl * (float)ad : -INFINITY;
        }
    }
    {
        const float* wsp_ = KA->w_sp; v4u* wsb_ = (v4u*)(KA->ws + WS_WSB);
        for (int e = bid * 512 + tid; e < NLAYER * 8 * 32 * 64; e += G * 512) {
            const int ln = e & 63, f = e >> 6, c = f & 3, tb = (f >> 2) & 7, lh = f >> 5;
            const float* wp = wsp_ + ((size_t)lh * 128 + 16 * tb + (ln & 15)) * 128 + 32 * c + 8 * (ln >> 4);
            const f32x4 w0 = *(const f32x4*)wp, w1 = *(const f32x4*)(wp + 4);
            v4u o; o.x = pk2(w0[0], w0[1]); o.y = pk2(w0[2], w0[3]); o.z = pk2(w1[0], w1[1]); o.w = pk2(w1[2], w1[3]);
            wsb_[e] = o;
        }
    }
    const int l1_cut = (G == 256) ? L1_CUT : 0;
    convert_layer(kargs(), 0, lds, gw, NGW, wave, lane, 0, 1 << 30);
    convert_layer(kargs(), 1, lds, gw, NGW, wave, lane, l1_cut, 1 << 30);
    GRID_SYNC();

    for (int l = 0; l < NLAYER; ++l) {
        #define ssA (SS + (size_t)(3 * l) * TOK)
#define ssB (SS + (size_t)(3 * l + 1) * TOK)
#define ssC (SS + (size_t)(3 * l + 2) * TOK)
#define ssD (SS + (size_t)(3 * l + 3) * TOK)
        if (PH_MASK & 1) { pg8::Gemm g{XB, (const bf16*)((unsigned char*)Wb + W_GU1), TOK, 2 * FF, DM}; pg8::StaticOrder S; S.init(TOK, 2 * FF, G, opaque(bid));
          pg8::EpiSwiglu E{Hb, FF, ssA};
#ifdef DUP_PA
          pg8::gemm_phase<pg8::EpiSwiglu, pg8::StaticOrder, true, true>(lds, g, S, E); __syncthreads();
#endif
          pg8::gemm_phase<pg8::EpiSwiglu, pg8::StaticOrder, true, true>(lds, g, S, E); }
        GRID_SYNC();
        if (PH_MASK & 2) { pg8::Gemm g{Hb, (const bf16*)((unsigned char*)Wb + W_D1), TOK, DM, FF}; pg8::StaticOrder S; S.init(TOK, DM, G, opaque(bid));
          pg8::EpiResid E{XB, ssB, 0.5f};
#ifdef DUP_PB
          { pg8::EpiResid E0{XB, nullptr, 0.0f}; pg8::gemm_phase<pg8::EpiResid, pg8::StaticOrder, true, true>(lds, g, S, E0); __syncthreads(); }
#endif
          pg8::gemm_phase<pg8::EpiResid, pg8::StaticOrder, true, true>(lds, g, S, E); }
        GRID_SYNC();
        if (PH_MASK & 4) { pg8::Gemm g{XB, (const bf16*)((unsigned char*)Wb + W_IN), TOK, NIN, DM}; pg8::StaticOrder S; S.init(TOK, NIN, G, opaque(bid));
          pg8::EpiInProj E{Zb, ssB, KA->vgain + l * 512};
          pg8::gemm_phase<pg8::EpiInProj, pg8::StaticOrder, true, true>(lds, g, S, E); }
        if (l == 0 && G == 256 && bid >= 128) {
          const int t_ = pg8::opaque_v((int)threadIdx.x), w_ = __builtin_amdgcn_readfirstlane(t_ >> 6);
          convert_layer(kargs(), 1, lds, (opaque(bid) - 128) * NWAVES + w_, 128 * NWAVES, w_, t_ & 63, 0, L1_CUT); }
        GRID_SYNC();
#ifdef MIXER_COPY
        if (PH_MASK & 8) { for (size_t i = (size_t)bid * 512 + threadIdx.x; i < (size_t)TOK * 128; i += (size_t)G * 512) { const size_t r = i >> 7, c = i & 127; *(v4u*)(MIXb + r * DM + 8 * c) = *(const v4u*)(Zb + r * NIN + 8 * c); } }
#else
        if (PH_MASK & 8) { const int t_ = pg8::opaque_v((int)threadIdx.x); mixer_phase(kargs(), l, lds, G, opaque(vcu), t_, __builtin_amdgcn_readfirstlane(t_ >> 6), t_ & 63); }
#ifdef DUP_PD
        { const int t_ = pg8::opaque_v((int)threadIdx.x); mixer_phase(kargs(), l, lds, G, opaque(vcu), t_, __builtin_amdgcn_readfirstlane(t_ >> 6), t_ & 63); }
#endif
#endif
        GRID_SYNC();
        if (PH_MASK & 16) { pg8::Gemm g{MIXb, (const bf16*)((unsigned char*)Wb + W_OUT), TOK, DM, DM}; pg8::StaticOrder S; S.init(TOK, DM, G, opaque(bid));
          pg8::EpiResid E{XB, ssC, 1.0f};
#ifdef DUP_PB
          { pg8::EpiResid E0{XB, nullptr, 0.0f}; pg8::gemm_phase<pg8::EpiResid, pg8::StaticOrder, true, true>(lds, g, S, E0); __syncthreads(); }
#endif
          pg8::gemm_phase<pg8::EpiResid, pg8::StaticOrder, true, true>(lds, g, S, E); }
        GRID_SYNC();
        if (PH_MASK & 32) { pg8::Gemm g{XB, (const bf16*)((unsigned char*)Wb + W_GU2), TOK, 2 * FF, DM}; pg8::StaticOrder S; S.init(TOK, 2 * FF, G, opaque(bid));
          pg8::EpiSwiglu E{Hb, FF, ssC};
#ifdef DUP_PA
          pg8::gemm_phase<pg8::EpiSwiglu, pg8::StaticOrder, true, true>(lds, g, S, E); __syncthreads();
#endif
          pg8::gemm_phase<pg8::EpiSwiglu, pg8::StaticOrder, true, true>(lds, g, S, E); }
        GRID_SYNC();
        if (PH_MASK & 64) { pg8::Gemm g{Hb, (const bf16*)((unsigned char*)Wb + W_D2), TOK, DM, FF}; pg8::StaticOrder S; S.init(TOK, DM, G, opaque(bid));
          pg8::EpiResid E{XB, ssD, 0.5f};
#ifdef DUP_PB
          { pg8::EpiResid E0{XB, nullptr, 0.0f}; pg8::gemm_phase<pg8::EpiResid, pg8::StaticOrder, true, true>(lds, g, S, E0); __syncthreads(); }
#endif
          pg8::gemm_phase<pg8::EpiResid, pg8::StaticOrder, true, true>(lds, g, S, E); }
        GRID_SYNC();
    }
    {
        const int t_ = pg8::opaque_v((int)threadIdx.x), lane = t_ & 63, gw = opaque(vcu) * NWAVES + __builtin_amdgcn_readfirstlane(t_ >> 6);
        const pg8::ss_t* ssF = SS + (size_t)6 * TOK; const bf16* xb_ = XB; float* out_ = X;
        f32x4 gn[4];
#pragma unroll
        for (int j = 0; j < 4; ++j) gn[j] = *(const f32x4*)(KA->norm_final + 256 * j + 4 * lane);
        for (int r0 = gw; r0 < TOK; r0 += 4 * NGW) {
            v2u w[4][4]; pg8::ss_t sv[4];
#pragma unroll
            for (int q = 0; q < 4; ++q) { const int r = r0 + q * NGW; sv[q] = ssF[r];
#pragma unroll
                for (int j = 0; j < 4; ++j) w[q][j] = *(const v2u*)(xb_ + (size_t)r * DM + 256 * j + 4 * lane); }
#pragma unroll
            for (int q = 0; q < 4; ++q) { const int r = r0 + q * NGW; const float rs = pg8::rs_of(sv[q]);
#pragma unroll
                for (int j = 0; j < 4; ++j) { const f32x4 v = (f32x4){bf_lo(w[q][j].x), bf_hi(w[q][j].x), bf_lo(w[q][j].y), bf_hi(w[q][j].y)}; *(f32x4*)(out_ + (size_t)r * DM + 256 * j + 4 * lane) = v * rs * gn[j]; } }
        }
    }
}
#undef KA
#undef X
#undef SS
#undef XB
#undef Wb
#undef Hb
#undef Zb
#undef MIXb
#undef ssA
#undef ssB
#undef ssC
#undef ssD

extern "C" void kernel_launch(void* const* d_in, const int* in_sizes, int n_in, void* d_out, int out_size, void* d_ws, size_t ws_size, hipStream_t stream) {
    static int grid = 0;
    if (grid == 0) {
        if (n_in != 18 || out_size != TOK * DM || ws_size < WS_END) { fprintf(stderr, "kernel_launch: unexpected shapes (n_in %d out %d ws %zu, need %zu)\n", n_in, out_size, ws_size, (size_t)WS_END); grid = -1; return; }
        int dev = 0, cus = 0, per_cu = 0;
        if (hipGetDevice(&dev) != hipSuccess || hipDeviceGetAttribute(&cus, hipDeviceAttributeMultiprocessorCount, dev) != hipSuccess) { grid = -1; return; }
        if (hipFuncSetAttribute((const void*)fwd_megakernel, hipFuncAttributeMaxDynamicSharedMemorySize, LDS_BYTES) != hipSuccess) { fprintf(stderr, "kernel_launch: hipFuncSetAttribute failed\n"); grid = -1; return; }
        if (hipOccupancyMaxActiveBlocksPerMultiprocessor(&per_cu, (const void*)fwd_megakernel, NWAVES * 64, LDS_BYTES) != hipSuccess || per_cu < 1) { fprintf(stderr, "kernel_launch: occupancy query says %d\n", per_cu); per_cu = 1; }
        (void)hipGetLastError();
        grid = cus;
    }
    if (grid < 0) return;
    if (hipMemsetAsync((char*)d_ws + WS_BAR, 0, WS_BAR_BYTES, stream) != hipSuccess) { fprintf(stderr, "kernel_launch: memset failed\n"); return; }
    Args a{};
    const float** f = (const float**)&a;
    for (int i = 0; i < 18; ++i) f[i] = (const float*)d_in[i];
    a.out = (float*)d_out; a.ws = (unsigned char*)d_ws;
    void* args[] = {&a};
    hipError_t e = hipLaunchCooperativeKernel((const void*)fwd_megakernel, dim3(grid), dim3(NWAVES * 64), args, LDS_BYTES, stream);
    if (e != hipSuccess) fprintf(stderr, "kernel_launch: cooperative launch failed: %s (grid %d)\n", hipGetErrorString(e), grid);
}
```

```cpp
#include <hip/hip_runtime.h>
#include <hip/hip_cooperative_groups.h>
#include <cstdio>
#include <cstdint>
#include <cmath>
namespace cg = cooperative_groups;
namespace pg8 {
#define PG8_LAS __attribute__((address_space(3)))
typedef unsigned short bf16_t;
typedef short bf16x8 __attribute__((ext_vector_type(8)));
typedef float f32x4 __attribute__((ext_vector_type(4)));
typedef unsigned u32x4 __attribute__((ext_vector_type(4)));
constexpr int BM = 256, BK = 64, HALF = 128, HTB = HALF * BK * 2  , STAGE_BYTES = 8 * HTB, NXCD = 8, WGM = 8;

__host__ __device__ __forceinline__ int lds_byte(int r, int c) { const int st = (r >> 4) * 2 + (c >> 5), rr = r & 15, cc = c & 31, ob = rr * 64 + cc * 2; return st * 1024 + (ob ^ (((ob >> 9) & 1) << 5)); }
__host__ __device__ __forceinline__ void stage_rc(int b, int& R, int& C) { const int st = b / 1024, sb = b % 1024, swz = sb ^ (((sb >> 9) & 1) << 5); R = (st >> 1) * 16 + swz / 64; C = (st & 1) * 32 + (swz % 64) / 2; }
__host__ __device__ __forceinline__ int perm32(int rho) { const int n = rho >> 4, i = rho & 15; return 8 * (i >> 2) + 4 * n + (i & 3); }

struct Unit { int pm, pn; };
struct Gemm { const bf16_t* A; const bf16_t* Bt; int M, N, K; };

struct StaticOrder {
    int nM, nN, nwg, G, c;
    __host__ __device__ void init(int M, int N, int G_, int c_) { nM = M / BM; nN = N / BM; nwg = nM * nN; G = G_; c = c_; }
    __host__ __device__ bool next(int i, Unit& u) const {
        const long L = (long)i * G + c; if (L >= nwg) return false;
        int wgid = (int)L; { const int q = nwg / NXCD, r = nwg % NXCD, xcd = wgid % NXCD, off = wgid / NXCD; wgid = (xcd < r ? xcd * (q + 1) : r * (q + 1) + (xcd - r) * q) + off; }
        const int nig = WGM * nN, gid = wgid / nig, fm = gid * WGM, gsz = (nM - fm) < WGM ? (nM - fm) : WGM;
        u.pm = fm + ((wgid % nig) % gsz); u.pn = (wgid % nig) / gsz; return true;
    }
    __device__ __forceinline__ void a_ready(const Unit&) const {}
    __device__ __forceinline__ void done(const Unit&) const {}
};

__device__ __forceinline__ unsigned cvt_pk_bf16(float lo, float hi) { unsigned r; asm volatile("v_cvt_pk_bf16_f32 %0, %1, %2" : "=v"(r) : "v"(lo), "v"(hi)); return r; }
typedef float f32x2 __attribute__((ext_vector_type(2)));
constexpr float RMS_EPS = 1e-6f;
__device__ __forceinline__ int opaque_v(int v) { asm volatile("" : "+v"(v)); return v; }
constexpr float K_LOG2E = 1.4426950408889634f;
__device__ __forceinline__ float fast_exp2(float x) { return __builtin_amdgcn_exp2f(x); }
__device__ __forceinline__ float fast_rcp(float x) { return __builtin_amdgcn_rcpf(x); }
__device__ __forceinline__ float silu_f(float g) { return g * fast_rcp(1.0f + fast_exp2(-K_LOG2E * g)); }
__device__ __forceinline__ float gelu_tanh_f(float v) { const float t = v * (1.0f + 0.044715f * v * v); return v * fast_rcp(1.0f + fast_exp2(-2.3022081978f * t)); }
typedef unsigned long long ss_t;
constexpr float SS_SCALE = 1048576.0f;
__device__ __forceinline__ ss_t ss_fix(float s) { return (ss_t)(s * SS_SCALE + 0.5f); }
__device__ __forceinline__ float rs_of(ss_t v) { return __builtin_amdgcn_rsqf((float)v * (1.0f / (1024.0f * SS_SCALE)) + RMS_EPS); }
__device__ __forceinline__ float row_rs(const ss_t* ss, int row) { return __builtin_amdgcn_rsqf((float)ss[row] * (1.0f / (1024.0f * SS_SCALE)) + RMS_EPS); }

__device__ __forceinline__ f32x2 swiglu_pk(f32x2 ag, f32x2 au, float rsn, float rs2) {
    const f32x2 t = ag * rsn; f32x2 e; e.x = fast_exp2(t.x); e.y = fast_exp2(t.y);
    const f32x2 den = e + 1.0f; f32x2 r; r.x = fast_rcp(den.x); r.y = fast_rcp(den.y);
    return ((ag * au) * rs2) * r;
}
struct EpiSwiglu {
    static constexpr bool PERM = true, AFTER_DRAIN = false;
    bf16_t* H; int ldh; const ss_t* ss;
    __device__ __forceinline__ void operator()(const f32x4 (&acc)[2][2][4][2], const Unit& u, int wr, int wc, int fr, int fq) const {
        const int row0 = u.pm * BM + wr * 64 + fr, col0 = u.pn * HALF + wc * 32 + 8 * fq;
        ss_t sv[2][4];
#pragma unroll
        for (int ai = 0; ai < 2; ++ai)
#pragma unroll
            for (int m = 0; m < 4; ++m) sv[ai][m] = ss[row0 + ai * HALF + m * 16];
#pragma unroll
        for (int ai = 0; ai < 2; ++ai)
#pragma unroll
            for (int m = 0; m < 4; ++m) {
                const int row = row0 + ai * HALF + m * 16; const float rs = rs_of(sv[ai][m]), rsn = -K_LOG2E * rs, rs2 = rs * rs;
                const f32x4 ag0 = acc[ai][0][m][0], ag1 = acc[ai][0][m][1], au0 = acc[ai][1][m][0], au1 = acc[ai][1][m][1];
                const f32x2 h0 = swiglu_pk((f32x2){ag0[0], ag0[1]}, (f32x2){au0[0], au0[1]}, rsn, rs2), h1 = swiglu_pk((f32x2){ag0[2], ag0[3]}, (f32x2){au0[2], au0[3]}, rsn, rs2);
                const f32x2 h2 = swiglu_pk((f32x2){ag1[0], ag1[1]}, (f32x2){au1[0], au1[1]}, rsn, rs2), h3 = swiglu_pk((f32x2){ag1[2], ag1[3]}, (f32x2){au1[2], au1[3]}, rsn, rs2);
                u32x4 w; w.x = cvt_pk_bf16(h0.x, h0.y); w.y = cvt_pk_bf16(h1.x, h1.y); w.z = cvt_pk_bf16(h2.x, h2.y); w.w = cvt_pk_bf16(h3.x, h3.y);
                *(u32x4*)(H + (size_t)row * ldh + col0) = w;
                asm volatile("" ::: "memory");
            }
    }
};
__device__ __forceinline__ float bfl(unsigned w) { return __builtin_bit_cast(float, w << 16); }
__device__ __forceinline__ float bfh(unsigned w) { return __builtin_bit_cast(float, w & 0xffff0000u); }
struct EpiResid {
    static constexpr bool PERM = true, AFTER_DRAIN = false;
    bf16_t* XB; ss_t* ssn; float scale;
    __device__ __forceinline__ void operator()(const f32x4 (&acc)[2][2][4][2], const Unit& u, int wr, int wc, int fr, int fq) const {
        const int row0 = u.pm * BM + wr * 64 + fr, col0 = u.pn * BM + wc * 32 + 8 * fq;
#pragma unroll
        for (int ai = 0; ai < 2; ++ai) {
            u32x4 xw[4][2];
#pragma unroll
            for (int m = 0; m < 4; ++m)
#pragma unroll
                for (int bj = 0; bj < 2; ++bj) xw[m][bj] = *(const u32x4*)(XB + (size_t)(row0 + ai * HALF + m * 16) * 1024 + col0 + bj * HALF);
#pragma unroll
            for (int m = 0; m < 4; ++m) {
                const int row = row0 + ai * HALF + m * 16; float s = 0.f;
#pragma unroll
                for (int bj = 0; bj < 2; ++bj) {
                    bf16_t* xp = XB + (size_t)row * 1024 + col0 + bj * HALF;
                    const u32x4 w0 = xw[m][bj];
                    f32x4 x0 = (f32x4){bfl(w0.x), bfh(w0.x), bfl(w0.y), bfh(w0.y)}, x1 = (f32x4){bfl(w0.z), bfh(w0.z), bfl(w0.w), bfh(w0.w)};
                    x0 = x0 + acc[ai][bj][m][0] * scale; x1 = x1 + acc[ai][bj][m][1] * scale;
                    s += (x0[0] * x0[0] + x0[1] * x0[1]) + (x0[2] * x0[2] + x0[3] * x0[3]) + (x1[0] * x1[0] + x1[1] * x1[1]) + (x1[2] * x1[2] + x1[3] * x1[3]);
                    u32x4 w; w.x = cvt_pk_bf16(x0[0], x0[1]); w.y = cvt_pk_bf16(x0[2], x0[3]); w.z = cvt_pk_bf16(x1[0], x1[1]); w.w = cvt_pk_bf16(x1[2], x1[3]);
                    *(u32x4*)xp = w;
                }
                s += __shfl_xor(s, 16); s += __shfl_xor(s, 32);
                if (fq == 0 && ssn) atomicAdd(ssn + row, ss_fix(s));
            }
            asm volatile("" ::: "memory");
        }
    }
};
struct EpiInProj {
    static constexpr bool PERM = true, AFTER_DRAIN = false;
    bf16_t* Z; const ss_t* ss; const float* vgain;
    __device__ __forceinline__ void operator()(const f32x4 (&acc)[2][2][4][2], const Unit& u, int wr, int wc, int fr, int fq) const {
        const int row0 = u.pm * BM + wr * 64 + fr, pn = u.pn;
        const int mode = pn < 2 ? 0 : (pn == 2 ? 1 : (pn < 5 ? 2 : 3));
        int colb[2]; f32x4 gv[2][2];
#pragma unroll
        for (int bj = 0; bj < 2; ++bj) {
            colb[bj] = mode == 3 ? 1280 + 64 * (4 * (pn - 5) + wc) + 32 * bj + 8 * fq : 256 * pn + 128 * bj + 32 * wc + 8 * fq;
#pragma unroll
            for (int n = 0; n < 2; ++n) gv[bj][n] = mode == 3 ? *(const f32x4*)(vgain + (colb[bj] - 1280) + 4 * n) : (f32x4){1.f, 1.f, 1.f, 1.f};
        }
        ss_t sv[2][4];
#pragma unroll
        for (int ai = 0; ai < 2; ++ai)
#pragma unroll
            for (int m = 0; m < 4; ++m) sv[ai][m] = ss[row0 + ai * HALF + m * 16];
#pragma unroll
        for (int ai = 0; ai < 2; ++ai)
#pragma unroll
            for (int m = 0; m < 4; ++m) {
                const int row = row0 + ai * HALF + m * 16; const float rs = rs_of(sv[ai][m]);
                f32x4 v[2][2];
#pragma unroll
                for (int bj = 0; bj < 2; ++bj)
#pragma unroll
                    for (int n = 0; n < 2; ++n) v[bj][n] = acc[ai][bj][m][n] * rs;
                if (mode == 0) {
#pragma unroll
                    for (int bj = 0; bj < 2; ++bj)
#pragma unroll
                        for (int n = 0; n < 2; ++n) v[bj][n] = v[bj][n] * (0.125f * K_LOG2E);
                } else if (mode >= 2) {
#pragma unroll
                    for (int bj = 0; bj < 2; ++bj)
#pragma unroll
                        for (int n = 0; n < 2; ++n)
#pragma unroll
                            for (int e = 0; e < 4; ++e) v[bj][n][e] = gelu_tanh_f(v[bj][n][e]);
                    if (mode == 3) {
                        float q = 0.f;
#pragma unroll
                        for (int bj = 0; bj < 2; ++bj)
#pragma unroll
                            for (int n = 0; n < 2; ++n) q += (v[bj][n][0] * v[bj][n][0] + v[bj][n][1] * v[bj][n][1]) + (v[bj][n][2] * v[bj][n][2] + v[bj][n][3] * v[bj][n][3]);
                        q += __shfl_xor(q, 16); q += __shfl_xor(q, 32);
                        const float r2 = __builtin_amdgcn_rsqf(q * (1.0f / 64.0f) + RMS_EPS);
#pragma unroll
                        for (int bj = 0; bj < 2; ++bj)
#pragma unroll
                            for (int n = 0; n < 2; ++n) v[bj][n] = v[bj][n] * r2 * gv[bj][n];
                    }
                }
#pragma unroll
                for (int bj = 0; bj < 2; ++bj) {
                    u32x4 w; w.x = cvt_pk_bf16(v[bj][0][0], v[bj][0][1]); w.y = cvt_pk_bf16(v[bj][0][2], v[bj][0][3]); w.z = cvt_pk_bf16(v[bj][1][0], v[bj][1][1]); w.w = cvt_pk_bf16(v[bj][1][2], v[bj][1][3]);
                    *(u32x4*)(Z + (size_t)row * 1792 + colb[bj]) = w;
                }
                asm volatile("" ::: "memory");
            }
    }
};

template <class Epi, class Sched, bool ALIGN_EPI = false, bool SP2 = false>
__device__ __forceinline__ void gemm_phase(PG8_LAS unsigned char* lds, const Gemm g, const Sched& S, const Epi& E) {
    const int tid = opaque_v((int)threadIdx.x), wid = __builtin_amdgcn_readfirstlane(tid >> 6), lane = tid & 63, wr = wid >> 2, wc = wid & 3, fr = lane & 15, fq = lane >> 4;
    const int K = g.K, nt = K / BK;
    unsigned voffA[2], voffB[2];
#pragma unroll
    for (int i = 0; i < 2; ++i) { int R, C; stage_rc(tid * 16 + i * 8192, R, C); const int Rb = Epi::PERM ? ((R & ~31) + perm32(R & 31)) : R;
        voffA[i] = (unsigned)(R * K + C) * 2u; voffB[i] = (unsigned)(Rb * K + C) * 2u; }
    const size_t kstep = (size_t)(BK * 2);
    const size_t hstep = (size_t)HALF * K * 2;
    const size_t tstep = 2 * hstep;
    const unsigned ldsw = (unsigned)wid * 1024u;
    const int aoff = lds_byte(wr * 64 + fr, fq * 8), boff = lds_byte(wc * 32 + fr, fq * 8);
#define PG8_SA(b, h) (((b) * 2 + (h)) * HTB)
#define PG8_SB(b, h) ((4 + (b) * 2 + (h)) * HTB)
#define PG8_STAGE(bufoff, gbase, voff) do { _Pragma("unroll") for (int _i = 0; _i < 2; ++_i) \
        __builtin_amdgcn_global_load_lds((const unsigned*)((const char*)(gbase) + (voff)[_i]), (PG8_LAS unsigned*)(lds + (bufoff) + ldsw + _i * 8192), 16, 0, 0); } while (0)
#define PG8_LDA(dst, b, h) do { _Pragma("unroll") for (int m = 0; m < 4; ++m) _Pragma("unroll") for (int k = 0; k < 2; ++k) dst[m][k] = *(const PG8_LAS bf16x8*)(lds + PG8_SA(b, h) + aoff + m * 2048 + k * 1024); } while (0)
#define PG8_LDB(dst, b, h) do { _Pragma("unroll") for (int n = 0; n < 2; ++n) _Pragma("unroll") for (int k = 0; k < 2; ++k) dst[n][k] = *(const PG8_LAS bf16x8*)(lds + PG8_SB(b, h) + boff + n * 2048 + k * 1024); } while (0)
#define PG8_MMA(ai, bj, At, Bt) do { __builtin_amdgcn_s_setprio(1); _Pragma("unroll") for (int m = 0; m < 4; ++m) _Pragma("unroll") for (int n = 0; n < 2; ++n) _Pragma("unroll") for (int k = 0; k < 2; ++k) \
        acc[ai][bj][m][n] = __builtin_amdgcn_mfma_f32_16x16x32_bf16(Bt[n][k], At[m][k], acc[ai][bj][m][n], 0, 0, 0); __builtin_amdgcn_s_setprio(0); } while (0)
#define PG8_WAIT_V(n) asm volatile("s_waitcnt vmcnt(" #n ")" ::: "memory")
#define PG8_WAIT_L(n) asm volatile("s_waitcnt lgkmcnt(" #n ")" ::: "memory")
#define PG8_BAR __builtin_amdgcn_s_barrier()
#define PG8_SCHED __builtin_amdgcn_sched_barrier(0)
    Unit cur, nxt; int ui = 0;
    if (!S.next(0, cur)) return;
    f32x4 acc[2][2][4][2];
#pragma unroll
    for (int a = 0; a < 2; ++a)
#pragma unroll
        for (int b = 0; b < 2; ++b)
#pragma unroll
            for (int m = 0; m < 4; ++m)
#pragma unroll
                for (int n = 0; n < 2; ++n) acc[a][b][m][n] = (f32x4){0.f, 0.f, 0.f, 0.f};
    bf16x8 At[4][2], B0[2][2], B1[2][2];
    const char* cA = (const char*)g.A + (size_t)cur.pm * tstep; const char* cB = (const char*)g.Bt + (size_t)cur.pn * tstep;
    S.a_ready(cur);
    if constexpr (SP2) {
        PG8_STAGE(PG8_SB(0, 0), cB, voffB); PG8_STAGE(PG8_SB(0, 1), cB + hstep, voffB); PG8_STAGE(PG8_SA(0, 0), cA, voffA); PG8_STAGE(PG8_SA(0, 1), cA + hstep, voffA);
        if (wr == 1) PG8_BAR;
        PG8_WAIT_V(2); PG8_BAR;
        PG8_STAGE(PG8_SB(1, 0), cB + kstep, voffB); PG8_STAGE(PG8_SA(1, 0), cA + kstep, voffA); PG8_STAGE(PG8_SB(1, 1), cB + hstep + kstep, voffB);
        PG8_WAIT_V(6); PG8_BAR;
    } else {
        PG8_STAGE(PG8_SB(0, 0), cB, voffB); PG8_STAGE(PG8_SA(0, 0), cA, voffA); PG8_STAGE(PG8_SB(0, 1), cB + hstep, voffB); PG8_STAGE(PG8_SA(0, 1), cA + hstep, voffA);
        if (wr == 1) PG8_BAR;
        PG8_WAIT_V(4); PG8_BAR;
        PG8_STAGE(PG8_SB(1, 0), cB + kstep, voffB); PG8_STAGE(PG8_SA(1, 0), cA + kstep, voffA); PG8_STAGE(PG8_SB(1, 1), cB + hstep + kstep, voffB);
        PG8_WAIT_V(6); PG8_BAR;
    }
    for (;;) {
        const bool has_next = S.next(ui + 1, nxt);
        const char* nA = has_next ? (const char*)g.A + (size_t)nxt.pm * tstep : cA; const char* nB = has_next ? (const char*)g.Bt + (size_t)nxt.pn * tstep : cB;
        for (int t = 0; t < nt; t += 2) {
            const bool last = (t == nt - 2);
            const char* a1 = cA + (size_t)(t + 1) * kstep;
            const char* a2 = last ? nA : cA + (size_t)(t + 2) * kstep; const char* b2 = last ? nB : cB + (size_t)(t + 2) * kstep;
            const char* a3 = a2 + kstep; const char* b3 = b2 + kstep;
            if (last && has_next) S.a_ready(nxt);
            if constexpr (SP2) {
            PG8_LDB(B0, 0, 0); PG8_LDB(B1, 0, 1); PG8_SCHED; PG8_LDA(At, 0, 0); PG8_STAGE(PG8_SA(1, 1), a1 + hstep, voffA);
            PG8_WAIT_V(8); PG8_WAIT_L(0); PG8_BAR; PG8_MMA(0, 0, At, B0); PG8_MMA(0, 1, At, B1); PG8_BAR; PG8_SCHED;
            PG8_LDA(At, 0, 1); PG8_STAGE(PG8_SB(0, 0), b2, voffB); PG8_STAGE(PG8_SB(0, 1), b2 + hstep, voffB); PG8_STAGE(PG8_SA(0, 0), a2, voffA);
            PG8_WAIT_V(8); PG8_WAIT_L(0); PG8_BAR; PG8_MMA(1, 0, At, B0); PG8_MMA(1, 1, At, B1); PG8_BAR; PG8_SCHED;
            PG8_LDB(B0, 1, 0); PG8_LDB(B1, 1, 1); PG8_SCHED; PG8_LDA(At, 1, 0); PG8_STAGE(PG8_SA(0, 1), a2 + hstep, voffA);
            PG8_WAIT_V(8); PG8_WAIT_L(0); PG8_BAR; PG8_MMA(0, 0, At, B0); PG8_MMA(0, 1, At, B1); PG8_BAR; PG8_SCHED;
            PG8_LDA(At, 1, 1); PG8_STAGE(PG8_SB(1, 0), b3, voffB); PG8_STAGE(PG8_SB(1, 1), b3 + hstep, voffB); PG8_STAGE(PG8_SA(1, 0), a3, voffA);
            PG8_WAIT_V(8); PG8_WAIT_L(0); PG8_BAR; PG8_MMA(1, 0, At, B0); PG8_MMA(1, 1, At, B1); PG8_BAR; PG8_SCHED;
            } else {
            PG8_LDB(B0, 0, 0); PG8_SCHED; PG8_LDA(At, 0, 0); PG8_STAGE(PG8_SA(1, 1), a1 + hstep, voffA);
            PG8_WAIT_L(8); PG8_BAR; PG8_WAIT_L(0); PG8_MMA(0, 0, At, B0); PG8_BAR; PG8_SCHED;
            PG8_LDB(B1, 0, 1); PG8_STAGE(PG8_SB(0, 0), b2, voffB);
            PG8_BAR; PG8_WAIT_L(0); PG8_MMA(0, 1, At, B1); PG8_BAR;
            PG8_LDA(At, 0, 1); PG8_STAGE(PG8_SA(0, 0), a2, voffA);
            PG8_BAR; PG8_WAIT_L(0); PG8_MMA(1, 0, At, B0); PG8_BAR; PG8_SCHED;
            PG8_STAGE(PG8_SB(0, 1), b2 + hstep, voffB);
            PG8_WAIT_V(6); PG8_BAR; PG8_MMA(1, 1, At, B1); PG8_BAR;
            PG8_LDB(B0, 1, 0); PG8_SCHED; PG8_LDA(At, 1, 0); PG8_STAGE(PG8_SA(0, 1), a2 + hstep, voffA);
            PG8_WAIT_L(8); PG8_BAR; PG8_WAIT_L(0); PG8_MMA(0, 0, At, B0); PG8_BAR; PG8_SCHED;
            PG8_LDB(B1, 1, 1); PG8_STAGE(PG8_SB(1, 0), b3, voffB);
            PG8_BAR; PG8_WAIT_L(0); PG8_MMA(0, 1, At, B1); PG8_BAR;
            PG8_LDA(At, 1, 1); PG8_STAGE(PG8_SA(1, 0), a3, voffA);
            PG8_BAR; PG8_WAIT_L(0); PG8_MMA(1, 0, At, B0); PG8_BAR; PG8_SCHED;
            PG8_STAGE(PG8_SB(1, 1), b3 + hstep, voffB);
            PG8_WAIT_V(6); PG8_BAR; PG8_MMA(1, 1, At, B1); PG8_BAR;
            }
        }
        if constexpr (ALIGN_EPI) { if (wr == 0) PG8_BAR; }
        if constexpr (!Epi::AFTER_DRAIN) { E(acc, cur, wr, wc, fr, fq); S.done(cur); }
        if (!has_next) break;
#pragma unroll
        for (int a = 0; a < 2; ++a)
#pragma unroll
            for (int b = 0; b < 2; ++b)
#pragma unroll
                for (int m = 0; m < 4; ++m)
#pragma unroll
                    for (int n = 0; n < 2; ++n) acc[a][b][m][n] = (f32x4){0.f, 0.f, 0.f, 0.f};
        cur = nxt; cA = nA; cB = nB; ++ui;
        if constexpr (ALIGN_EPI) { if (wr == 1) PG8_BAR; }
    }
    PG8_WAIT_V(0);
    if constexpr (!ALIGN_EPI) { if (wr == 0) PG8_BAR; }
    PG8_BAR;
    if constexpr (Epi::AFTER_DRAIN) { E.fused(acc, cur, wr, wc, fr, fq, lds, wid, lane); S.done(cur); }
#undef PG8_SA
#undef PG8_SB
#undef PG8_STAGE
#undef PG8_LDA
#undef PG8_LDB
#undef PG8_MMA
#undef PG8_WAIT_V
#undef PG8_WAIT_L
#undef PG8_BAR
#undef PG8_SCHED
}
}

#ifndef PH_MASK
#define PH_MASK 127
#endif
#ifndef N_LAYER
#define N_LAYER 2
#endif
constexpr int NWAVES = 8;
#ifndef L1_CUT
#define L1_CUT 7168
#endif
constexpr int TOK = 32768, TOKP = 16384, DM = 1024, FF = 2816, NIN = 1792, NLAYER = N_LAYER, NBLK = TOK / 128;
constexpr size_t WS_SS = 0;
constexpr size_t WS_W = 2u << 20;
constexpr size_t W_GU1 = 0, W_D1 = W_GU1 + (size_t)2 * FF * DM * 2, W_IN = W_D1 + (size_t)DM * FF * 2, W_OUT = W_IN + (size_t)NIN * DM * 2,
                 W_GU2 = W_OUT + (size_t)DM * DM * 2, W_D2 = W_GU2 + (size_t)2 * FF * DM * 2, W_BYTES = W_D2 + (size_t)DM * FF * 2;
constexpr size_t WS_XB = WS_W + W_BYTES;
constexpr size_t WS_R1 = WS_XB + (size_t)TOK * DM * 2;
constexpr size_t WS_Z = WS_R1, WS_MIX = WS_R1 + (size_t)TOK * NIN * 2, WS_H = WS_R1;
constexpr size_t WS_WSB = WS_R1 + (size_t)TOK * FF * 2;
constexpr size_t WS_TAB = WS_WSB + (size_t)NLAYER * 8 * 128 * 128 * 2;
constexpr size_t WS_END = WS_TAB + (size_t)8 * 4 * 388 * 4;
static_assert(WS_MIX + (size_t)TOK * DM * 2 == WS_WSB && WS_XB % 256 == 0 && WS_R1 % 256 == 0, "d_ws map");
constexpr int LDSCTL_OFF = 147456 - 256;
constexpr size_t WS_BAR = 0x1D0000, WS_BAR_BYTES = 16384;
constexpr int LDS_BYTES = 147456;

#define LAS __attribute__((address_space(3)))
typedef unsigned short bf16;
typedef unsigned v4u __attribute__((ext_vector_type(4)));
typedef unsigned v2u __attribute__((ext_vector_type(2)));
typedef float f32x4 __attribute__((ext_vector_type(4)));
typedef short bf16x8 __attribute__((ext_vector_type(8)));
typedef short s16x4 __attribute__((ext_vector_type(4)));
typedef short v4i16_t __attribute__((ext_vector_type(4)));
#define LDS_WAIT() asm volatile("s_waitcnt lgkmcnt(0)" ::: "memory")
typedef float f32x2_t __attribute__((ext_vector_type(2)));
typedef __bf16 bf16x2_t __attribute__((ext_vector_type(2)));
__device__ __forceinline__ unsigned pk2(float lo, float hi) { f32x2_t v = {lo, hi}; bf16x2_t b = __builtin_convertvector(v, bf16x2_t); return __builtin_bit_cast(unsigned, b); }
__device__ __forceinline__ float bf_lo(unsigned w) { return __builtin_bit_cast(float, w << 16); }
__device__ __forceinline__ float bf_hi(unsigned w) { return __builtin_bit_cast(float, w & 0xffff0000u); }
__device__ __forceinline__ s16x4 vtr(const LAS unsigned char* p) { return __builtin_bit_cast(s16x4, __builtin_amdgcn_ds_read_tr16_b64_v4i16((LAS v4i16_t*)p)); }
__device__ __forceinline__ int opaque(int v) { asm volatile("" : "+s"(v)); return v; }
__device__ __forceinline__ float wave_sum(float v) {
#pragma unroll
    for (int o = 1; o < 64; o <<= 1) v += __shfl_xor(v, o);
    return v;
}

#define XB_TMO      128
#define XB_XCNT(j)  (256  + 64 * (j))
#define XB_XSUB(j)  (1280 + 64 * (j))
#define XB_XGEN(j)  (2304 + 64 * (j))
#define XB_TOP      3328
#define XB_TOPGEN   3392
#define XCD_BAR_WORDS 3456
#define XB_SPIN_CAP (1u << 18)

__device__ __forceinline__ unsigned xb_ld(unsigned* p)              { return __hip_atomic_load(p, __ATOMIC_RELAXED, __HIP_MEMORY_SCOPE_AGENT); }
__device__ __forceinline__ unsigned xb_add(unsigned* p, unsigned v) { return __hip_atomic_fetch_add(p, v, __ATOMIC_RELAXED, __HIP_MEMORY_SCOPE_AGENT); }
__device__ __forceinline__ unsigned xb_xcc_id() { return (unsigned)__builtin_amdgcn_s_getreg((3 << 11) | 20) & 0xFu; }
#define XB_SPIN(cond, bar) do { unsigned _sp = 0; while (cond) { __builtin_amdgcn_s_sleep(1); \
    if ((++_sp & 255u) == 0u) { if (xb_ld(&(bar)[XB_TMO])) break; if (_sp > XB_SPIN_CAP) { atomicAdd(&(bar)[XB_TMO], 1u); break; } } } } while (0)

struct XcdBarrier {
    unsigned* bar; unsigned x;
    volatile LAS unsigned* st;
};

__device__ __forceinline__ XcdBarrier xcd_barrier_post(unsigned* bar, volatile LAS unsigned* st) {
    XcdBarrier b; b.bar = bar; b.x = xb_xcc_id(); b.st = st;
    if (threadIdx.x == 0) (void)xb_add(&bar[XB_XCNT(b.x)], 1u);
    return b;
}
__device__ __forceinline__ void xcd_barrier_complete(unsigned* bar, unsigned x, unsigned& nloc, unsigned& nx) {
    const unsigned G = gridDim.x * gridDim.y * gridDim.z;
    unsigned sum, cnt, mine, sp = 0u;
    for (;;) {
        sum = 0u; cnt = 0u; mine = 0u;
#pragma unroll
        for (unsigned j = 0; j < 16; ++j) { const unsigned c = xb_ld(&bar[XB_XCNT(j)]); sum += c; cnt += (c > 0u) ? 1u : 0u; mine = (j == x) ? c : mine; }
        if (sum == G) break;
        __builtin_amdgcn_s_sleep(1);
        if ((++sp & 255u) == 0u) { if (xb_ld(&bar[XB_TMO])) break; if (sp > XB_SPIN_CAP) { atomicAdd(&bar[XB_TMO], 1u); break; } }
    }
    nloc = mine > 0u ? mine : 1u; nx = cnt > 0u ? cnt : 1u;
}

__device__ __forceinline__ void xcd_barrier(const XcdBarrier& b) {
    asm volatile("s_waitcnt vmcnt(0)" ::: "memory");
    __syncthreads();
    if (threadIdx.x == 0) {
        unsigned* bar = b.bar;
        __builtin_amdgcn_s_waitcnt(0);
        unsigned nloc = b.st[0], nx = b.st[1];
        if (nloc == 0u) { xcd_barrier_complete(bar, b.x, nloc, nx); b.st[0] = nloc; b.st[1] = nx; }
        const unsigned old = xb_add(&bar[XB_XSUB(b.x)], 1u);
        const unsigned gen = old / nloc;
        if (old + 1u == (gen + 1u) * nloc) {
            __builtin_amdgcn_fence(__ATOMIC_RELEASE, "agent");
            asm volatile("s_waitcnt vmcnt(0)" ::: "memory");
            const unsigned og = xb_add(&bar[XB_TOP], 1u);
            const unsigned tg = og / nx;
            if (og + 1u == (tg + 1u) * nx) xb_add(&bar[XB_TOPGEN], 1u);
            else XB_SPIN(xb_ld(&bar[XB_TOPGEN]) == tg, bar);
            __builtin_amdgcn_fence(__ATOMIC_ACQUIRE, "agent");
            xb_add(&bar[XB_XGEN(b.x)], 1u);
            asm volatile("s_waitcnt vmcnt(0)" ::: "memory");
        } else {
            XB_SPIN(xb_ld(&bar[XB_XGEN(b.x)]) == gen, bar);
            __builtin_amdgcn_fence(__ATOMIC_ACQUIRE, "agent");
            asm volatile("s_waitcnt vmcnt(0)" ::: "memory");
        }
    }
    __syncthreads();
}

struct Args {
    const float *x_prompt, *x_sample, *norm_ffn1, *w1_gate, *w1_up, *w1_down, *norm_mix, *w_in, *sink, *vgain, *w_sp, *b_sp, *w_out, *norm_ffn2, *w2_gate, *w2_up, *w2_down, *norm_final;
    float* out; unsigned char* ws;
};

typedef const __attribute__((address_space(4))) Args* KArgs;
__device__ __forceinline__ KArgs kargs() { const __attribute__((address_space(4))) void* p = (const __attribute__((address_space(4))) void*)__builtin_amdgcn_kernarg_segment_ptr(); asm volatile("" : "+s"(p)); return (KArgs)p; }
__device__ __forceinline__ void conv_item(const float* W, int ldn, int K, const float* gain, bf16* WT, int dst_row0, int src_col0, int k0, LAS float* scr, int lane) {
    f32x4 v[8]; float g[8];
#pragma unroll
    for (int i = 0; i < 8; ++i) { const int kk = 8 * i + (lane >> 3); v[i] = *(const f32x4*)(W + (size_t)(k0 + kk) * ldn + src_col0 + 4 * (lane & 7)); g[i] = gain ? gain[k0 + kk] : 1.0f; }
#pragma unroll
    for (int i = 0; i < 8; ++i) { const int kk = 8 * i + (lane >> 3); LAS float* s = scr + kk * 33 + 4 * (lane & 7); s[0] = v[i][0] * g[i]; s[1] = v[i][1] * g[i]; s[2] = v[i][2] * g[i]; s[3] = v[i][3] * g[i]; }
    LDS_WAIT(); asm volatile("" ::: "memory");
    const int c = lane & 7;
#pragma unroll
    for (int j = 0; j < 4; ++j) { const int n = (lane >> 3) + 8 * j; const LAS float* s = scr + (8 * c) * 33 + n;
        v4u o; o.x = pk2(s[0 * 33], s[1 * 33]); o.y = pk2(s[2 * 33], s[3 * 33]); o.z = pk2(s[4 * 33], s[5 * 33]); o.w = pk2(s[6 * 33], s[7 * 33]);
        *(v4u*)(WT + (size_t)(dst_row0 + n) * K + k0 + 8 * c) = o; }
    LDS_WAIT(); asm volatile("" ::: "memory");
}
__device__ __forceinline__ void convert_layer(KArgs a, int l, LAS unsigned char* lds, int gw, int NGW, int wave, int lane, int it_lo, int it_hi) {
    LAS float* scr = (LAS float*)(lds + wave * 16384);
    bf16* Wb = l == 0 ? (bf16*)(a->ws + WS_W) : (bf16*)a->out;
    constexpr int I_GU = (2 * FF / 32) * (DM / 64), I_D = (DM / 32) * (FF / 64), I_IN = (NIN / 32) * (DM / 64), I_OUT = (DM / 32) * (DM / 64);
    constexpr int NITEMS = 2 * I_GU + 2 * I_D + I_IN + I_OUT;
    const int it_end = it_hi < NITEMS ? it_hi : NITEMS;
    for (int it = it_lo + gw; it < it_end; it += NGW) {
        int r = it; const float* src; const float* gain = nullptr; int ldn, K, nblk; size_t dsto; int kind;
        const float *gsrc = nullptr, *usrc = nullptr;
        if (r < I_GU) { kind = 1; gsrc = a->w1_gate + (size_t)l * DM * FF; usrc = a->w1_up + (size_t)l * DM * FF; gain = a->norm_ffn1 + l * DM; ldn = FF; K = DM; nblk = 2 * FF / 32; dsto = W_GU1; }
        else if ((r -= I_GU) < I_D) { kind = 0; gsrc = a->w1_down + (size_t)l * DM * FF; ldn = DM; K = FF; nblk = DM / 32; dsto = W_D1; }
        else if ((r -= I_D) < I_IN) { kind = 2; gsrc = a->w_in + (size_t)l * DM * NIN; gain = a->norm_mix + l * DM; ldn = NIN; K = DM; nblk = NIN / 32; dsto = W_IN; }
        else if ((r -= I_IN) < I_OUT) { kind = 0; gsrc = a->w_out + (size_t)l * DM * DM; ldn = DM; K = DM; nblk = DM / 32; dsto = W_OUT; }
        else if ((r -= I_OUT) < I_GU) { kind = 1; gsrc = a->w2_gate + (size_t)l * DM * FF; usrc = a->w2_up + (size_t)l * DM * FF; gain = a->norm_ffn2 + l * DM; ldn = FF; K = DM; nblk = 2 * FF / 32; dsto = W_GU2; }
        else { r -= I_GU; kind = 0; gsrc = a->w2_down + (size_t)l * DM * FF; ldn = DM; K = FF; nblk = DM / 32; dsto = W_D2; }
        const int kb = r / nblk, nb = r % nblk; int sc0 = 32 * nb; src = gsrc;
        if (kind == 1) { const int pn = nb >> 3, lb = nb & 7; src = lb < 4 ? gsrc : usrc; sc0 = 128 * pn + 32 * (lb & 3); }
        else if (kind == 2 && nb >= 40) { const int t = nb - 40, pnl = t >> 3, lb = t & 7, bj = lb >> 2, wc = lb & 3; sc0 = 1280 + 64 * (4 * pnl + wc) + 32 * bj; }
        conv_item(src, ldn, K, gain, (bf16*)((unsigned char*)Wb + dsto), 32 * nb, sc0, 64 * kb, scr, lane);
    }
}

constexpr int KS_STRIDE = 144;
constexpr int KS_BYTES = 384 * KS_STRIDE;
constexpr int TAB_OFF = 2 * KS_BYTES, TAB_N = 388, TAB_ZERO = 196;
static_assert(TAB_OFF + 4 * 4 * TAB_N * 4 <= LDSCTL_OFF, "LDS map");
constexpr float DEFER_THR = 10.0f;
constexpr int GS_STRIDE = 1040;
static_assert(128 * GS_STRIDE <= LDSCTL_OFF, "LDS map");
__device__ __forceinline__ void mixer_phase(KArgs a, int l, LAS unsigned char* lds, int G, int bid, int tid, int wave, int lane) {
    const bf16* Z = (const bf16*)(a->ws + WS_Z); bf16* MIX = (bf16*)(a->ws + WS_MIX);
    const int fr = lane & 15, fq = lane >> 4, tq = fr >> 2, tp = fr & 3;
    LAS unsigned char* Ks = lds; LAS unsigned char* Vs = lds + KS_BYTES; LAS unsigned char* Gs = lds;
#pragma unroll 1
    for (int blk = bid; blk < NBLK; blk += G) {
        const int sb = blk < 128 ? (blk & ~63) : (blk & ~15), se = sb + (blk < 128 ? 64 : 16);
        const bool has_prev = blk > sb, has_next = blk + 1 < se;
#ifndef MIX_NO_ATT
#ifndef REP_ATT
#define REP_ATT 1
#endif
#pragma unroll 1
        for (int kvh2 = 0; kvh2 < 2 * REP_ATT; ++kvh2) { const int kvh = kvh2 & 1;
            const int hq = kvh * 4 + (wave >> 1), half = wave & 1;
            const float sinkl = a->sink[l * 8 + hq] * pg8::K_LOG2E;
            bf16x8 qf[4][2];
#pragma unroll
            for (int qg = 0; qg < 4; ++qg)
#pragma unroll
                for (int dk = 0; dk < 2; ++dk) qf[qg][dk] = *(const bf16x8*)(Z + (size_t)(128 * blk + 64 * half + 16 * qg + fr) * NIN + hq * 64 + 32 * dk + 8 * fq);
            __syncthreads();
#pragma unroll
            for (int i = 0; i < 6; ++i) {
                const int id = tid + 512 * i, kj = id >> 3, c = id & 7, kb = kj >> 7;
                const bool ok = kb == 1 || (kb == 0 ? has_prev : has_next);
                v4u kv = (v4u){0u, 0u, 0u, 0u}, vv = (v4u){0u, 0u, 0u, 0u};
                if (ok) { const bf16* zr = Z + (size_t)(128 * (blk - 1) + kj) * NIN + 64 * kvh + 8 * c; kv = *(const v4u*)(zr + 512); vv = *(const v4u*)(zr + 640); }
                *(LAS v4u*)(Ks + kj * KS_STRIDE + c * 16) = kv; *(LAS v4u*)(Vs + kj * KS_STRIDE + c * 16) = vv;
            }
            {
                const v4u* tsrc = (const v4u*)(a->ws + WS_TAB) + kvh * (4 * TAB_N);
                if (tid < TAB_N) {
#pragma unroll
                    for (int i = 0; i < 4; ++i) *(LAS v4u*)(lds + TAB_OFF + 64 * tid + 16 * i) = tsrc[4 * tid + i];
                }
            }
            __syncthreads();
            {
                f32x4 o[4][4];
#pragma unroll
                for (int db = 0; db < 4; ++db)
#pragma unroll
                    for (int qg = 0; qg < 4; ++qg) o[db][qg] = (f32x4){0.f, 0.f, 0.f, 0.f};
                float mrow[4], lsum[4];
#pragma unroll
                for (int qg = 0; qg < 4; ++qg) { mrow[qg] = sinkl; lsum[qg] = 0.f; }
                const int dl0 = 4 * fq - fr, kcp = dl0 & 3;
                const LAS unsigned char* tbl = lds + TAB_OFF + ((wave >> 1) * 4 + kcp) * (TAB_N * 4) + 4 * (dl0 - kcp + TAB_ZERO - 128 - 48);
#pragma unroll 2
                for (int kt = 0; kt < 10; ++kt) {
                    const int key0 = 64 * half + 32 * kt, tb = key0 >> 7;
                    if ((tb == 0 && !has_prev) || (tb == 2 && !has_next)) continue;
                    f32x4 s[2][4];
#pragma unroll
                    for (int kb = 0; kb < 2; ++kb)
#pragma unroll
                        for (int qg = 0; qg < 4; ++qg) s[kb][qg] = (f32x4){0.f, 0.f, 0.f, 0.f};
#pragma unroll
                    for (int kb = 0; kb < 2; ++kb)
#pragma unroll
                        for (int dk = 0; dk < 2; ++dk) {
                            const bf16x8 kf = *(const LAS bf16x8*)(Ks + (key0 + 16 * kb + fr) * KS_STRIDE + 64 * dk + 16 * fq);
#pragma unroll
                            for (int qg = 0; qg < 4; ++qg) s[kb][qg] = __builtin_amdgcn_mfma_f32_16x16x32_bf16(kf, qf[qg][dk], s[kb][qg], 0, 0, 0);
                        }
                    bf16x8 pb[4];
                    const LAS unsigned char* tbp = tbl + 128 * kt;
                    bool need = false;
#pragma unroll
                    for (int qg = 0; qg < 4; ++qg) {
#pragma unroll
                        for (int kb = 0; kb < 2; ++kb) s[kb][qg] = s[kb][qg] + *(const LAS f32x4*)(tbp + 64 * (kb - qg + 3));
                        const float lm = fmaxf(fmaxf(fmaxf(s[0][qg][0], s[0][qg][1]), fmaxf(s[0][qg][2], s[0][qg][3])), fmaxf(fmaxf(s[1][qg][0], s[1][qg][1]), fmaxf(s[1][qg][2], s[1][qg][3])));
                        need |= lm > mrow[qg] + DEFER_THR;
                    }
                    if (__builtin_amdgcn_readfirstlane(__any(need))) {
#pragma unroll
                        for (int qg = 0; qg < 4; ++qg) {
                            float mx = fmaxf(fmaxf(fmaxf(s[0][qg][0], s[0][qg][1]), fmaxf(s[0][qg][2], s[0][qg][3])), fmaxf(fmaxf(s[1][qg][0], s[1][qg][1]), fmaxf(s[1][qg][2], s[1][qg][3])));
                            mx = fmaxf(mx, mrow[qg]);
                            mx = fmaxf(mx, __shfl_xor(mx, 16)); mx = fmaxf(mx, __shfl_xor(mx, 32));
                            const float alpha = __builtin_amdgcn_exp2f(mrow[qg] - mx); mrow[qg] = mx;
                            lsum[qg] = lsum[qg] * alpha;
#pragma unroll
                            for (int db = 0; db < 4; ++db) o[db][qg] = o[db][qg] * alpha;
                        }
                    }
#pragma unroll
                    for (int qg = 0; qg < 4; ++qg) {
                        const float mx = mrow[qg];
                        float ps = 0.f;
#pragma unroll
                        for (int kb = 0; kb < 2; ++kb)
#pragma unroll
                            for (int j = 0; j < 4; ++j) { const float p = __builtin_amdgcn_exp2f(s[kb][qg][j] - mx); s[kb][qg][j] = p; ps += p; }
                        lsum[qg] += ps;
                        v4u w; w.x = pk2(s[0][qg][0], s[0][qg][1]); w.y = pk2(s[0][qg][2], s[0][qg][3]); w.z = pk2(s[1][qg][0], s[1][qg][1]); w.w = pk2(s[1][qg][2], s[1][qg][3]);
                        pb[qg] = __builtin_bit_cast(bf16x8, w);
                    }
#pragma unroll
                    for (int db = 0; db < 4; ++db) {
                        const LAS unsigned char* vp = Vs + (key0 + 4 * fq + tq) * KS_STRIDE + (16 * db + 4 * tp) * 2;
                        const s16x4 lo = vtr(vp), hi = vtr(vp + 16 * KS_STRIDE);
                        const bf16x8 vf = (bf16x8){lo[0], lo[1], lo[2], lo[3], hi[0], hi[1], hi[2], hi[3]};
#pragma unroll
                        for (int qg = 0; qg < 4; ++qg) o[db][qg] = __builtin_amdgcn_mfma_f32_16x16x32_bf16(vf, pb[qg], o[db][qg], 0, 0, 0);
                    }
                }
#pragma unroll
                for (int qg = 0; qg < 4; ++qg) {
                    float lt = lsum[qg]; lt += __shfl_xor(lt, 16); lt += __shfl_xor(lt, 32); lt += __builtin_amdgcn_exp2f(sinkl - mrow[qg]);
                    const float inv = 1.0f / lt;
                    bf16* op = MIX + (size_t)(128 * blk + 64 * half + 16 * qg + fr) * DM + hq * 64 + 4 * fq;
#pragma unroll
                    for (int db = 0; db < 4; ++db) { const f32x4 v = o[db][qg] * inv; v2u w; w.x = pk2(v[0], v[1]); w.y = pk2(v[2], v[3]); *(v2u*)(op + 16 * db) = w; }
                }
            }
        }
#endif
        {
            const int tidg = pg8::opaque_v(tid);
            const int h = wave;
            const v4u* wsb = (const v4u*)(a->ws + WS_WSB) + ((size_t)(l * 8 + h) * 32) * 64 + lane;
            v4u gl[16];
#pragma unroll
            for (int i = 0; i < 16; ++i) { const int id = tidg + 512 * i, srow = id >> 6, c = id & 63; gl[i] = *(const v4u*)(Z + (size_t)(128 * blk + srow) * NIN + 1280 + 8 * c); }
            __syncthreads();
#pragma unroll
            for (int i = 0; i < 16; ++i) { const int id = tidg + 512 * i, srow = id >> 6, c = id & 63; *(LAS v4u*)(Gs + srow * GS_STRIDE + c * 16) = gl[i]; }
#pragma unroll 1
            for (int th = 0; th < 2; ++th) {
                const int tbase = 64 * th;
                v4u wf[4][4]; v2u uu[4][4]; float bias[4];
#pragma unroll
                for (int tb = 0; tb < 4; ++tb) { const size_t row = (size_t)128 * blk + tbase + 16 * tb + fr; bias[tb] = a->b_sp[(l * 8 + h) * 128 + tbase + 16 * tb + fr];
#pragma unroll
                    for (int c = 0; c < 4; ++c) wf[tb][c] = wsb[((4 * th + tb) * 4 + c) * 64];
#pragma unroll
                    for (int db = 0; db < 4; ++db) uu[tb][db] = *(const v2u*)(Z + row * NIN + 768 + 64 * h + 16 * db + 4 * fq); }
                if (th == 0) __syncthreads();
                f32x4 d[4][4];
#pragma unroll
                for (int tb = 0; tb < 4; ++tb)
#pragma unroll
                    for (int db = 0; db < 4; ++db) d[tb][db] = (f32x4){0.f, 0.f, 0.f, 0.f};
#pragma unroll
                for (int c = 0; c < 4; ++c)
#pragma unroll
                    for (int db = 0; db < 4; ++db) {
                        const LAS unsigned char* gp = Gs + (32 * c + 8 * fq + tq) * GS_STRIDE + (64 * h + 16 * db + 4 * tp) * 2;
                        const s16x4 lo = vtr(gp), hi = vtr(gp + 4 * GS_STRIDE);
                        const bf16x8 af = (bf16x8){lo[0], lo[1], lo[2], lo[3], hi[0], hi[1], hi[2], hi[3]};
#pragma unroll
                        for (int tb = 0; tb < 4; ++tb) d[tb][db] = __builtin_amdgcn_mfma_f32_16x16x32_bf16(af, __builtin_bit_cast(bf16x8, wf[tb][c]), d[tb][db], 0, 0, 0);
                    }
#pragma unroll
                for (int tb = 0; tb < 4; ++tb) { const size_t row = (size_t)128 * blk + tbase + 16 * tb + fr;
#pragma unroll
                    for (int db = 0; db < 4; ++db) {
                        const int d0 = 64 * h + 16 * db + 4 * fq; const v2u u2 = uu[tb][db]; const f32x4 dv = d[tb][db]; const float bs = bias[tb];
                        v2u w; w.x = pk2(bf_lo(u2.x) * (dv[0] + bs), bf_hi(u2.x) * (dv[1] + bs)); w.y = pk2(bf_lo(u2.y) * (dv[2] + bs), bf_hi(u2.y) * (dv[3] + bs));
                        *(v2u*)(MIX + row * DM + 512 + d0) = w;
                    } }
            }
        }
    }
    __syncthreads();
}

#define GRID_SYNC1() do { XcdBarrier b_ = bar; b_.x = (unsigned)opaque((int)bar.x); xcd_barrier(b_); } while (0)
#ifdef DUP_SYNC
#define GRID_SYNC() do { GRID_SYNC1(); GRID_SYNC1(); } while (0)
#else
#define GRID_SYNC() GRID_SYNC1()
#endif
__global__ void __launch_bounds__(NWAVES * 64, 2) fwd_megakernel(Args a) {
    extern __shared__ __attribute__((aligned(16))) unsigned char lds_raw[];
    LAS unsigned char* lds = (LAS unsigned char*)lds_raw;
    cg::grid_group grid = cg::this_grid();
    const int tid = threadIdx.x, lane = tid & 63, wave = __builtin_amdgcn_readfirstlane(tid >> 6);
    const int G = gridDim.x, bid = blockIdx.x;
    const int vcu = (G % 8 == 0) ? (bid % 8) * (G / 8) + bid / 8 : bid;
    const int gw = vcu * NWAVES + wave, NGW = G * NWAVES;
    if (tid < 64) ((LAS unsigned*)(lds + LDSCTL_OFF))[tid] = 0u;
    __syncthreads();
    const XcdBarrier bar = xcd_barrier_post((unsigned*)(kargs()->ws + WS_BAR), (volatile LAS unsigned*)(lds + LDSCTL_OFF));
    grid.sync();
#define KA (kargs())
#define X (KA->out)
#define SS ((pg8::ss_t*)(KA->ws + WS_SS))
#define XB ((bf16*)(KA->ws + WS_XB))
#define Wb (l == 0 ? (bf16*)(KA->ws + WS_W) : (bf16*)KA->out)
#define Hb ((bf16*)(KA->ws + WS_H))
#define Zb ((bf16*)(KA->ws + WS_Z))
#define MIXb ((bf16*)(KA->ws + WS_MIX))

    { bf16* xb_ = XB; pg8::ss_t* ss_ = SS; const float* xp_ = KA->x_prompt; const float* xs_ = KA->x_sample;
    for (int r0 = gw; r0 < TOK; r0 += 4 * NGW) {
        f32x4 v[4][4];
#pragma unroll
        for (int q = 0; q < 4; ++q) { const int r = r0 + q * NGW; const float* src = r < TOKP ? xp_ + (size_t)r * DM : xs_ + (size_t)(r - TOKP) * DM;
#pragma unroll
            for (int j = 0; j < 4; ++j) v[q][j] = *(const f32x4*)(src + 256 * j + 4 * lane); }
#pragma unroll
        for (int q = 0; q < 4; ++q) { const int r = r0 + q * NGW; float s = 0.f;
#pragma unroll
            for (int j = 0; j < 4; ++j) { const f32x4 x = v[q][j]; v2u w; w.x = pk2(x[0], x[1]); w.y = pk2(x[2], x[3]); *(v2u*)(xb_ + (size_t)r * DM + 256 * j + 4 * lane) = w;
                s += (x[0] * x[0] + x[1] * x[1]) + (x[2] * x[2] + x[3] * x[3]); }
            s = wave_sum(s);
            if (lane == 0) ss_[r] = pg8::ss_fix(s); }
    }
    for (int i = bid * 512 + tid; i < 6 * TOK; i += G * 512) ss_[TOK + i] = 0ull; }
    {
        float* tab_ = (float*)(KA->ws + WS_TAB);
        for (int e = bid * 512 + tid; e < 8 * 4 * TAB_N; e += G * 512) {
            const int hd = e / (4 * TAB_N), k = (e / TAB_N) & 3, i = e % TAB_N, rel = i + k - TAB_ZERO, ad = rel < 0 ? -rel : rel;
            const float sl = __builtin_amdgcn_exp2f(-(float)(hd + 1)) * pg8::K_LOG2E;
            tab_[e] = ad <= 128 ? -sl * (float)ad : -INFINITY;
        }
    }
    {
        const float* wsp_ = KA->w_sp; v4u* wsb_ = (v4u*)(KA->ws + WS_WSB);
        for (int e = bid * 512 + tid; e < NLAYER * 8 * 32 * 64; e += G * 512) {
            const int ln = e & 63, f = e >> 6, c = f & 3, tb = (f >> 2) & 7, lh = f >> 5;
            const float* wp = wsp_ + ((size_t)lh * 128 + 16 * tb + (ln & 15)) * 128 + 32 * c + 8 * (ln >> 4);
            const f32x4 w0 = *(const f32x4*)wp, w1 = *(const f32x4*)(wp + 4);
            v4u o; o.x = pk2(w0[0], w0[1]); o.y = pk2(w0[2], w0[3]); o.z = pk2(w1[0], w1[1]); o.w = pk2(w1[2], w1[3]);
            wsb_[e] = o;
        }
    }
    const int l1_cut = (G == 256) ? L1_CUT : 0;
    convert_layer(kargs(), 0, lds, gw, NGW, wave, lane, 0, 1 << 30);
    convert_layer(kargs(), 1, lds, gw, NGW, wave, lane, l1_cut, 1 << 30);
    GRID_SYNC();

    for (int l = 0; l < NLAYER; ++l) {
        #define ssA (SS + (size_t)(3 * l) * TOK)
#define ssB (SS + (size_t)(3 * l + 1) * TOK)
#define ssC (SS + (size_t)(3 * l + 2) * TOK)
#define ssD (SS + (size_t)(3 * l + 3) * TOK)
        if (PH_MASK & 1) { pg8::Gemm g{XB, (const bf16*)((unsigned char*)Wb + W_GU1), TOK, 2 * FF, DM}; pg8::StaticOrder S; S.init(TOK, 2 * FF, G, opaque(bid));
          pg8::EpiSwiglu E{Hb, FF, ssA};
#ifdef DUP_PA
          pg8::gemm_phase<pg8::EpiSwiglu, pg8::StaticOrder, true, true>(lds, g, S, E); __syncthreads();
#endif
          pg8::gemm_phase<pg8::EpiSwiglu, pg8::StaticOrder, true, true>(lds, g, S, E); }
        GRID_SYNC();
        if (PH_MASK & 2) { pg8::Gemm g{Hb, (const bf16*)((unsigned char*)Wb + W_D1), TOK, DM, FF}; pg8::StaticOrder S; S.init(TOK, DM, G, opaque(bid));
          pg8::EpiResid E{XB, ssB, 0.5f};
#ifdef DUP_PB
          { pg8::EpiResid E0{XB, nullptr, 0.0f}; pg8::gemm_phase<pg8::EpiResid, pg8::StaticOrder, true, true>(lds, g, S, E0); __syncthreads(); }
#endif
          pg8::gemm_phase<pg8::EpiResid, pg8::StaticOrder, true, true>(lds, g, S, E); }
        GRID_SYNC();
        if (PH_MASK & 4) { pg8::Gemm g{XB, (const bf16*)((unsigned char*)Wb + W_IN), TOK, NIN, DM}; pg8::StaticOrder S; S.init(TOK, NIN, G, opaque(bid));
          pg8::EpiInProj E{Zb, ssB, KA->vgain + l * 512};
          pg8::gemm_phase<pg8::EpiInProj, pg8::StaticOrder, true, true>(lds, g, S, E); }
        if (l == 0 && G == 256 && bid >= 128) {
          const int t_ = pg8::opaque_v((int)threadIdx.x), w_ = __builtin_amdgcn_readfirstlane(t_ >> 6);
          convert_layer(kargs(), 1, lds, (opaque(bid) - 128) * NWAVES + w_, 128 * NWAVES, w_, t_ & 63, 0, L1_CUT); }
        GRID_SYNC();
#ifdef MIXER_COPY
        if (PH_MASK & 8) { for (size_t i = (size_t)bid * 512 + threadIdx.x; i < (size_t)TOK * 128; i += (size_t)G * 512) { const size_t r = i >> 7, c = i & 127; *(v4u*)(MIXb + r * DM + 8 * c) = *(const v4u*)(Zb + r * NIN + 8 * c); } }
#else
        if (PH_MASK & 8) { const int t_ = pg8::opaque_v((int)threadIdx.x); mixer_phase(kargs(), l, lds, G, opaque(vcu), t_, __builtin_amdgcn_readfirstlane(t_ >> 6), t_ & 63); }
#ifdef DUP_PD
        { const int t_ = pg8::opaque_v((int)threadIdx.x); mixer_phase(kargs(), l, lds, G, opaque(vcu), t_, __builtin_amdgcn_readfirstlane(t_ >> 6), t_ & 63); }
#endif
#endif
        GRID_SYNC();
        if (PH_MASK & 16) { pg8::Gemm g{MIXb, (const bf16*)((unsigned char*)Wb + W_OUT), TOK, DM, DM}; pg8::StaticOrder S; S.init(TOK, DM, G, opaque(bid));
          pg8::EpiResid E{XB, ssC, 1.0f};
#ifdef DUP_PB
          { pg8::EpiResid E0{XB, nullptr, 0.0f}; pg8::gemm_phase<pg8::EpiResid, pg8::StaticOrder, true, true>(lds, g, S, E0); __syncthreads(); }
#endif
          pg8::gemm_phase<pg8::EpiResid, pg8::StaticOrder, true, true>(lds, g, S, E); }
        GRID_SYNC();
        if (PH_MASK & 32) { pg8::Gemm g{XB, (const bf16*)((unsigned char*)Wb + W_GU2), TOK, 2 * FF, DM}; pg8::StaticOrder S; S.init(TOK, 2 * FF, G, opaque(bid));
          pg8::EpiSwiglu E{Hb, FF, ssC};
#ifdef DUP_PA
          pg8::gemm_phase<pg8::EpiSwiglu, pg8::StaticOrder, true, true>(lds, g, S, E); __syncthreads();
#endif
          pg8::gemm_phase<pg8::EpiSwiglu, pg8::StaticOrder, true, true>(lds, g, S, E); }
        GRID_SYNC();
        if (PH_MASK & 64) { pg8::Gemm g{Hb, (const bf16*)((unsigned char*)Wb + W_D2), TOK, DM, FF}; pg8::StaticOrder S; S.init(TOK, DM, G, opaque(bid));
          pg8::EpiResid E{XB, ssD, 0.5f};
#ifdef DUP_PB
          { pg8::EpiResid E0{XB, nullptr, 0.0f}; pg8::gemm_phase<pg8::EpiResid, pg8::StaticOrder, true, true>(lds, g, S, E0); __syncthreads(); }
#endif
          pg8::gemm_phase<pg8::EpiResid, pg8::StaticOrder, true, true>(lds, g, S, E); }
        GRID_SYNC();
    }
    {
        const int t_ = pg8::opaque_v((int)threadIdx.x), lane = t_ & 63, gw = opaque(vcu) * NWAVES + __builtin_amdgcn_readfirstlane(t_ >> 6);
        const pg8::ss_t* ssF = SS + (size_t)6 * TOK; const bf16* xb_ = XB; float* out_ = X;
        f32x4 gn[4];
#pragma unroll
        for (int j = 0; j < 4; ++j) gn[j] = *(const f32x4*)(KA->norm_final + 256 * j + 4 * lane);
        for (int r0 = gw; r0 < TOK; r0 += 4 * NGW) {
            v2u w[4][4]; pg8::ss_t sv[4];
#pragma unroll
            for (int q = 0; q < 4; ++q) { const int r = r0 + q * NGW; sv[q] = ssF[r];
#pragma unroll
                for (int j = 0; j < 4; ++j) w[q][j] = *(const v2u*)(xb_ + (size_t)r * DM + 256 * j + 4 * lane); }
#pragma unroll
            for (int q = 0; q < 4; ++q) { const int r = r0 + q * NGW; const float rs = pg8::rs_of(sv[q]);
#pragma unroll
                for (int j = 0; j < 4; ++j) { const f32x4 v = (f32x4){bf_lo(w[q][j].x), bf_hi(w[q][j].x), bf_lo(w[q][j].y), bf_hi(w[q][j].y)}; *(f32x4*)(out_ + (size_t)r * DM + 256 * j + 4 * lane) = v * rs * gn[j]; } }
        }
    }
}
#undef KA
#undef X
#undef SS
#undef XB
#undef Wb
#undef Hb
#undef Zb
#undef MIXb
#undef ssA
#undef ssB
#undef ssC
#undef ssD

extern "C" void kernel_launch(void* const* d_in, const int* in_sizes, int n_in, void* d_out, int out_size, void* d_ws, size_t ws_size, hipStream_t stream) {
    static int grid = 0;
    if (grid == 0) {
        if (n_in != 18 || out_size != TOK * DM || ws_size < WS_END) { fprintf(stderr, "kernel_launch: unexpected shapes (n_in %d out %d ws %zu, need %zu)\n", n_in, out_size, ws_size, (size_t)WS_END); grid = -1; return; }
        int dev = 0, cus = 0, per_cu = 0;
        if (hipGetDevice(&dev) != hipSuccess || hipDeviceGetAttribute(&cus, hipDeviceAttributeMultiprocessorCount, dev) != hipSuccess) { grid = -1; return; }
        if (hipFuncSetAttribute((const void*)fwd_megakernel, hipFuncAttributeMaxDynamicSharedMemorySize, LDS_BYTES) != hipSuccess) { fprintf(stderr, "kernel_launch: hipFuncSetAttribute failed\n"); grid = -1; return; }
        if (hipOccupancyMaxActiveBlocksPerMultiprocessor(&per_cu, (const void*)fwd_megakernel, NWAVES * 64, LDS_BYTES) != hipSuccess || per_cu < 1) { fprintf(stderr, "kernel_launch: occupancy query says %d\n", per_cu); per_cu = 1; }
        (void)hipGetLastError();
        grid = cus;
    }
    if (grid < 0) return;
    if (hipMemsetAsync((char*)d_ws + WS_BAR, 0, WS_BAR_BYTES, stream) != hipSuccess) { fprintf(stderr, "kernel_launch: memset failed\n"); return; }
    Args a{};
    const float** f = (const float**)&a;
    for (int i = 0; i < 18; ++i) f[i] = (const float*)d_in[i];
    a.out = (float*)d_out; a.ws = (unsigned char*)d_ws;
    void* args[] = {&a};
    hipError_t e = hipLaunchCooperativeKernel((const void*)fwd_megakernel, dim3(grid), dim3(NWAVES * 64), args, LDS_BYTES, stream);
    if (e != hipSuccess) fprintf(stderr, "kernel_launch: cooperative launch failed: %s (grid %d)\n", hipGetErrorString(e), grid);
}
```

```cpp
#include <hip/hip_runtime.h>
#include <hip/hip_cooperative_groups.h>
#include <cstdio>
#include <cstdint>
#include <cmath>
namespace cg = cooperative_groups;
namespace pg8 {
#define PG8_LAS __attribute__((address_space(3)))
typedef unsigned short bf16_t;
typedef short bf16x8 __attribute__((ext_vector_type(8)));
typedef float f32x4 __attribute__((ext_vector_type(4)));
typedef unsigned u32x4 __attribute__((ext_vector_type(4)));
constexpr int BM = 256, BK = 64, HALF = 128, HTB = HALF * BK * 2  , STAGE_BYTES = 8 * HTB, NXCD = 8, WGM = 8;

__host__ __device__ __forceinline__ int lds_byte(int r, int c) { const int st = (r >> 4) * 2 + (c >> 5), rr = r & 15, cc = c & 31, ob = rr * 64 + cc * 2; return st * 1024 + (ob ^ (((ob >> 9) & 1) << 5)); }
__host__ __device__ __forceinline__ void stage_rc(int b, int& R, int& C) { const int st = b / 1024, sb = b % 1024, swz = sb ^ (((sb >> 9) & 1) << 5); R = (st >> 1) * 16 + swz / 64; C = (st & 1) * 32 + (swz % 64) / 2; }
__host__ __device__ __forceinline__ int perm32(int rho) { const int n = rho >> 4, i = rho & 15; return 8 * (i >> 2) + 4 * n + (i & 3); }

struct Unit { int pm, pn; };
struct Gemm { const bf16_t* A; const bf16_t* Bt; int M, N, K; };

struct StaticOrder {
    int nM, nN, nwg, G, c;
    __host__ __device__ void init(int M, int N, int G_, int c_) { nM = M / BM; nN = N / BM; nwg = nM * nN; G = G_; c = c_; }
    __host__ __device__ bool next(int i, Unit& u) const {
        const long L = (long)i * G + c; if (L >= nwg) return false;
        int wgid = (int)L; { const int q = nwg / NXCD, r = nwg % NXCD, xcd = wgid % NXCD, off = wgid / NXCD; wgid = (xcd < r ? xcd * (q + 1) : r * (q + 1) + (xcd - r) * q) + off; }
        const int nig = WGM * nN, gid = wgid / nig, fm = gid * WGM, gsz = (nM - fm) < WGM ? (nM - fm) : WGM;
        u.pm = fm + ((wgid % nig) % gsz); u.pn = (wgid % nig) / gsz; return true;
    }
    __device__ __forceinline__ void a_ready(const Unit&) const {}
    __device__ __forceinline__ void done(const Unit&) const {}
};

__device__ __forceinline__ unsigned cvt_pk_bf16(float lo, float hi) { unsigned r; asm volatile("v_cvt_pk_bf16_f32 %0, %1, %2" : "=v"(r) : "v"(lo), "v"(hi)); return r; }
typedef float f32x2 __attribute__((ext_vector_type(2)));
constexpr float RMS_EPS = 1e-6f;
__device__ __forceinline__ int opaque_v(int v) { asm volatile("" : "+v"(v)); return v; }
constexpr float K_LOG2E = 1.4426950408889634f;
__device__ __forceinline__ float fast_exp2(float x) { return __builtin_amdgcn_exp2f(x); }
__device__ __forceinline__ float fast_rcp(float x) { return __builtin_amdgcn_rcpf(x); }
__device__ __forceinline__ float silu_f(float g) { return g * fast_rcp(1.0f + fast_exp2(-K_LOG2E * g)); }
__device__ __forceinline__ float gelu_tanh_f(float v) { const float t = v * (1.0f + 0.044715f * v * v); return v * fast_rcp(1.0f + fast_exp2(-2.3022081978f * t)); }
typedef unsigned long long ss_t;
constexpr float SS_SCALE = 1048576.0f;
__device__ __forceinline__ ss_t ss_fix(float s) { return (ss_t)(s * SS_SCALE + 0.5f); }
__device__ __forceinline__ float rs_of(ss_t v) { return __builtin_amdgcn_rsqf((float)v * (1.0f / (1024.0f * SS_SCALE)) + RMS_EPS); }
__device__ __forceinline__ float row_rs(const ss_t* ss, int row) { return __builtin_amdgcn_rsqf((float)ss[row] * (1.0f / (1024.0f * SS_SCALE)) + RMS_EPS); }

__device__ __forceinline__ f32x2 swiglu_pk(f32x2 ag, f32x2 au, float rsn, float rs2) {
    const f32x2 t = ag * rsn; f32x2 e; e.x = fast_exp2(t.x); e.y = fast_exp2(t.y);
    const f32x2 den = e + 1.0f; f32x2 r; r.x = fast_rcp(den.x); r.y = fast_rcp(den.y);
    return ((ag * au) * rs2) * r;
}
struct EpiSwiglu {
    static constexpr bool PERM = true, AFTER_DRAIN = false;
    bf16_t* H; int ldh; const ss_t* ss;
    __device__ __forceinline__ void operator()(const f32x4 (&acc)[2][2][4][2], const Unit& u, int wr, int wc, int fr, int fq) const {
        const int row0 = u.pm * BM + wr * 64 + fr, col0 = u.pn * HALF + wc * 32 + 8 * fq;
        ss_t sv[2][4];
#pragma unroll
        for (int ai = 0; ai < 2; ++ai)
#pragma unroll
            for (int m = 0; m < 4; ++m) sv[ai][m] = ss[row0 + ai * HALF + m * 16];
#pragma unroll
        for (int ai = 0; ai < 2; ++ai)
#pragma unroll
            for (int m = 0; m < 4; ++m) {
                const int row = row0 + ai * HALF + m * 16; const float rs = rs_of(sv[ai][m]), rsn = -K_LOG2E * rs, rs2 = rs * rs;
                const f32x4 ag0 = acc[ai][0][m][0], ag1 = acc[ai][0][m][1], au0 = acc[ai][1][m][0], au1 = acc[ai][1][m][1];
                const f32x2 h0 = swiglu_pk((f32x2){ag0[0], ag0[1]}, (f32x2){au0[0], au0[1]}, rsn, rs2), h1 = swiglu_pk((f32x2){ag0[2], ag0[3]}, (f32x2){au0[2], au0[3]}, rsn, rs2);
                const f32x2 h2 = swiglu_pk((f32x2){ag1[0], ag1[1]}, (f32x2){au1[0], au1[1]}, rsn, rs2), h3 = swiglu_pk((f32x2){ag1[2], ag1[3]}, (f32x2){au1[2], au1[3]}, rsn, rs2);
                u32x4 w; w.x = cvt_pk_bf16(h0.x, h0.y); w.y = cvt_pk_bf16(h1.x, h1.y); w.z = cvt_pk_bf16(h2.x, h2.y); w.w = cvt_pk_bf16(h3.x, h3.y);
                *(u32x4*)(H + (size_t)row * ldh + col0) = w;
                asm volatile("" ::: "memory");
            }
    }
};
__device__ __forceinline__ float bfl(unsigned w) { return __builtin_bit_cast(float, w << 16); }
__device__ __forceinline__ float bfh(unsigned w) { return __builtin_bit_cast(float, w & 0xffff0000u); }
struct EpiResid {
    static constexpr bool PERM = true, AFTER_DRAIN = false;
    bf16_t* XB; ss_t* ssn; float scale;
    __device__ __forceinline__ void operator()(const f32x4 (&acc)[2][2][4][2], const Unit& u, int wr, int wc, int fr, int fq) const {
        const int row0 = u.pm * BM + wr * 64 + fr, col0 = u.pn * BM + wc * 32 + 8 * fq;
#pragma unroll
        for (int ai = 0; ai < 2; ++ai) {
            u32x4 xw[4][2];
#pragma unroll
            for (int m = 0; m < 4; ++m)
#pragma unroll
                for (int bj = 0; bj < 2; ++bj) xw[m][bj] = *(const u32x4*)(XB + (size_t)(row0 + ai * HALF + m * 16) * 1024 + col0 + bj * HALF);
#pragma unroll
            for (int m = 0; m < 4; ++m) {
                const int row = row0 + ai * HALF + m * 16; float s = 0.f;
#pragma unroll
                for (int bj = 0; bj < 2; ++bj) {
                    bf16_t* xp = XB + (size_t)row * 1024 + col0 + bj * HALF;
                    const u32x4 w0 = xw[m][bj];
                    f32x4 x0 = (f32x4){bfl(w0.x), bfh(w0.x), bfl(w0.y), bfh(w0.y)}, x1 = (f32x4){bfl(w0.z), bfh(w0.z), bfl(w0.w), bfh(w0.w)};
                    x0 = x0 + acc[ai][bj][m][0] * scale; x1 = x1 + acc[ai][bj][m][1] * scale;
                    s += (x0[0] * x0[0] + x0[1] * x0[1]) + (x0[2] * x0[2] + x0[3] * x0[3]) + (x1[0] * x1[0] + x1[1] * x1[1]) + (x1[2] * x1[2] + x1[3] * x1[3]);
                    u32x4 w; w.x = cvt_pk_bf16(x0[0], x0[1]); w.y = cvt_pk_bf16(x0[2], x0[3]); w.z = cvt_pk_bf16(x1[0], x1[1]); w.w = cvt_pk_bf16(x1[2], x1[3]);
                    *(u32x4*)xp = w;
                }
                s += __shfl_xor(s, 16); s += __shfl_xor(s, 32);
                if (fq == 0 && ssn) atomicAdd(ssn + row, ss_fix(s));
            }
            asm volatile("" ::: "memory");
        }
    }
};
struct EpiInProj {
    static constexpr bool PERM = true, AFTER_DRAIN = false;
    bf16_t* Z; const ss_t* ss; const float* vgain;
    __device__ __forceinline__ void operator()(const f32x4 (&acc)[2][2][4][2], const Unit& u, int wr, int wc, int fr, int fq) const {
        const int row0 = u.pm * BM + wr * 64 + fr, pn = u.pn;
        const int mode = pn < 2 ? 0 : (pn == 2 ? 1 : (pn < 5 ? 2 : 3));
        int colb[2]; f32x4 gv[2][2];
#pragma unroll
        for (int bj = 0; bj < 2; ++bj) {
            colb[bj] = mode == 3 ? 1280 + 64 * (4 * (pn - 5) + wc) + 32 * bj + 8 * fq : 256 * pn + 128 * bj + 32 * wc + 8 * fq;
#pragma unroll
            for (int n = 0; n < 2; ++n) gv[bj][n] = mode == 3 ? *(const f32x4*)(vgain + (colb[bj] - 1280) + 4 * n) : (f32x4){1.f, 1.f, 1.f, 1.f};
        }
        ss_t sv[2][4];
#pragma unroll
        for (int ai = 0; ai < 2; ++ai)
#pragma unroll
            for (int m = 0; m < 4; ++m) sv[ai][m] = ss[row0 + ai * HALF + m * 16];
#pragma unroll
        for (int ai = 0; ai < 2; ++ai)
#pragma unroll
            for (int m = 0; m < 4; ++m) {
                const int row = row0 + ai * HALF + m * 16; const float rs = rs_of(sv[ai][m]);
                f32x4 v[2][2];
#pragma unroll
                for (int bj = 0; bj < 2; ++bj)
#pragma unroll
                    for (int n = 0; n < 2; ++n) v[bj][n] = acc[ai][bj][m][n] * rs;
                if (mode == 0) {
#pragma unroll
                    for (int bj = 0; bj < 2; ++bj)
#pragma unroll
                        for (int n = 0; n < 2; ++n) v[bj][n] = v[bj][n] * (0.125f * K_LOG2E);
                } else if (mode >= 2) {
#pragma unroll
                    for (int bj = 0; bj < 2; ++bj)
#pragma unroll
                        for (int n = 0; n < 2; ++n)
#pragma unroll
                            for (int e = 0; e < 4; ++e) v[bj][n][e] = gelu_tanh_f(v[bj][n][e]);
                    if (mode == 3) {
                        float q = 0.f;
#pragma unroll
                        for (int bj = 0; bj < 2; ++bj)
#pragma unroll
                            for (int n = 0; n < 2; ++n) q += (v[bj][n][0] * v[bj][n][0] + v[bj][n][1] * v[bj][n][1]) + (v[bj][n][2] * v[bj][n][2] + v[bj][n][3] * v[bj][n][3]);
                        q += __shfl_xor(q, 16); q += __shfl_xor(q, 32);
                        const float r2 = __builtin_amdgcn_rsqf(q * (1.0f / 64.0f) + RMS_EPS);
#pragma unroll
                        for (int bj = 0; bj < 2; ++bj)
#pragma unroll
                            for (int n = 0; n < 2; ++n) v[bj][n] = v[bj][n] * r2 * gv[bj][n];
                    }
                }
#pragma unroll
                for (int bj = 0; bj < 2; ++bj) {
                    u32x4 w; w.x = cvt_pk_bf16(v[bj][0][0], v[bj][0][1]); w.y = cvt_pk_bf16(v[bj][0][2], v[bj][0][3]); w.z = cvt_pk_bf16(v[bj][1][0], v[bj][1][1]); w.w = cvt_pk_bf16(v[bj][1][2], v[bj][1][3]);
                    *(u32x4*)(Z + (size_t)row * 1792 + colb[bj]) = w;
                }
                asm volatile("" ::: "memory");
            }
    }
};

template <class Epi, class Sched, bool ALIGN_EPI = false, bool SP2 = false>
__device__ __forceinline__ void gemm_phase(PG8_LAS unsigned char* lds, const Gemm g, const Sched& S, const Epi& E) {
    const int tid = opaque_v((int)threadIdx.x), wid = __builtin_amdgcn_readfirstlane(tid >> 6), lane = tid & 63, wr = wid >> 2, wc = wid & 3, fr = lane & 15, fq = lane >> 4;
    const int K = g.K, nt = K / BK;
    unsigned voffA[2], voffB[2];
#pragma unroll
    for (int i = 0; i < 2; ++i) { int R, C; stage_rc(tid * 16 + i * 8192, R, C); const int Rb = Epi::PERM ? ((R & ~31) + perm32(R & 31)) : R;
        voffA[i] = (unsigned)(R * K + C) * 2u; voffB[i] = (unsigned)(Rb * K + C) * 2u; }
    const size_t kstep = (size_t)(BK * 2);
    const size_t hstep = (size_t)HALF * K * 2;
    const size_t tstep = 2 * hstep;
    const unsigned ldsw = (unsigned)wid * 1024u;
    const int aoff = lds_byte(wr * 64 + fr, fq * 8), boff = lds_byte(wc * 32 + fr, fq * 8);
#define PG8_SA(b, h) (((b) * 2 + (h)) * HTB)
#define PG8_SB(b, h) ((4 + (b) * 2 + (h)) * HTB)
#define PG8_STAGE(bufoff, gbase, voff) do { _Pragma("unroll") for (int _i = 0; _i < 2; ++_i) \
        __builtin_amdgcn_global_load_lds((const unsigned*)((const char*)(gbase) + (voff)[_i]), (PG8_LAS unsigned*)(lds + (bufoff) + ldsw + _i * 8192), 16, 0, 0); } while (0)
#define PG8_LDA(dst, b, h) do { _Pragma("unroll") for (int m = 0; m < 4; ++m) _Pragma("unroll") for (int k = 0; k < 2; ++k) dst[m][k] = *(const PG8_LAS bf16x8*)(lds + PG8_SA(b, h) + aoff + m * 2048 + k * 1024); } while (0)
#define PG8_LDB(dst, b, h) do { _Pragma("unroll") for (int n = 0; n < 2; ++n) _Pragma("unroll") for (int k = 0; k < 2; ++k) dst[n][k] = *(const PG8_LAS bf16x8*)(lds + PG8_SB(b, h) + boff + n * 2048 + k * 1024); } while (0)
#define PG8_MMA(ai, bj, At, Bt) do { __builtin_amdgcn_s_setprio(1); _Pragma("unroll") for (int m = 0; m < 4; ++m) _Pragma("unroll") for (int n = 0; n < 2; ++n) _Pragma("unroll") for (int k = 0; k < 2; ++k) \
        acc[ai][bj][m][n] = __builtin_amdgcn_mfma_f32_16x16x32_bf16(Bt[n][k], At[m][k], acc[ai][bj][m][n], 0, 0, 0); __builtin_amdgcn_s_setprio(0); } while (0)
#define PG8_WAIT_V(n) asm volatile("s_waitcnt vmcnt(" #n ")" ::: "memory")
#define PG8_WAIT_L(n) asm volatile("s_waitcnt lgkmcnt(" #n ")" ::: "memory")
#define PG8_BAR __builtin_amdgcn_s_barrier()
#define PG8_SCHED __builtin_amdgcn_sched_barrier(0)
    Unit cur, nxt; int ui = 0;
    if (!S.next(0, cur)) return;
    f32x4 acc[2][2][4][2];
#pragma unroll
    for (int a = 0; a < 2; ++a)
#pragma unroll
        for (int b = 0; b < 2; ++b)
#pragma unroll
            for (int m = 0; m < 4; ++m)
#pragma unroll
                for (int n = 0; n < 2; ++n) acc[a][b][m][n] = (f32x4){0.f, 0.f, 0.f, 0.f};
    bf16x8 At[4][2], B0[2][2], B1[2][2];
    const char* cA = (const char*)g.A + (size_t)cur.pm * tstep; const char* cB = (const char*)g.Bt + (size_t)cur.pn * tstep;
    S.a_ready(cur);
    if constexpr (SP2) {
        PG8_STAGE(PG8_SB(0, 0), cB, voffB); PG8_STAGE(PG8_SB(0, 1), cB + hstep, voffB); PG8_STAGE(PG8_SA(0, 0), cA, voffA); PG8_STAGE(PG8_SA(0, 1), cA + hstep, voffA);
        if (wr == 1) PG8_BAR;
        PG8_WAIT_V(2); PG8_BAR;
        PG8_STAGE(PG8_SB(1, 0), cB + kstep, voffB); PG8_STAGE(PG8_SA(1, 0), cA + kstep, voffA); PG8_STAGE(PG8_SB(1, 1), cB + hstep + kstep, voffB);
        PG8_WAIT_V(6); PG8_BAR;
    } else {
        PG8_STAGE(PG8_SB(0, 0), cB, voffB); PG8_STAGE(PG8_SA(0, 0), cA, voffA); PG8_STAGE(PG8_SB(0, 1), cB + hstep, voffB); PG8_STAGE(PG8_SA(0, 1), cA + hstep, voffA);
        if (wr == 1) PG8_BAR;
        PG8_WAIT_V(4); PG8_BAR;
        PG8_STAGE(PG8_SB(1, 0), cB + kstep, voffB); PG8_STAGE(PG8_SA(1, 0), cA + kstep, voffA); PG8_STAGE(PG8_SB(1, 1), cB + hstep + kstep, voffB);
        PG8_WAIT_V(6); PG8_BAR;
    }
    for (;;) {
        const bool has_next = S.next(ui + 1, nxt);
        const char* nA = has_next ? (const char*)g.A + (size_t)nxt.pm * tstep : cA; const char* nB = has_next ? (const char*)g.Bt + (size_t)nxt.pn * tstep : cB;
        for (int t = 0; t < nt; t += 2) {
            const bool last = (t == nt - 2);
            const char* a1 = cA + (size_t)(t + 1) * kstep;
            const char* a2 = last ? nA : cA + (size_t)(t + 2) * kstep; const char* b2 = last ? nB : cB + (size_t)(t + 2) * kstep;
            const char* a3 = a2 + kstep; const char* b3 = b2 + kstep;
            if (last && has_next) S.a_ready(nxt);
            if constexpr (SP2) {
            PG8_LDB(B0, 0, 0); PG8_LDB(B1, 0, 1); PG8_SCHED; PG8_LDA(At, 0, 0); PG8_STAGE(PG8_SA(1, 1), a1 + hstep, voffA);
            PG8_WAIT_V(8); PG8_WAIT_L(0); PG8_BAR; PG8_MMA(0, 0, At, B0); PG8_MMA(0, 1, At, B1); PG8_BAR; PG8_SCHED;
            PG8_LDA(At, 0, 1); PG8_STAGE(PG8_SB(0, 0), b2, voffB); PG8_STAGE(PG8_SB(0, 1), b2 + hstep, voffB); PG8_STAGE(PG8_SA(0, 0), a2, voffA);
            PG8_WAIT_V(8); PG8_WAIT_L(0); PG8_BAR; PG8_MMA(1, 0, At, B0); PG8_MMA(1, 1, At, B1); PG8_BAR; PG8_SCHED;
            PG8_LDB(B0, 1, 0); PG8_LDB(B1, 1, 1); PG8_SCHED; PG8_LDA(At, 1, 0); PG8_STAGE(PG8_SA(0, 1), a2 + hstep, voffA);
            PG8_WAIT_V(8); PG8_WAIT_L(0); PG8_BAR; PG8_MMA(0, 0, At, B0); PG8_MMA(0, 1, At, B1); PG8_BAR; PG8_SCHED;
            PG8_LDA(At, 1, 1); PG8_STAGE(PG8_SB(1, 0), b3, voffB); PG8_STAGE(PG8_SB(1, 1), b3 + hstep, voffB); PG8_STAGE(PG8_SA(1, 0), a3, voffA);
            PG8_WAIT_V(8); PG8_WAIT_L(0); PG8_BAR; PG8_MMA(1, 0, At, B0); PG8_MMA(1, 1, At, B1); PG8_BAR; PG8_SCHED;
            } else {
            PG8_LDB(B0, 0, 0); PG8_SCHED; PG8_LDA(At, 0, 0); PG8_STAGE(PG8_SA(1, 1), a1 + hstep, voffA);
            PG8_WAIT_L(8); PG8_BAR; PG8_WAIT_L(0); PG8_MMA(0, 0, At, B0); PG8_BAR; PG8_SCHED;
            PG8_LDB(B1, 0, 1); PG8_STAGE(PG8_SB(0, 0), b2, voffB);
            PG8_BAR; PG8_WAIT_L(0); PG8_MMA(0, 1, At, B1); PG8_BAR;
            PG8_LDA(At, 0, 1); PG8_STAGE(PG8_SA(0, 0), a2, voffA);
            PG8_BAR; PG8_WAIT_L(0); PG8_MMA(1, 0, At, B0); PG8_BAR; PG8_SCHED;
            PG8_STAGE(PG8_SB(0, 1), b2 + hstep, voffB);
            PG8_WAIT_V(6); PG8_BAR; PG8_MMA(1, 1, At, B1); PG8_BAR;
            PG8_LDB(B0, 1, 0); PG8_SCHED; PG8_LDA(At, 1, 0); PG8_STAGE(PG8_SA(0, 1), a2 + hstep, voffA);
            PG8_WAIT_L(8); PG8_BAR; PG8_WAIT_L(0); PG8_MMA(0, 0, At, B0); PG8_BAR; PG8_SCHED;
            PG8_LDB(B1, 1, 1); PG8_STAGE(PG8_SB(1, 0), b3, voffB);
            PG8_BAR; PG8_WAIT_L(0); PG8_MMA(0, 1, At, B1); PG8_BAR;
            PG8_LDA(At, 1, 1); PG8_STAGE(PG8_SA(1, 0), a3, voffA);
            PG8_BAR; PG8_WAIT_L(0); PG8_MMA(1, 0, At, B0); PG8_BAR; PG8_SCHED;
            PG8_STAGE(PG8_SB(1, 1), b3 + hstep, voffB);
            PG8_WAIT_V(6); PG8_BAR; PG8_MMA(1, 1, At, B1); PG8_BAR;
            }
        }
        if constexpr (ALIGN_EPI) { if (wr == 0) PG8_BAR; }
        if constexpr (!Epi::AFTER_DRAIN) { E(acc, cur, wr, wc, fr, fq); S.done(cur); }
        if (!has_next) break;
#pragma unroll
        for (int a = 0; a < 2; ++a)
#pragma unroll
            for (int b = 0; b < 2; ++b)
#pragma unroll
                for (int m = 0; m < 4; ++m)
#pragma unroll
                    for (int n = 0; n < 2; ++n) acc[a][b][m][n] = (f32x4){0.f, 0.f, 0.f, 0.f};
        cur = nxt; cA = nA; cB = nB; ++ui;
        if constexpr (ALIGN_EPI) { if (wr == 1) PG8_BAR; }
    }
    PG8_WAIT_V(0);
    if constexpr (!ALIGN_EPI) { if (wr == 0) PG8_BAR; }
    PG8_BAR;
    if constexpr (Epi::AFTER_DRAIN) { E.fused(acc, cur, wr, wc, fr, fq, lds, wid, lane); S.done(cur); }
#undef PG8_SA
#undef PG8_SB
#undef PG8_STAGE
#undef PG8_LDA
#undef PG8_LDB
#undef PG8_MMA
#undef PG8_WAIT_V
#undef PG8_WAIT_L
#undef PG8_BAR
#undef PG8_SCHED
}
}

#ifndef PH_MASK
#define PH_MASK 127
#endif
#ifndef N_LAYER
#define N_LAYER 2
#endif
constexpr int NWAVES = 8;
#ifndef L1_CUT
#define L1_CUT 7168
#endif
constexpr int TOK = 32768, TOKP = 16384, DM = 1024, FF = 2816, NIN = 1792, NLAYER = N_LAYER, NBLK = TOK / 128;
constexpr size_t WS_SS = 0;
constexpr size_t WS_W = 2u << 20;
constexpr size_t W_GU1 = 0, W_D1 = W_GU1 + (size_t)2 * FF * DM * 2, W_IN = W_D1 + (size_t)DM * FF * 2, W_OUT = W_IN + (size_t)NIN * DM * 2,
                 W_GU2 = W_OUT + (size_t)DM * DM * 2, W_D2 = W_GU2 + (size_t)2 * FF * DM * 2, W_BYTES = W_D2 + (size_t)DM * FF * 2;
constexpr size_t WS_XB = WS_W + W_BYTES;
constexpr size_t WS_R1 = WS_XB + (size_t)TOK * DM * 2;
constexpr size_t WS_Z = WS_R1, WS_MIX = WS_R1 + (size_t)TOK * NIN * 2, WS_H = WS_R1;
constexpr size_t WS_WSB = WS_R1 + (size_t)TOK * FF * 2;
constexpr size_t WS_TAB = WS_WSB + (size_t)NLAYER * 8 * 128 * 128 * 2;
constexpr size_t WS_END = WS_TAB + (size_t)8 * 4 * 388 * 4;
static_assert(WS_MIX + (size_t)TOK * DM * 2 == WS_WSB && WS_XB % 256 == 0 && WS_R1 % 256 == 0, "d_ws map");
constexpr int LDSCTL_OFF = 147456 - 256;
constexpr size_t WS_BAR = 0x1D0000, WS_BAR_BYTES = 16384;
constexpr int LDS_BYTES = 147456;

#define LAS __attribute__((address_space(3)))
typedef unsigned short bf16;
typedef unsigned v4u __attribute__((ext_vector_type(4)));
typedef unsigned v2u __attribute__((ext_vector_type(2)));
typedef float f32x4 __attribute__((ext_vector_type(4)));
typedef short bf16x8 __attribute__((ext_vector_type(8)));
typedef short s16x4 __attribute__((ext_vector_type(4)));
typedef short v4i16_t __attribute__((ext_vector_type(4)));
#define LDS_WAIT() asm volatile("s_waitcnt lgkmcnt(0)" ::: "memory")
typedef float f32x2_t __attribute__((ext_vector_type(2)));
typedef __bf16 bf16x2_t __attribute__((ext_vector_type(2)));
__device__ __forceinline__ unsigned pk2(float lo, float hi) { f32x2_t v = {lo, hi}; bf16x2_t b = __builtin_convertvector(v, bf16x2_t); return __builtin_bit_cast(unsigned, b); }
__device__ __forceinline__ float bf_lo(unsigned w) { return __builtin_bit_cast(float, w << 16); }
__device__ __forceinline__ float bf_hi(unsigned w) { return __builtin_bit_cast(float, w & 0xffff0000u); }
__device__ __forceinline__ s16x4 vtr(const LAS unsigned char* p) { return __builtin_bit_cast(s16x4, __builtin_amdgcn_ds_read_tr16_b64_v4i16((LAS v4i16_t*)p)); }
__device__ __forceinline__ int opaque(int v) { asm volatile("" : "+s"(v)); return v; }
__device__ __forceinline__ float wave_sum(float v) {
#pragma unroll
    for (int o = 1; o < 64; o <<= 1) v += __shfl_xor(v, o);
    return v;
}

#define XB_TMO      128
#define XB_XCNT(j)  (256  + 64 * (j))
#define XB_XSUB(j)  (1280 + 64 * (j))
#define XB_XGEN(j)  (2304 + 64 * (j))
#define XB_TOP      3328
#define XB_TOPGEN   3392
#define XCD_BAR_WORDS 3456
#define XB_SPIN_CAP (1u << 18)

__device__ __forceinline__ unsigned xb_ld(unsigned* p)              { return __hip_atomic_load(p, __ATOMIC_RELAXED, __HIP_MEMORY_SCOPE_AGENT); }
__device__ __forceinline__ unsigned xb_add(unsigned* p, unsigned v) { return __hip_atomic_fetch_add(p, v, __ATOMIC_RELAXED, __HIP_MEMORY_SCOPE_AGENT); }
__device__ __forceinline__ unsigned xb_xcc_id() { return (unsigned)__builtin_amdgcn_s_getreg((3 << 11) | 20) & 0xFu; }
#define XB_SPIN(cond, bar) do { unsigned _sp = 0; while (cond) { __builtin_amdgcn_s_sleep(1); \
    if ((++_sp & 255u) == 0u) { if (xb_ld(&(bar)[XB_TMO])) break; if (_sp > XB_SPIN_CAP) { atomicAdd(&(bar)[XB_TMO], 1u); break; } } } } while (0)

struct XcdBarrier {
    unsigned* bar; unsigned x;
    volatile LAS unsigned* st;
};

__device__ __forceinline__ XcdBarrier xcd_barrier_post(unsigned* bar, volatile LAS unsigned* st) {
    XcdBarrier b; b.bar = bar; b.x = xb_xcc_id(); b.st = st;
    if (threadIdx.x == 0) (void)xb_add(&bar[XB_XCNT(b.x)], 1u);
    return b;
}
__device__ __forceinline__ void xcd_barrier_complete(unsigned* bar, unsigned x, unsigned& nloc, unsigned& nx) {
    const unsigned G = gridDim.x * gridDim.y * gridDim.z;
    unsigned sum, cnt, mine, sp = 0u;
    for (;;) {
        sum = 0u; cnt = 0u; mine = 0u;
#pragma unroll
        for (unsigned j = 0; j < 16; ++j) { const unsigned c = xb_ld(&bar[XB_XCNT(j)]); sum += c; cnt += (c > 0u) ? 1u : 0u; mine = (j == x) ? c : mine; }
        if (sum == G) break;
        __builtin_amdgcn_s_sleep(1);
        if ((++sp & 255u) == 0u) { if (xb_ld(&bar[XB_TMO])) break; if (sp > XB_SPIN_CAP) { atomicAdd(&bar[XB_TMO], 1u); break; } }
    }
    nloc = mine > 0u ? mine : 1u; nx = cnt > 0u ? cnt : 1u;
}

__device__ __forceinline__ void xcd_barrier(const XcdBarrier& b) {
    asm volatile("s_waitcnt vmcnt(0)" ::: "memory");
    __syncthreads();
    if (threadIdx.x == 0) {
        unsigned* bar = b.bar;
        __builtin_amdgcn_s_waitcnt(0);
        unsigned nloc = b.st[0], nx = b.st[1];
        if (nloc == 0u) { xcd_barrier_complete(bar, b.x, nloc, nx); b.st[0] = nloc; b.st[1] = nx; }
        const unsigned old = xb_add(&bar[XB_XSUB(b.x)], 1u);
        const unsigned gen = old / nloc;
        if (old + 1u == (gen + 1u) * nloc) {
            __builtin_amdgcn_fence(__ATOMIC_RELEASE, "agent");
            asm volatile("s_waitcnt vmcnt(0)" ::: "memory");
            const unsigned og = xb_add(&bar[XB_TOP], 1u);
            const unsigned tg = og / nx;
            if (og + 1u == (tg + 1u) * nx) xb_add(&bar[XB_TOPGEN], 1u);
            else XB_SPIN(xb_ld(&bar[XB_TOPGEN]) == tg, bar);
            __builtin_amdgcn_fence(__ATOMIC_ACQUIRE, "agent");
            xb_add(&bar[XB_XGEN(b.x)], 1u);
            asm volatile("s_waitcnt vmcnt(0)" ::: "memory");
        } else {
            XB_SPIN(xb_ld(&bar[XB_XGEN(b.x)]) == gen, bar);
            __builtin_amdgcn_fence(__ATOMIC_ACQUIRE, "agent");
            asm volatile("s_waitcnt vmcnt(0)" ::: "memory");
        }
    }
    __syncthreads();
}

struct Args {
    const float *x_prompt, *x_sample, *norm_ffn1, *w1_gate, *w1_up, *w1_down, *norm_mix, *w_in, *sink, *vgain, *w_sp, *b_sp, *w_out, *norm_ffn2, *w2_gate, *w2_up, *w2_down, *norm_final;
    float* out; unsigned char* ws;
};

typedef const __attribute__((address_space(4))) Args* KArgs;
__device__ __forceinline__ KArgs kargs() { const __attribute__((address_space(4))) void* p = (const __attribute__((address_space(4))) void*)__builtin_amdgcn_kernarg_segment_ptr(); asm volatile("" : "+s"(p)); return (KArgs)p; }
__device__ __forceinline__ void conv_item(const float* W, int ldn, int K, const float* gain, bf16* WT, int dst_row0, int src_col0, int k0, LAS float* scr, int lane) {
    f32x4 v[8]; float g[8];
#pragma unroll
    for (int i = 0; i < 8; ++i) { const int kk = 8 * i + (lane >> 3); v[i] = *(const f32x4*)(W + (size_t)(k0 + kk) * ldn + src_col0 + 4 * (lane & 7)); g[i] = gain ? gain[k0 + kk] : 1.0f; }
#pragma unroll
    for (int i = 0; i < 8; ++i) { const int kk = 8 * i + (lane >> 3); LAS float* s = scr + kk * 33 + 4 * (lane & 7); s[0] = v[i][0] * g[i]; s[1] = v[i][1] * g[i]; s[2] = v[i][2] * g[i]; s[3] = v[i][3] * g[i]; }
    LDS_WAIT(); asm volatile("" ::: "memory");
    const int c = lane & 7;
#pragma unroll
    for (int j = 0; j < 4; ++j) { const int n = (lane >> 3) + 8 * j; const LAS float* s = scr + (8 * c) * 33 + n;
        v4u o; o.x = pk2(s[0 * 33], s[1 * 33]); o.y = pk2(s[2 * 33], s[3 * 33]); o.z = pk2(s[4 * 33], s[5 * 33]); o.w = pk2(s[6 * 33], s[7 * 33]);
        *(v4u*)(WT + (size_t)(dst_row0 + n) * K + k0 + 8 * c) = o; }
    LDS_WAIT(); asm volatile("" ::: "memory");
}
__device__ __forceinline__ void convert_layer(KArgs a, int l, LAS unsigned char* lds, int gw, int NGW, int wave, int lane, int it_lo, int it_hi) {
    LAS float* scr = (LAS float*)(lds + wave * 16384);
    bf16* Wb = l == 0 ? (bf16*)(a->ws + WS_W) : (bf16*)a->out;
    constexpr int I_GU = (2 * FF / 32) * (DM / 64), I_D = (DM / 32) * (FF / 64), I_IN = (NIN / 32) * (DM / 64), I_OUT = (DM / 32) * (DM / 64);
    constexpr int NITEMS = 2 * I_GU + 2 * I_D + I_IN + I_OUT;
    const int it_end = it_hi < NITEMS ? it_hi : NITEMS;
    for (int it = it_lo + gw; it < it_end; it += NGW) {
        int r = it; const float* src; const float* gain = nullptr; int ldn, K, nblk; size_t dsto; int kind;
        const float *gsrc = nullptr, *usrc = nullptr;
        if (r < I_GU) { kind = 1; gsrc = a->w1_gate + (size_t)l * DM * FF; usrc = a->w1_up + (size_t)l * DM * FF; gain = a->norm_ffn1 + l * DM; ldn = FF; K = DM; nblk = 2 * FF / 32; dsto = W_GU1; }
        else if ((r -= I_GU) < I_D) { kind = 0; gsrc = a->w1_down + (size_t)l * DM * FF; ldn = DM; K = FF; nblk = DM / 32; dsto = W_D1; }
        else if ((r -= I_D) < I_IN) { kind = 2; gsrc = a->w_in + (size_t)l * DM * NIN; gain = a->norm_mix + l * DM; ldn = NIN; K = DM; nblk = NIN / 32; dsto = W_IN; }
        else if ((r -= I_IN) < I_OUT) { kind = 0; gsrc = a->w_out + (size_t)l * DM * DM; ldn = DM; K = DM; nblk = DM / 32; dsto = W_OUT; }
        else if ((r -= I_OUT) < I_GU) { kind = 1; gsrc = a->w2_gate + (size_t)l * DM * FF; usrc = a->w2_up + (size_t)l * DM * FF; gain = a->norm_ffn2 + l * DM; ldn = FF; K = DM; nblk = 2 * FF / 32; dsto = W_GU2; }
        else { r -= I_GU; kind = 0; gsrc = a->w2_down + (size_t)l * DM * FF; ldn = DM; K = FF; nblk = DM / 32; dsto = W_D2; }
        const int kb = r / nblk, nb = r % nblk; int sc0 = 32 * nb; src = gsrc;
        if (kind == 1) { const int pn = nb >> 3, lb = nb & 7; src = lb < 4 ? gsrc : usrc; sc0 = 128 * pn + 32 * (lb & 3); }
        else if (kind == 2 && nb >= 40) { const int t = nb - 40, pnl = t >> 3, lb = t & 7, bj = lb >> 2, wc = lb & 3; sc0 = 1280 + 64 * (4 * pnl + wc) + 32 * bj; }
        conv_item(src, ldn, K, gain, (bf16*)((unsigned char*)Wb + dsto), 32 * nb, sc0, 64 * kb, scr, lane);
    }
}

constexpr int KS_STRIDE = 144;
constexpr int KS_BYTES = 384 * KS_STRIDE;
constexpr int TAB_OFF = 2 * KS_BYTES, TAB_N = 388, TAB_ZERO = 196;
static_assert(TAB_OFF + 4 * 4 * TAB_N * 4 <= LDSCTL_OFF, "LDS map");
constexpr float DEFER_THR = 10.0f;
constexpr int GS_STRIDE = 1040;
static_assert(128 * GS_STRIDE <= LDSCTL_OFF, "LDS map");
__device__ __forceinline__ void mixer_phase(KArgs a, int l, LAS unsigned char* lds, int G, int bid, int tid, int wave, int lane) {
    const bf16* Z = (const bf16*)(a->ws + WS_Z); bf16* MIX = (bf16*)(a->ws + WS_MIX);
    const int fr = lane & 15, fq = lane >> 4, tq = fr >> 2, tp = fr & 3;
    LAS unsigned char* Ks = lds; LAS unsigned char* Vs = lds + KS_BYTES; LAS unsigned char* Gs = lds;
#pragma unroll 1
    for (int blk = bid; blk < NBLK; blk += G) {
        const int sb = blk < 128 ? (blk & ~63) : (blk & ~15), se = sb + (blk < 128 ? 64 : 16);
        const bool has_prev = blk > sb, has_next = blk + 1 < se;
#ifndef MIX_NO_ATT
#ifndef REP_ATT
#define REP_ATT 1
#endif
#pragma unroll 1
        for (int kvh2 = 0; kvh2 < 2 * REP_ATT; ++kvh2) { const int kvh = kvh2 & 1;
            const int hq = kvh * 4 + (wave >> 1), half = wave & 1;
            const float sinkl = a->sink[l * 8 + hq] * pg8::K_LOG2E;
            bf16x8 qf[4][2];
#pragma unroll
            for (int qg = 0; qg < 4; ++qg)
#pragma unroll
                for (int dk = 0; dk < 2; ++dk) qf[qg][dk] = *(const bf16x8*)(Z + (size_t)(128 * blk + 64 * half + 16 * qg + fr) * NIN + hq * 64 + 32 * dk + 8 * fq);
            v4u kvr[6], vvr[6], ttr[4];
#pragma unroll
            for (int i = 0; i < 6; ++i) {
                const int id = tid + 512 * i, kj = id >> 3, c = id & 7, kb = kj >> 7;
                const bool ok = kb == 1 || (kb == 0 ? has_prev : has_next);
                kvr[i] = (v4u){0u, 0u, 0u, 0u}; vvr[i] = (v4u){0u, 0u, 0u, 0u};
                if (ok) { const bf16* zr = Z + (size_t)(128 * (blk - 1) + kj) * NIN + 64 * kvh + 8 * c; kvr[i] = *(const v4u*)(zr + 512); vvr[i] = *(const v4u*)(zr + 640); }
            }
            {
                const v4u* tsrc = (const v4u*)(a->ws + WS_TAB) + kvh * (4 * TAB_N);
#pragma unroll
                for (int i = 0; i < 4; ++i) ttr[i] = tid < TAB_N ? tsrc[4 * tid + i] : (v4u){0u, 0u, 0u, 0u};
            }
            __syncthreads();
#pragma unroll
            for (int i = 0; i < 6; ++i) { const int id = tid + 512 * i, kj = id >> 3, c = id & 7;
                *(LAS v4u*)(Ks + kj * KS_STRIDE + c * 16) = kvr[i]; *(LAS v4u*)(Vs + kj * KS_STRIDE + c * 16) = vvr[i]; }
            if (tid < TAB_N) {
#pragma unroll
                for (int i = 0; i < 4; ++i) *(LAS v4u*)(lds + TAB_OFF + 64 * tid + 16 * i) = ttr[i];
            }
            __syncthreads();
            {
                f32x4 o[4][4];
#pragma unroll
                for (int db = 0; db < 4; ++db)
#pragma unroll
                    for (int qg = 0; qg < 4; ++qg) o[db][qg] = (f32x4){0.f, 0.f, 0.f, 0.f};
                float mrow[4], lsum[4];
#pragma unroll
                for (int qg = 0; qg < 4; ++qg) { mrow[qg] = sinkl; lsum[qg] = 0.f; }
                const int dl0 = 4 * fq - fr, kcp = dl0 & 3;
                const LAS unsigned char* tbl = lds + TAB_OFF + ((wave >> 1) * 4 + kcp) * (TAB_N * 4) + 4 * (dl0 - kcp + TAB_ZERO - 128 - 48);
#pragma unroll 2
                for (int kt = 0; kt < 10; ++kt) {
                    const int key0 = 64 * half + 32 * kt, tb = key0 >> 7;
                    if ((tb == 0 && !has_prev) || (tb == 2 && !has_next)) continue;
                    f32x4 s[2][4];
#pragma unroll
                    for (int kb = 0; kb < 2; ++kb)
#pragma unroll
                        for (int qg = 0; qg < 4; ++qg) s[kb][qg] = (f32x4){0.f, 0.f, 0.f, 0.f};
#pragma unroll
                    for (int kb = 0; kb < 2; ++kb)
#pragma unroll
                        for (int dk = 0; dk < 2; ++dk) {
                            const bf16x8 kf = *(const LAS bf16x8*)(Ks + (key0 + 16 * kb + fr) * KS_STRIDE + 64 * dk + 16 * fq);
#pragma unroll
                            for (int qg = 0; qg < 4; ++qg) s[kb][qg] = __builtin_amdgcn_mfma_f32_16x16x32_bf16(kf, qf[qg][dk], s[kb][qg], 0, 0, 0);
                        }
                    bf16x8 pb[4];
                    const LAS unsigned char* tbp = tbl + 128 * kt;
                    bool need = false;
#pragma unroll
                    for (int qg = 0; qg < 4; ++qg) {
#pragma unroll
                        for (int kb = 0; kb < 2; ++kb) s[kb][qg] = s[kb][qg] + *(const LAS f32x4*)(tbp + 64 * (kb - qg + 3));
                        const float lm = fmaxf(fmaxf(fmaxf(s[0][qg][0], s[0][qg][1]), fmaxf(s[0][qg][2], s[0][qg][3])), fmaxf(fmaxf(s[1][qg][0], s[1][qg][1]), fmaxf(s[1][qg][2], s[1][qg][3])));
                        need |= lm > mrow[qg] + DEFER_THR;
                    }
                    if (__builtin_amdgcn_readfirstlane(__any(need))) {
#pragma unroll
                        for (int qg = 0; qg < 4; ++qg) {
                            float mx = fmaxf(fmaxf(fmaxf(s[0][qg][0], s[0][qg][1]), fmaxf(s[0][qg][2], s[0][qg][3])), fmaxf(fmaxf(s[1][qg][0], s[1][qg][1]), fmaxf(s[1][qg][2], s[1][qg][3])));
                            mx = fmaxf(mx, mrow[qg]);
                            mx = fmaxf(mx, __shfl_xor(mx, 16)); mx = fmaxf(mx, __shfl_xor(mx, 32));
                            const float alpha = __builtin_amdgcn_exp2f(mrow[qg] - mx); mrow[qg] = mx;
                            lsum[qg] = lsum[qg] * alpha;
#pragma unroll
                            for (int db = 0; db < 4; ++db) o[db][qg] = o[db][qg] * alpha;
                        }
                    }
#pragma unroll
                    for (int qg = 0; qg < 4; ++qg) {
                        const float mx = mrow[qg];
                        float ps = 0.f;
#pragma unroll
                        for (int kb = 0; kb < 2; ++kb)
#pragma unroll
                            for (int j = 0; j < 4; ++j) { const float p = __builtin_amdgcn_exp2f(s[kb][qg][j] - mx); s[kb][qg][j] = p; ps += p; }
                        lsum[qg] += ps;
                        v4u w; w.x = pk2(s[0][qg][0], s[0][qg][1]); w.y = pk2(s[0][qg][2], s[0][qg][3]); w.z = pk2(s[1][qg][0], s[1][qg][1]); w.w = pk2(s[1][qg][2], s[1][qg][3]);
                        pb[qg] = __builtin_bit_cast(bf16x8, w);
                    }
#pragma unroll
                    for (int db = 0; db < 4; ++db) {
                        const LAS unsigned char* vp = Vs + (key0 + 4 * fq + tq) * KS_STRIDE + (16 * db + 4 * tp) * 2;
                        const s16x4 lo = vtr(vp), hi = vtr(vp + 16 * KS_STRIDE);
                        const bf16x8 vf = (bf16x8){lo[0], lo[1], lo[2], lo[3], hi[0], hi[1], hi[2], hi[3]};
#pragma unroll
                        for (int qg = 0; qg < 4; ++qg) o[db][qg] = __builtin_amdgcn_mfma_f32_16x16x32_bf16(vf, pb[qg], o[db][qg], 0, 0, 0);
                    }
                }
#pragma unroll
                for (int qg = 0; qg < 4; ++qg) {
                    float lt = lsum[qg]; lt += __shfl_xor(lt, 16); lt += __shfl_xor(lt, 32); lt += __builtin_amdgcn_exp2f(sinkl - mrow[qg]);
                    const float inv = 1.0f / lt;
                    bf16* op = MIX + (size_t)(128 * blk + 64 * half + 16 * qg + fr) * DM + hq * 64 + 4 * fq;
#pragma unroll
                    for (int db = 0; db < 4; ++db) { const f32x4 v = o[db][qg] * inv; v2u w; w.x = pk2(v[0], v[1]); w.y = pk2(v[2], v[3]); *(v2u*)(op + 16 * db) = w; }
                }
            }
        }
#endif
        {
            const int tidg = pg8::opaque_v(tid);
            const int h = wave;
            const v4u* wsb = (const v4u*)(a->ws + WS_WSB) + ((size_t)(l * 8 + h) * 32) * 64 + lane;
            v4u gl[16];
#pragma unroll
            for (int i = 0; i < 16; ++i) { const int id = tidg + 512 * i, srow = id >> 6, c = id & 63; gl[i] = *(const v4u*)(Z + (size_t)(128 * blk + srow) * NIN + 1280 + 8 * c); }
            __syncthreads();
#pragma unroll
            for (int i = 0; i < 16; ++i) { const int id = tidg + 512 * i, srow = id >> 6, c = id & 63; *(LAS v4u*)(Gs + srow * GS_STRIDE + c * 16) = gl[i]; }
#pragma unroll 1
            for (int th = 0; th < 2; ++th) {
                const int tbase = 64 * th;
                v4u wf[4][4]; v2u uu[4][4]; float bias[4];
#pragma unroll
                for (int tb = 0; tb < 4; ++tb) { const size_t row = (size_t)128 * blk + tbase + 16 * tb + fr; bias[tb] = a->b_sp[(l * 8 + h) * 128 + tbase + 16 * tb + fr];
#pragma unroll
                    for (int c = 0; c < 4; ++c) wf[tb][c] = wsb[((4 * th + tb) * 4 + c) * 64];
#pragma unroll
                    for (int db = 0; db < 4; ++db) uu[tb][db] = *(const v2u*)(Z + row * NIN + 768 + 64 * h + 16 * db + 4 * fq); }
                if (th == 0) __syncthreads();
                f32x4 d[4][4];
#pragma unroll
                for (int tb = 0; tb < 4; ++tb)
#pragma unroll
                    for (int db = 0; db < 4; ++db) d[tb][db] = (f32x4){0.f, 0.f, 0.f, 0.f};
#pragma unroll
                for (int c = 0; c < 4; ++c)
#pragma unroll
                    for (int db = 0; db < 4; ++db) {
                        const LAS unsigned char* gp = Gs + (32 * c + 8 * fq + tq) * GS_STRIDE + (64 * h + 16 * db + 4 * tp) * 2;
                        const s16x4 lo = vtr(gp), hi = vtr(gp + 4 * GS_STRIDE);
                        const bf16x8 af = (bf16x8){lo[0], lo[1], lo[2], lo[3], hi[0], hi[1], hi[2], hi[3]};
#pragma unroll
                        for (int tb = 0; tb < 4; ++tb) d[tb][db] = __builtin_amdgcn_mfma_f32_16x16x32_bf16(af, __builtin_bit_cast(bf16x8, wf[tb][c]), d[tb][db], 0, 0, 0);
                    }
#pragma unroll
                for (int tb = 0; tb < 4; ++tb) { const size_t row = (size_t)128 * blk + tbase + 16 * tb + fr;
#pragma unroll
                    for (int db = 0; db < 4; ++db) {
                        const int d0 = 64 * h + 16 * db + 4 * fq; const v2u u2 = uu[tb][db]; const f32x4 dv = d[tb][db]; const float bs = bias[tb];
                        v2u w; w.x = pk2(bf_lo(u2.x) * (dv[0] + bs), bf_hi(u2.x) * (dv[1] + bs)); w.y = pk2(bf_lo(u2.y) * (dv[2] + bs), bf_hi(u2.y) * (dv[3] + bs));
                        *(v2u*)(MIX + row * DM + 512 + d0) = w;
                    } }
            }
        }
    }
    __syncthreads();
}

#define GRID_SYNC1() do { XcdBarrier b_ = bar; b_.x = (unsigned)opaque((int)bar.x); xcd_barrier(b_); } while (0)
#ifdef DUP_SYNC
#define GRID_SYNC() do { GRID_SYNC1(); GRID_SYNC1(); } while (0)
#else
#define GRID_SYNC() GRID_SYNC1()
#endif
__global__ void __launch_bounds__(NWAVES * 64, 2) fwd_megakernel(Args a) {
    extern __shared__ __attribute__((aligned(16))) unsigned char lds_raw[];
    LAS unsigned char* lds = (LAS unsigned char*)lds_raw;
    cg::grid_group grid = cg::this_grid();
    const int tid = threadIdx.x, lane = tid & 63, wave = __builtin_amdgcn_readfirstlane(tid >> 6);
    const int G = gridDim.x, bid = blockIdx.x;
    const int vcu = (G % 8 == 0) ? (bid % 8) * (G / 8) + bid / 8 : bid;
    const int gw = vcu * NWAVES + wave, NGW = G * NWAVES;
    if (tid < 64) ((LAS unsigned*)(lds + LDSCTL_OFF))[tid] = 0u;
    __syncthreads();
    const XcdBarrier bar = xcd_barrier_post((unsigned*)(kargs()->ws + WS_BAR), (volatile LAS unsigned*)(lds + LDSCTL_OFF));
    grid.sync();
#define KA (kargs())
#define X (KA->out)
#define SS ((pg8::ss_t*)(KA->ws + WS_SS))
#define XB ((bf16*)(KA->ws + WS_XB))
#define Wb (l == 0 ? (bf16*)(KA->ws + WS_W) : (bf16*)KA->out)
#define Hb ((bf16*)(KA->ws + WS_H))
#define Zb ((bf16*)(KA->ws + WS_Z))
#define MIXb ((bf16*)(KA->ws + WS_MIX))

    { bf16* xb_ = XB; pg8::ss_t* ss_ = SS; const float* xp_ = KA->x_prompt; const float* xs_ = KA->x_sample;
    for (int r0 = gw; r0 < TOK; r0 += 4 * NGW) {
        f32x4 v[4][4];
#pragma unroll
        for (int q = 0; q < 4; ++q) { const int r = r0 + q * NGW; const float* src = r < TOKP ? xp_ + (size_t)r * DM : xs_ + (size_t)(r - TOKP) * DM;
#pragma unroll
            for (int j = 0; j < 4; ++j) v[q][j] = *(const f32x4*)(src + 256 * j + 4 * lane); }
#pragma unroll
        for (int q = 0; q < 4; ++q) { const int r = r0 + q * NGW; float s = 0.f;
#pragma unroll
            for (int j = 0; j < 4; ++j) { const f32x4 x = v[q][j]; v2u w; w.x = pk2(x[0], x[1]); w.y = pk2(x[2], x[3]); *(v2u*)(xb_ + (size_t)r * DM + 256 * j + 4 * lane) = w;
                s += (x[0] * x[0] + x[1] * x[1]) + (x[2] * x[2] + x[3] * x[3]); }
            s = wave_sum(s);
            if (lane == 0) ss_[r] = pg8::ss_fix(s); }
    }
    for (int i = bid * 512 + tid; i < 6 * TOK; i += G * 512) ss_[TOK + i] = 0ull; }
    {
        float* tab_ = (float*)(KA->ws + WS_TAB);
        for (int e = bid * 512 + tid; e < 8 * 4 * TAB_N; e += G * 512) {
            const int hd = e / (4 * TAB_N), k = (e / TAB_N) & 3, i = e % TAB_N, rel = i + k - TAB_ZERO, ad = rel < 0 ? -rel : rel;
            const float sl = __builtin_amdgcn_exp2f(-(float)(hd + 1)) * pg8::K_LOG2E;
            tab_[e] = ad <= 128 ? -sl * (float)ad : -INFINITY;
        }
    }
    {
        const float* wsp_ = KA->w_sp; v4u* wsb_ = (v4u*)(KA->ws + WS_WSB);
        for (int e = bid * 512 + tid; e < NLAYER * 8 * 32 * 64; e += G * 512) {
            const int ln = e & 63, f = e >> 6, c = f & 3, tb = (f >> 2) & 7, lh = f >> 5;
            const float* wp = wsp_ + ((size_t)lh * 128 + 16 * tb + (ln & 15)) * 128 + 32 * c + 8 * (ln >> 4);
            const f32x4 w0 = *(const f32x4*)wp, w1 = *(const f32x4*)(wp + 4);
            v4u o; o.x = pk2(w0[0], w0[1]); o.y = pk2(w0[2], w0[3]); o.z = pk2(w1[0], w1[1]); o.w = pk2(w1[2], w1[3]);
            wsb_[e] = o;
        }
    }
    const int l1_cut = (G == 256) ? L1_CUT : 0;
    convert_layer(kargs(), 0, lds, gw, NGW, wave, lane, 0, 1 << 30);
    convert_layer(kargs(), 1, lds, gw, NGW, wave, lane, l1_cut, 1 << 30);
    GRID_SYNC();

    for (int l = 0; l < NLAYER; ++l) {
        #define ssA (SS + (size_t)(3 * l) * TOK)
#define ssB (SS + (size_t)(3 * l + 1) * TOK)
#define ssC (SS + (size_t)(3 * l + 2) * TOK)
#define ssD (SS + (size_t)(3 * l + 3) * TOK)
        if (PH_MASK & 1) { pg8::Gemm g{XB, (const bf16*)((unsigned char*)Wb + W_GU1), TOK, 2 * FF, DM}; pg8::StaticOrder S; S.init(TOK, 2 * FF, G, opaque(bid));
          pg8::EpiSwiglu E{Hb, FF, ssA};
#ifdef DUP_PA
          pg8::gemm_phase<pg8::EpiSwiglu, pg8::StaticOrder, true, true>(lds, g, S, E); __syncthreads();
#endif
          pg8::gemm_phase<pg8::EpiSwiglu, pg8::StaticOrder, true, true>(lds, g, S, E); }
        GRID_SYNC();
        if (PH_MASK & 2) { pg8::Gemm g{Hb, (const bf16*)((unsigned char*)Wb + W_D1), TOK, DM, FF}; pg8::StaticOrder S; S.init(TOK, DM, G, opaque(bid));
          pg8::EpiResid E{XB, ssB, 0.5f};
#ifdef DUP_PB
          { pg8::EpiResid E0{XB, nullptr, 0.0f}; pg8::gemm_phase<pg8::EpiResid, pg8::StaticOrder, true, true>(lds, g, S, E0); __syncthreads(); }
#endif
          pg8::gemm_phase<pg8::EpiResid, pg8::StaticOrder, true, true>(lds, g, S, E); }
        GRID_SYNC();
        if (PH_MASK & 4) { pg8::Gemm g{XB, (const bf16*)((unsigned char*)Wb + W_IN), TOK, NIN, DM}; pg8::StaticOrder S; S.init(TOK, NIN, G, opaque(bid));
          pg8::EpiInProj E{Zb, ssB, KA->vgain + l * 512};
          pg8::gemm_phase<pg8::EpiInProj, pg8::StaticOrder, true, true>(lds, g, S, E); }
        if (l == 0 && G == 256 && bid >= 128) {
          const int t_ = pg8::opaque_v((int)threadIdx.x), w_ = __builtin_amdgcn_readfirstlane(t_ >> 6);
          convert_layer(kargs(), 1, lds, (opaque(bid) - 128) * NWAVES + w_, 128 * NWAVES, w_, t_ & 63, 0, L1_CUT); }
        GRID_SYNC();
#ifdef MIXER_COPY
        if (PH_MASK & 8) { for (size_t i = (size_t)bid * 512 + threadIdx.x; i < (size_t)TOK * 128; i += (size_t)G * 512) { const size_t r = i >> 7, c = i & 127; *(v4u*)(MIXb + r * DM + 8 * c) = *(const v4u*)(Zb + r * NIN + 8 * c); } }
#else
        if (PH_MASK & 8) { const int t_ = pg8::opaque_v((int)threadIdx.x); mixer_phase(kargs(), l, lds, G, opaque(vcu), t_, __builtin_amdgcn_readfirstlane(t_ >> 6), t_ & 63); }
#ifdef DUP_PD
        { const int t_ = pg8::opaque_v((int)threadIdx.x); mixer_phase(kargs(), l, lds, G, opaque(vcu), t_, __builtin_amdgcn_readfirstlane(t_ >> 6), t_ & 63); }
#endif
#endif
        GRID_SYNC();
        if (PH_MASK & 16) { pg8::Gemm g{MIXb, (const bf16*)((unsigned char*)Wb + W_OUT), TOK, DM, DM}; pg8::StaticOrder S; S.init(TOK, DM, G, opaque(bid));
          pg8::EpiResid E{XB, ssC, 1.0f};
#ifdef DUP_PB
          { pg8::EpiResid E0{XB, nullptr, 0.0f}; pg8::gemm_phase<pg8::EpiResid, pg8::StaticOrder, true, true>(lds, g, S, E0); __syncthreads(); }
#endif
          pg8::gemm_phase<pg8::EpiResid, pg8::StaticOrder, true, true>(lds, g, S, E); }
        GRID_SYNC();
        if (PH_MASK & 32) { pg8::Gemm g{XB, (const bf16*)((unsigned char*)Wb + W_GU2), TOK, 2 * FF, DM}; pg8::StaticOrder S; S.init(TOK, 2 * FF, G, opaque(bid));
          pg8::EpiSwiglu E{Hb, FF, ssC};
#ifdef DUP_PA
          pg8::gemm_phase<pg8::EpiSwiglu, pg8::StaticOrder, true, true>(lds, g, S, E); __syncthreads();
#endif
          pg8::gemm_phase<pg8::EpiSwiglu, pg8::StaticOrder, true, true>(lds, g, S, E); }
        GRID_SYNC();
        if (PH_MASK & 64) { pg8::Gemm g{Hb, (const bf16*)((unsigned char*)Wb + W_D2), TOK, DM, FF}; pg8::StaticOrder S; S.init(TOK, DM, G, opaque(bid));
          pg8::EpiResid E{XB, ssD, 0.5f};
#ifdef DUP_PB
          { pg8::EpiResid E0{XB, nullptr, 0.0f}; pg8::gemm_phase<pg8::EpiResid, pg8::StaticOrder, true, true>(lds, g, S, E0); __syncthreads(); }
#endif
          pg8::gemm_phase<pg8::EpiResid, pg8::StaticOrder, true, true>(lds, g, S, E); }
        GRID_SYNC();
    }
    {
        const int t_ = pg8::opaque_v((int)threadIdx.x), lane = t_ & 63, gw = opaque(vcu) * NWAVES + __builtin_amdgcn_readfirstlane(t_ >> 6);
        const pg8::ss_t* ssF = SS + (size_t)6 * TOK; const bf16* xb_ = XB; float* out_ = X;
        f32x4 gn[4];
#pragma unroll
        for (int j = 0; j < 4; ++j) gn[j] = *(const f32x4*)(KA->norm_final + 256 * j + 4 * lane);
        for (int r0 = gw; r0 < TOK; r0 += 4 * NGW) {
            v2u w[4][4]; pg8::ss_t sv[4];
#pragma unroll
            for (int q = 0; q < 4; ++q) { const int r = r0 + q * NGW; sv[q] = ssF[r];
#pragma unroll
                for (int j = 0; j < 4; ++j) w[q][j] = *(const v2u*)(xb_ + (size_t)r * DM + 256 * j + 4 * lane); }
#pragma unroll
            for (int q = 0; q < 4; ++q) { const int r = r0 + q * NGW; const float rs = pg8::rs_of(sv[q]);
#pragma unroll
                for (int j = 0; j < 4; ++j) { const f32x4 v = (f32x4){bf_lo(w[q][j].x), bf_hi(w[q][j].x), bf_lo(w[q][j].y), bf_hi(w[q][j].y)}; *(f32x4*)(out_ + (size_t)r * DM + 256 * j + 4 * lane) = v * rs * gn[j]; } }
        }
    }
}
#undef KA
#undef X
#undef SS
#undef XB
#undef Wb
#undef Hb
#undef Zb
#undef MIXb
#undef ssA
#undef ssB
#undef ssC
#undef ssD

extern "C" void kernel_launch(void* const* d_in, const int* in_sizes, int n_in, void* d_out, int out_size, void* d_ws, size_t ws_size, hipStream_t stream) {
    static int grid = 0;
    if (grid == 0) {
        if (n_in != 18 || out_size != TOK * DM || ws_size < WS_END) { fprintf(stderr, "kernel_launch: unexpected shapes (n_in %d out %d ws %zu, need %zu)\n", n_in, out_size, ws_size, (size_t)WS_END); grid = -1; return; }
        int dev = 0, cus = 0, per_cu = 0;
        if (hipGetDevice(&dev) != hipSuccess || hipDeviceGetAttribute(&cus, hipDeviceAttributeMultiprocessorCount, dev) != hipSuccess) { grid = -1; return; }
        if (hipFuncSetAttribute((const void*)fwd_megakernel, hipFuncAttributeMaxDynamicSharedMemorySize, LDS_BYTES) != hipSuccess) { fprintf(stderr, "kernel_launch: hipFuncSetAttribute failed\n"); grid = -1; return; }
        if (hipOccupancyMaxActiveBlocksPerMultiprocessor(&per_cu, (const void*)fwd_megakernel, NWAVES * 64, LDS_BYTES) != hipSuccess || per_cu < 1) { fprintf(stderr, "kernel_launch: occupancy query says %d\n", per_cu); per_cu = 1; }
        (void)hipGetLastError();
        grid = cus;
    }
    if (grid < 0) return;
    if (hipMemsetAsync((char*)d_ws + WS_BAR, 0, WS_BAR_BYTES, stream) != hipSuccess) { fprintf(stderr, "kernel_launch: memset failed\n"); return; }
    Args a{};
    const float** f = (const float**)&a;
    for (int i = 0; i < 18; ++i) f[i] = (const float*)d_in[i];
    a.out = (float*)d_out; a.ws = (unsigned char*)d_ws;
    void* args[] = {&a};
    hipError_t e = hipLaunchCooperativeKernel((const void*)fwd_megakernel, dim3(grid), dim3(NWAVES * 64), args, LDS_BYTES, stream);
    if (e != hipSuccess) fprintf(stderr, "kernel_launch: cooperative launch failed: %s (grid %d)\n", hipGetErrorString(e), grid);
}
```

```cpp
#include <hip/hip_runtime.h>
#include <hip/hip_cooperative_groups.h>
#include <cstdio>
#include <cstdint>
#include <cmath>
namespace cg = cooperative_groups;
namespace pg8 {
#define PG8_LAS __attribute__((address_space(3)))
typedef unsigned short bf16_t;
typedef short bf16x8 __attribute__((ext_vector_type(8)));
typedef float f32x4 __attribute__((ext_vector_type(4)));
typedef unsigned u32x4 __attribute__((ext_vector_type(4)));
constexpr int BM = 256, BK = 64, HALF = 128, HTB = HALF * BK * 2  , STAGE_BYTES = 8 * HTB, NXCD = 8, WGM = 8;

__host__ __device__ __forceinline__ int lds_byte(int r, int c) { const int st = (r >> 4) * 2 + (c >> 5), rr = r & 15, cc = c & 31, ob = rr * 64 + cc * 2; return st * 1024 + (ob ^ (((ob >> 9) & 1) << 5)); }
__host__ __device__ __forceinline__ void stage_rc(int b, int& R, int& C) { const int st = b / 1024, sb = b % 1024, swz = sb ^ (((sb >> 9) & 1) << 5); R = (st >> 1) * 16 + swz / 64; C = (st & 1) * 32 + (swz % 64) / 2; }
__host__ __device__ __forceinline__ int perm32(int rho) { const int n = rho >> 4, i = rho & 15; return 8 * (i >> 2) + 4 * n + (i & 3); }

struct Unit { int pm, pn; };
struct Gemm { const bf16_t* A; const bf16_t* Bt; int M, N, K; };

struct StaticOrder {
    int nM, nN, nwg, G, c;
    __host__ __device__ void init(int M, int N, int G_, int c_) { nM = M / BM; nN = N / BM; nwg = nM * nN; G = G_; c = c_; }
    __host__ __device__ bool next(int i, Unit& u) const {
        const long L = (long)i * G + c; if (L >= nwg) return false;
        int wgid = (int)L; { const int q = nwg / NXCD, r = nwg % NXCD, xcd = wgid % NXCD, off = wgid / NXCD; wgid = (xcd < r ? xcd * (q + 1) : r * (q + 1) + (xcd - r) * q) + off; }
        const int nig = WGM * nN, gid = wgid / nig, fm = gid * WGM, gsz = (nM - fm) < WGM ? (nM - fm) : WGM;
        u.pm = fm + ((wgid % nig) % gsz); u.pn = (wgid % nig) / gsz; return true;
    }
    __device__ __forceinline__ void a_ready(const Unit&) const {}
    __device__ __forceinline__ void done(const Unit&) const {}
};

__device__ __forceinline__ unsigned cvt_pk_bf16(float lo, float hi) { unsigned r; asm volatile("v_cvt_pk_bf16_f32 %0, %1, %2" : "=v"(r) : "v"(lo), "v"(hi)); return r; }
typedef float f32x2 __attribute__((ext_vector_type(2)));
struct ReverseOrder : StaticOrder {
    int R;
    __device__ void initr(int M, int N, int G_, int c_) { init(M, N, G_, c_); R = (nwg % G_ == 0) ? nwg / G_ : 0; }
    __device__ bool next(int i, Unit& u) const { return R ? (i < R ? StaticOrder::next(R - 1 - i, u) : false) : StaticOrder::next(i, u); }
};
constexpr float RMS_EPS = 1e-6f;
__device__ __forceinline__ int opaque_v(int v) { asm volatile("" : "+v"(v)); return v; }
constexpr float K_LOG2E = 1.4426950408889634f;
__device__ __forceinline__ float fast_exp2(float x) { return __builtin_amdgcn_exp2f(x); }
__device__ __forceinline__ float fast_rcp(float x) { return __builtin_amdgcn_rcpf(x); }
__device__ __forceinline__ float silu_f(float g) { return g * fast_rcp(1.0f + fast_exp2(-K_LOG2E * g)); }
__device__ __forceinline__ float gelu_tanh_f(float v) { const float t = v * (1.0f + 0.044715f * v * v); return v * fast_rcp(1.0f + fast_exp2(-2.3022081978f * t)); }
typedef unsigned long long ss_t;
constexpr float SS_SCALE = 1048576.0f;
__device__ __forceinline__ ss_t ss_fix(float s) { return (ss_t)(s * SS_SCALE + 0.5f); }
__device__ __forceinline__ float rs_of(ss_t v) { return __builtin_amdgcn_rsqf((float)v * (1.0f / (1024.0f * SS_SCALE)) + RMS_EPS); }
__device__ __forceinline__ float row_rs(const ss_t* ss, int row) { return __builtin_amdgcn_rsqf((float)ss[row] * (1.0f / (1024.0f * SS_SCALE)) + RMS_EPS); }

__device__ __forceinline__ f32x2 swiglu_pk(f32x2 ag, f32x2 au, float rsn, float rs2) {
    const f32x2 t = ag * rsn; f32x2 e; e.x = fast_exp2(t.x); e.y = fast_exp2(t.y);
    const f32x2 den = e + 1.0f; f32x2 r; r.x = fast_rcp(den.x); r.y = fast_rcp(den.y);
    return ((ag * au) * rs2) * r;
}
struct EpiSwiglu {
    static constexpr bool PERM = true, AFTER_DRAIN = false;
    bf16_t* H; int ldh; const ss_t* ss;
    __device__ __forceinline__ void operator()(const f32x4 (&acc)[2][2][4][2], const Unit& u, int wr, int wc, int fr, int fq) const {
        const int row0 = u.pm * BM + wr * 64 + fr, col0 = u.pn * HALF + wc * 32 + 8 * fq;
        ss_t sv[2][4];
#pragma unroll
        for (int ai = 0; ai < 2; ++ai)
#pragma unroll
            for (int m = 0; m < 4; ++m) sv[ai][m] = ss[row0 + ai * HALF + m * 16];
#pragma unroll
        for (int ai = 0; ai < 2; ++ai)
#pragma unroll
            for (int m = 0; m < 4; ++m) {
                const int row = row0 + ai * HALF + m * 16; const float rs = rs_of(sv[ai][m]), rsn = -K_LOG2E * rs, rs2 = rs * rs;
                const f32x4 ag0 = acc[ai][0][m][0], ag1 = acc[ai][0][m][1], au0 = acc[ai][1][m][0], au1 = acc[ai][1][m][1];
                const f32x2 h0 = swiglu_pk((f32x2){ag0[0], ag0[1]}, (f32x2){au0[0], au0[1]}, rsn, rs2), h1 = swiglu_pk((f32x2){ag0[2], ag0[3]}, (f32x2){au0[2], au0[3]}, rsn, rs2);
                const f32x2 h2 = swiglu_pk((f32x2){ag1[0], ag1[1]}, (f32x2){au1[0], au1[1]}, rsn, rs2), h3 = swiglu_pk((f32x2){ag1[2], ag1[3]}, (f32x2){au1[2], au1[3]}, rsn, rs2);
                u32x4 w; w.x = cvt_pk_bf16(h0.x, h0.y); w.y = cvt_pk_bf16(h1.x, h1.y); w.z = cvt_pk_bf16(h2.x, h2.y); w.w = cvt_pk_bf16(h3.x, h3.y);
                *(u32x4*)(H + (size_t)row * ldh + col0) = w;
                asm volatile("" ::: "memory");
            }
    }
};
__device__ __forceinline__ float bfl(unsigned w) { return __builtin_bit_cast(float, w << 16); }
__device__ __forceinline__ float bfh(unsigned w) { return __builtin_bit_cast(float, w & 0xffff0000u); }
struct EpiResid {
    static constexpr bool PERM = true, AFTER_DRAIN = false;
    bf16_t* XB; ss_t* ssn; float scale;
    __device__ __forceinline__ void operator()(const f32x4 (&acc)[2][2][4][2], const Unit& u, int wr, int wc, int fr, int fq) const {
        const int row0 = u.pm * BM + wr * 64 + fr, col0 = u.pn * BM + wc * 32 + 8 * fq;
#pragma unroll
        for (int ai = 0; ai < 2; ++ai) {
            u32x4 xw[4][2];
#pragma unroll
            for (int m = 0; m < 4; ++m)
#pragma unroll
                for (int bj = 0; bj < 2; ++bj) xw[m][bj] = *(const u32x4*)(XB + (size_t)(row0 + ai * HALF + m * 16) * 1024 + col0 + bj * HALF);
#pragma unroll
            for (int m = 0; m < 4; ++m) {
                const int row = row0 + ai * HALF + m * 16; float s = 0.f;
#pragma unroll
                for (int bj = 0; bj < 2; ++bj) {
                    bf16_t* xp = XB + (size_t)row * 1024 + col0 + bj * HALF;
                    const u32x4 w0 = xw[m][bj];
                    f32x4 x0 = (f32x4){bfl(w0.x), bfh(w0.x), bfl(w0.y), bfh(w0.y)}, x1 = (f32x4){bfl(w0.z), bfh(w0.z), bfl(w0.w), bfh(w0.w)};
                    x0 = x0 + acc[ai][bj][m][0] * scale; x1 = x1 + acc[ai][bj][m][1] * scale;
                    s += (x0[0] * x0[0] + x0[1] * x0[1]) + (x0[2] * x0[2] + x0[3] * x0[3]) + (x1[0] * x1[0] + x1[1] * x1[1]) + (x1[2] * x1[2] + x1[3] * x1[3]);
                    u32x4 w; w.x = cvt_pk_bf16(x0[0], x0[1]); w.y = cvt_pk_bf16(x0[2], x0[3]); w.z = cvt_pk_bf16(x1[0], x1[1]); w.w = cvt_pk_bf16(x1[2], x1[3]);
                    *(u32x4*)xp = w;
                }
                s += __shfl_xor(s, 16); s += __shfl_xor(s, 32);
                if (fq == 0 && ssn) atomicAdd(ssn + row, ss_fix(s));
            }
            asm volatile("" ::: "memory");
        }
    }
};
struct EpiInProj {
    static constexpr bool PERM = true, AFTER_DRAIN = false;
    bf16_t* Z; const ss_t* ss; const float* vgain;
    __device__ __forceinline__ void operator()(const f32x4 (&acc)[2][2][4][2], const Unit& u, int wr, int wc, int fr, int fq) const {
        const int row0 = u.pm * BM + wr * 64 + fr, pn = u.pn;
        const int mode = pn < 2 ? 0 : (pn == 2 ? 1 : (pn < 5 ? 2 : 3));
        int colb[2]; f32x4 gv[2][2];
#pragma unroll
        for (int bj = 0; bj < 2; ++bj) {
            colb[bj] = mode == 3 ? 1280 + 64 * (4 * (pn - 5) + wc) + 32 * bj + 8 * fq : 256 * pn + 128 * bj + 32 * wc + 8 * fq;
#pragma unroll
            for (int n = 0; n < 2; ++n) gv[bj][n] = mode == 3 ? *(const f32x4*)(vgain + (colb[bj] - 1280) + 4 * n) : (f32x4){1.f, 1.f, 1.f, 1.f};
        }
        ss_t sv[2][4];
#pragma unroll
        for (int ai = 0; ai < 2; ++ai)
#pragma unroll
            for (int m = 0; m < 4; ++m) sv[ai][m] = ss[row0 + ai * HALF + m * 16];
#pragma unroll
        for (int ai = 0; ai < 2; ++ai)
#pragma unroll
            for (int m = 0; m < 4; ++m) {
                const int row = row0 + ai * HALF + m * 16; const float rs = rs_of(sv[ai][m]);
                f32x4 v[2][2];
#pragma unroll
                for (int bj = 0; bj < 2; ++bj)
#pragma unroll
                    for (int n = 0; n < 2; ++n) v[bj][n] = acc[ai][bj][m][n] * rs;
                if (mode == 0) {
#pragma unroll
                    for (int bj = 0; bj < 2; ++bj)
#pragma unroll
                        for (int n = 0; n < 2; ++n) v[bj][n] = v[bj][n] * (0.125f * K_LOG2E);
                } else if (mode >= 2) {
#pragma unroll
                    for (int bj = 0; bj < 2; ++bj)
#pragma unroll
                        for (int n = 0; n < 2; ++n)
#pragma unroll
                            for (int e = 0; e < 4; ++e) v[bj][n][e] = gelu_tanh_f(v[bj][n][e]);
                    if (mode == 3) {
                        float q = 0.f;
#pragma unroll
                        for (int bj = 0; bj < 2; ++bj)
#pragma unroll
                            for (int n = 0; n < 2; ++n) q += (v[bj][n][0] * v[bj][n][0] + v[bj][n][1] * v[bj][n][1]) + (v[bj][n][2] * v[bj][n][2] + v[bj][n][3] * v[bj][n][3]);
                        q += __shfl_xor(q, 16); q += __shfl_xor(q, 32);
                        const float r2 = __builtin_amdgcn_rsqf(q * (1.0f / 64.0f) + RMS_EPS);
#pragma unroll
                        for (int bj = 0; bj < 2; ++bj)
#pragma unroll
                            for (int n = 0; n < 2; ++n) v[bj][n] = v[bj][n] * r2 * gv[bj][n];
                    }
                }
#pragma unroll
                for (int bj = 0; bj < 2; ++bj) {
                    u32x4 w; w.x = cvt_pk_bf16(v[bj][0][0], v[bj][0][1]); w.y = cvt_pk_bf16(v[bj][0][2], v[bj][0][3]); w.z = cvt_pk_bf16(v[bj][1][0], v[bj][1][1]); w.w = cvt_pk_bf16(v[bj][1][2], v[bj][1][3]);
                    *(u32x4*)(Z + (size_t)row * 1792 + colb[bj]) = w;
                }
                asm volatile("" ::: "memory");
            }
    }
};

template <class Epi, class Sched, bool ALIGN_EPI = false, bool SP2 = false>
__device__ __forceinline__ void gemm_phase(PG8_LAS unsigned char* lds, const Gemm g, const Sched& S, const Epi& E) {
    const int tid = opaque_v((int)threadIdx.x), wid = __builtin_amdgcn_readfirstlane(tid >> 6), lane = tid & 63, wr = wid >> 2, wc = wid & 3, fr = lane & 15, fq = lane >> 4;
    const int K = g.K, nt = K / BK;
    unsigned voffA[2], voffB[2];
#pragma unroll
    for (int i = 0; i < 2; ++i) { int R, C; stage_rc(tid * 16 + i * 8192, R, C); const int Rb = Epi::PERM ? ((R & ~31) + perm32(R & 31)) : R;
        voffA[i] = (unsigned)(R * K + C) * 2u; voffB[i] = (unsigned)(Rb * K + C) * 2u; }
    const size_t kstep = (size_t)(BK * 2);
    const size_t hstep = (size_t)HALF * K * 2;
    const size_t tstep = 2 * hstep;
    const unsigned ldsw = (unsigned)wid * 1024u;
    const int aoff = lds_byte(wr * 64 + fr, fq * 8), boff = lds_byte(wc * 32 + fr, fq * 8);
#define PG8_SA(b, h) (((b) * 2 + (h)) * HTB)
#define PG8_SB(b, h) ((4 + (b) * 2 + (h)) * HTB)
#define PG8_STAGE(bufoff, gbase, voff) do { _Pragma("unroll") for (int _i = 0; _i < 2; ++_i) \
        __builtin_amdgcn_global_load_lds((const unsigned*)((const char*)(gbase) + (voff)[_i]), (PG8_LAS unsigned*)(lds + (bufoff) + ldsw + _i * 8192), 16, 0, 0); } while (0)
#define PG8_LDA(dst, b, h) do { _Pragma("unroll") for (int m = 0; m < 4; ++m) _Pragma("unroll") for (int k = 0; k < 2; ++k) dst[m][k] = *(const PG8_LAS bf16x8*)(lds + PG8_SA(b, h) + aoff + m * 2048 + k * 1024); } while (0)
#define PG8_LDB(dst, b, h) do { _Pragma("unroll") for (int n = 0; n < 2; ++n) _Pragma("unroll") for (int k = 0; k < 2; ++k) dst[n][k] = *(const PG8_LAS bf16x8*)(lds + PG8_SB(b, h) + boff + n * 2048 + k * 1024); } while (0)
#define PG8_MMA(ai, bj, At, Bt) do { __builtin_amdgcn_s_setprio(1); _Pragma("unroll") for (int m = 0; m < 4; ++m) _Pragma("unroll") for (int n = 0; n < 2; ++n) _Pragma("unroll") for (int k = 0; k < 2; ++k) \
        acc[ai][bj][m][n] = __builtin_amdgcn_mfma_f32_16x16x32_bf16(Bt[n][k], At[m][k], acc[ai][bj][m][n], 0, 0, 0); __builtin_amdgcn_s_setprio(0); } while (0)
#define PG8_WAIT_V(n) asm volatile("s_waitcnt vmcnt(" #n ")" ::: "memory")
#define PG8_WAIT_L(n) asm volatile("s_waitcnt lgkmcnt(" #n ")" ::: "memory")
#define PG8_BAR __builtin_amdgcn_s_barrier()
#define PG8_SCHED __builtin_amdgcn_sched_barrier(0)
    Unit cur, nxt; int ui = 0;
    if (!S.next(0, cur)) return;
    f32x4 acc[2][2][4][2];
#pragma unroll
    for (int a = 0; a < 2; ++a)
#pragma unroll
        for (int b = 0; b < 2; ++b)
#pragma unroll
            for (int m = 0; m < 4; ++m)
#pragma unroll
                for (int n = 0; n < 2; ++n) acc[a][b][m][n] = (f32x4){0.f, 0.f, 0.f, 0.f};
    bf16x8 At[4][2], B0[2][2], B1[2][2];
    const char* cA = (const char*)g.A + (size_t)cur.pm * tstep; const char* cB = (const char*)g.Bt + (size_t)cur.pn * tstep;
    S.a_ready(cur);
    if constexpr (SP2) {
        PG8_STAGE(PG8_SB(0, 0), cB, voffB); PG8_STAGE(PG8_SB(0, 1), cB + hstep, voffB); PG8_STAGE(PG8_SA(0, 0), cA, voffA); PG8_STAGE(PG8_SA(0, 1), cA + hstep, voffA);
        if (wr == 1) PG8_BAR;
        PG8_WAIT_V(2); PG8_BAR;
        PG8_STAGE(PG8_SB(1, 0), cB + kstep, voffB); PG8_STAGE(PG8_SA(1, 0), cA + kstep, voffA); PG8_STAGE(PG8_SB(1, 1), cB + hstep + kstep, voffB);
        PG8_WAIT_V(6); PG8_BAR;
    } else {
        PG8_STAGE(PG8_SB(0, 0), cB, voffB); PG8_STAGE(PG8_SA(0, 0), cA, voffA); PG8_STAGE(PG8_SB(0, 1), cB + hstep, voffB); PG8_STAGE(PG8_SA(0, 1), cA + hstep, voffA);
        if (wr == 1) PG8_BAR;
        PG8_WAIT_V(4); PG8_BAR;
        PG8_STAGE(PG8_SB(1, 0), cB + kstep, voffB); PG8_STAGE(PG8_SA(1, 0), cA + kstep, voffA); PG8_STAGE(PG8_SB(1, 1), cB + hstep + kstep, voffB);
        PG8_WAIT_V(6); PG8_BAR;
    }
    for (;;) {
        const bool has_next = S.next(ui + 1, nxt);
        const char* nA = has_next ? (const char*)g.A + (size_t)nxt.pm * tstep : cA; const char* nB = has_next ? (const char*)g.Bt + (size_t)nxt.pn * tstep : cB;
        for (int t = 0; t < nt; t += 2) {
            const bool last = (t == nt - 2);
            const char* a1 = cA + (size_t)(t + 1) * kstep;
            const char* a2 = last ? nA : cA + (size_t)(t + 2) * kstep; const char* b2 = last ? nB : cB + (size_t)(t + 2) * kstep;
            const char* a3 = a2 + kstep; const char* b3 = b2 + kstep;
            if (last && has_next) S.a_ready(nxt);
            if constexpr (SP2) {
            PG8_LDB(B0, 0, 0); PG8_LDB(B1, 0, 1); PG8_SCHED; PG8_LDA(At, 0, 0); PG8_STAGE(PG8_SA(1, 1), a1 + hstep, voffA);
            PG8_WAIT_V(8); PG8_WAIT_L(0); PG8_BAR; PG8_MMA(0, 0, At, B0); PG8_MMA(0, 1, At, B1); PG8_BAR; PG8_SCHED;
            PG8_LDA(At, 0, 1); PG8_STAGE(PG8_SB(0, 0), b2, voffB); PG8_STAGE(PG8_SB(0, 1), b2 + hstep, voffB); PG8_STAGE(PG8_SA(0, 0), a2, voffA);
            PG8_WAIT_V(8); PG8_WAIT_L(0); PG8_BAR; PG8_MMA(1, 0, At, B0); PG8_MMA(1, 1, At, B1); PG8_BAR; PG8_SCHED;
            PG8_LDB(B0, 1, 0); PG8_LDB(B1, 1, 1); PG8_SCHED; PG8_LDA(At, 1, 0); PG8_STAGE(PG8_SA(0, 1), a2 + hstep, voffA);
            PG8_WAIT_V(8); PG8_WAIT_L(0); PG8_BAR; PG8_MMA(0, 0, At, B0); PG8_MMA(0, 1, At, B1); PG8_BAR; PG8_SCHED;
            PG8_LDA(At, 1, 1); PG8_STAGE(PG8_SB(1, 0), b3, voffB); PG8_STAGE(PG8_SB(1, 1), b3 + hstep, voffB); PG8_STAGE(PG8_SA(1, 0), a3, voffA);
            PG8_WAIT_V(8); PG8_WAIT_L(0); PG8_BAR; PG8_MMA(1, 0, At, B0); PG8_MMA(1, 1, At, B1); PG8_BAR; PG8_SCHED;
            } else {
            PG8_LDB(B0, 0, 0); PG8_SCHED; PG8_LDA(At, 0, 0); PG8_STAGE(PG8_SA(1, 1), a1 + hstep, voffA);
            PG8_WAIT_L(8); PG8_BAR; PG8_WAIT_L(0); PG8_MMA(0, 0, At, B0); PG8_BAR; PG8_SCHED;
            PG8_LDB(B1, 0, 1); PG8_STAGE(PG8_SB(0, 0), b2, voffB);
            PG8_BAR; PG8_WAIT_L(0); PG8_MMA(0, 1, At, B1); PG8_BAR;
            PG8_LDA(At, 0, 1); PG8_STAGE(PG8_SA(0, 0), a2, voffA);
            PG8_BAR; PG8_WAIT_L(0); PG8_MMA(1, 0, At, B0); PG8_BAR; PG8_SCHED;
            PG8_STAGE(PG8_SB(0, 1), b2 + hstep, voffB);
            PG8_WAIT_V(6); PG8_BAR; PG8_MMA(1, 1, At, B1); PG8_BAR;
            PG8_LDB(B0, 1, 0); PG8_SCHED; PG8_LDA(At, 1, 0); PG8_STAGE(PG8_SA(0, 1), a2 + hstep, voffA);
            PG8_WAIT_L(8); PG8_BAR; PG8_WAIT_L(0); PG8_MMA(0, 0, At, B0); PG8_BAR; PG8_SCHED;
            PG8_LDB(B1, 1, 1); PG8_STAGE(PG8_SB(1, 0), b3, voffB);
            PG8_BAR; PG8_WAIT_L(0); PG8_MMA(0, 1, At, B1); PG8_BAR;
            PG8_LDA(At, 1, 1); PG8_STAGE(PG8_SA(1, 0), a3, voffA);
            PG8_BAR; PG8_WAIT_L(0); PG8_MMA(1, 0, At, B0); PG8_BAR; PG8_SCHED;
            PG8_STAGE(PG8_SB(1, 1), b3 + hstep, voffB);
            PG8_WAIT_V(6); PG8_BAR; PG8_MMA(1, 1, At, B1); PG8_BAR;
            }
        }
        if constexpr (ALIGN_EPI) { if (wr == 0) PG8_BAR; }
        if constexpr (!Epi::AFTER_DRAIN) { E(acc, cur, wr, wc, fr, fq); S.done(cur); }
        if (!has_next) break;
#pragma unroll
        for (int a = 0; a < 2; ++a)
#pragma unroll
            for (int b = 0; b < 2; ++b)
#pragma unroll
                for (int m = 0; m < 4; ++m)
#pragma unroll
                    for (int n = 0; n < 2; ++n) acc[a][b][m][n] = (f32x4){0.f, 0.f, 0.f, 0.f};
        cur = nxt; cA = nA; cB = nB; ++ui;
        if constexpr (ALIGN_EPI) { if (wr == 1) PG8_BAR; }
    }
    PG8_WAIT_V(0);
    if constexpr (!ALIGN_EPI) { if (wr == 0) PG8_BAR; }
    PG8_BAR;
    if constexpr (Epi::AFTER_DRAIN) { E.fused(acc, cur, wr, wc, fr, fq, lds, wid, lane); S.done(cur); }
#undef PG8_SA
#undef PG8_SB
#undef PG8_STAGE
#undef PG8_LDA
#undef PG8_LDB
#undef PG8_MMA
#undef PG8_WAIT_V
#undef PG8_WAIT_L
#undef PG8_BAR
#undef PG8_SCHED
}
}

#ifndef PH_MASK
#define PH_MASK 127
#endif
#ifndef N_LAYER
#define N_LAYER 2
#endif
constexpr int NWAVES = 8;
#ifndef L1_CUT
#define L1_CUT 7168
#endif
constexpr int TOK = 32768, TOKP = 16384, DM = 1024, FF = 2816, NIN = 1792, NLAYER = N_LAYER, NBLK = TOK / 128;
constexpr size_t WS_SS = 0;
constexpr size_t WS_W = 2u << 20;
constexpr size_t W_GU1 = 0, W_D1 = W_GU1 + (size_t)2 * FF * DM * 2, W_IN = W_D1 + (size_t)DM * FF * 2, W_OUT = W_IN + (size_t)NIN * DM * 2,
                 W_GU2 = W_OUT + (size_t)DM * DM * 2, W_D2 = W_GU2 + (size_t)2 * FF * DM * 2, W_BYTES = W_D2 + (size_t)DM * FF * 2;
constexpr size_t WS_XB = WS_W + W_BYTES;
constexpr size_t WS_R1 = WS_XB + (size_t)TOK * DM * 2;
constexpr size_t WS_Z = WS_R1, WS_MIX = WS_R1 + (size_t)TOK * NIN * 2, WS_H = WS_R1;
constexpr size_t WS_WSB = WS_R1 + (size_t)TOK * FF * 2;
constexpr size_t WS_TAB = WS_WSB + (size_t)NLAYER * 8 * 128 * 128 * 2;
constexpr size_t WS_END = WS_TAB + (size_t)8 * 4 * 388 * 4;
static_assert(WS_MIX + (size_t)TOK * DM * 2 == WS_WSB && WS_XB % 256 == 0 && WS_R1 % 256 == 0, "d_ws map");
constexpr int LDSCTL_OFF = 147456 - 256;
constexpr size_t WS_BAR = 0x1D0000, WS_BAR_BYTES = 16384;
constexpr int LDS_BYTES = 147456;

#define LAS __attribute__((address_space(3)))
typedef unsigned short bf16;
typedef unsigned v4u __attribute__((ext_vector_type(4)));
typedef unsigned v2u __attribute__((ext_vector_type(2)));
typedef float f32x4 __attribute__((ext_vector_type(4)));
typedef short bf16x8 __attribute__((ext_vector_type(8)));
typedef short s16x4 __attribute__((ext_vector_type(4)));
typedef short v4i16_t __attribute__((ext_vector_type(4)));
#define LDS_WAIT() asm volatile("s_waitcnt lgkmcnt(0)" ::: "memory")
typedef float f32x2_t __attribute__((ext_vector_type(2)));
typedef __bf16 bf16x2_t __attribute__((ext_vector_type(2)));
__device__ __forceinline__ unsigned pk2(float lo, float hi) { f32x2_t v = {lo, hi}; bf16x2_t b = __builtin_convertvector(v, bf16x2_t); return __builtin_bit_cast(unsigned, b); }
__device__ __forceinline__ float bf_lo(unsigned w) { return __builtin_bit_cast(float, w << 16); }
__device__ __forceinline__ float bf_hi(unsigned w) { return __builtin_bit_cast(float, w & 0xffff0000u); }
__device__ __forceinline__ s16x4 vtr(const LAS unsigned char* p) { return __builtin_bit_cast(s16x4, __builtin_amdgcn_ds_read_tr16_b64_v4i16((LAS v4i16_t*)p)); }
__device__ __forceinline__ int opaque(int v) { asm volatile("" : "+s"(v)); return v; }
__device__ __forceinline__ float wave_sum(float v) {
#pragma unroll
    for (int o = 1; o < 64; o <<= 1) v += __shfl_xor(v, o);
    return v;
}

#define XB_TMO      128
#define XB_XCNT(j)  (256  + 64 * (j))
#define XB_XSUB(j)  (1280 + 64 * (j))
#define XB_XGEN(j)  (2304 + 64 * (j))
#define XB_TOP      3328
#define XB_TOPGEN   3392
#define XCD_BAR_WORDS 3456
#define XB_SPIN_CAP (1u << 18)

__device__ __forceinline__ unsigned xb_ld(unsigned* p)              { return __hip_atomic_load(p, __ATOMIC_RELAXED, __HIP_MEMORY_SCOPE_AGENT); }
__device__ __forceinline__ unsigned xb_add(unsigned* p, unsigned v) { return __hip_atomic_fetch_add(p, v, __ATOMIC_RELAXED, __HIP_MEMORY_SCOPE_AGENT); }
__device__ __forceinline__ unsigned xb_xcc_id() { return (unsigned)__builtin_amdgcn_s_getreg((3 << 11) | 20) & 0xFu; }
#define XB_SPIN(cond, bar) do { unsigned _sp = 0; while (cond) { __builtin_amdgcn_s_sleep(1); \
    if ((++_sp & 255u) == 0u) { if (xb_ld(&(bar)[XB_TMO])) break; if (_sp > XB_SPIN_CAP) { atomicAdd(&(bar)[XB_TMO], 1u); break; } } } } while (0)

struct XcdBarrier {
    unsigned* bar; unsigned x;
    volatile LAS unsigned* st;
};

__device__ __forceinline__ XcdBarrier xcd_barrier_post(unsigned* bar, volatile LAS unsigned* st) {
    XcdBarrier b; b.bar = bar; b.x = xb_xcc_id(); b.st = st;
    if (threadIdx.x == 0) (void)xb_add(&bar[XB_XCNT(b.x)], 1u);
    return b;
}
__device__ __forceinline__ void xcd_barrier_complete(unsigned* bar, unsigned x, unsigned& nloc, unsigned& nx) {
    const unsigned G = gridDim.x * gridDim.y * gridDim.z;
    unsigned sum, cnt, mine, sp = 0u;
    for (;;) {
        sum = 0u; cnt = 0u; mine = 0u;
#pragma unroll
        for (unsigned j = 0; j < 16; ++j) { const unsigned c = xb_ld(&bar[XB_XCNT(j)]); sum += c; cnt += (c > 0u) ? 1u : 0u; mine = (j == x) ? c : mine; }
        if (sum == G) break;
        __builtin_amdgcn_s_sleep(1);
        if ((++sp & 255u) == 0u) { if (xb_ld(&bar[XB_TMO])) break; if (sp > XB_SPIN_CAP) { atomicAdd(&bar[XB_TMO], 1u); break; } }
    }
    nloc = mine > 0u ? mine : 1u; nx = cnt > 0u ? cnt : 1u;
}

__device__ __forceinline__ void xcd_barrier(const XcdBarrier& b) {
    asm volatile("s_waitcnt vmcnt(0)" ::: "memory");
    __syncthreads();
    if (threadIdx.x == 0) {
        unsigned* bar = b.bar;
        __builtin_amdgcn_s_waitcnt(0);
        unsigned nloc = b.st[0], nx = b.st[1];
        if (nloc == 0u) { xcd_barrier_complete(bar, b.x, nloc, nx); b.st[0] = nloc; b.st[1] = nx; }
        const unsigned old = xb_add(&bar[XB_XSUB(b.x)], 1u);
        const unsigned gen = old / nloc;
        if (old + 1u == (gen + 1u) * nloc) {
            __builtin_amdgcn_fence(__ATOMIC_RELEASE, "agent");
            asm volatile("s_waitcnt vmcnt(0)" ::: "memory");
            const unsigned og = xb_add(&bar[XB_TOP], 1u);
            const unsigned tg = og / nx;
            if (og + 1u == (tg + 1u) * nx) xb_add(&bar[XB_TOPGEN], 1u);
            else XB_SPIN(xb_ld(&bar[XB_TOPGEN]) == tg, bar);
            __builtin_amdgcn_fence(__ATOMIC_ACQUIRE, "agent");
            xb_add(&bar[XB_XGEN(b.x)], 1u);
            asm volatile("s_waitcnt vmcnt(0)" ::: "memory");
        } else {
            XB_SPIN(xb_ld(&bar[XB_XGEN(b.x)]) == gen, bar);
            __builtin_amdgcn_fence(__ATOMIC_ACQUIRE, "agent");
            asm volatile("s_waitcnt vmcnt(0)" ::: "memory");
        }
    }
    __syncthreads();
}

struct Args {
    const float *x_prompt, *x_sample, *norm_ffn1, *w1_gate, *w1_up, *w1_down, *norm_mix, *w_in, *sink, *vgain, *w_sp, *b_sp, *w_out, *norm_ffn2, *w2_gate, *w2_up, *w2_down, *norm_final;
    float* out; unsigned char* ws;
};

typedef const __attribute__((address_space(4))) Args* KArgs;
__device__ __forceinline__ KArgs kargs() { const __attribute__((address_space(4))) void* p = (const __attribute__((address_space(4))) void*)__builtin_amdgcn_kernarg_segment_ptr(); asm volatile("" : "+s"(p)); return (KArgs)p; }
__device__ __forceinline__ void conv_item(const float* W, int ldn, int K, const float* gain, bf16* WT, int dst_row0, int src_col0, int k0, LAS float* scr, int lane) {
    f32x4 v[8]; float g[8];
#pragma unroll
    for (int i = 0; i < 8; ++i) { const int kk = 8 * i + (lane >> 3); v[i] = *(const f32x4*)(W + (size_t)(k0 + kk) * ldn + src_col0 + 4 * (lane & 7)); g[i] = gain ? gain[k0 + kk] : 1.0f; }
#pragma unroll
    for (int i = 0; i < 8; ++i) { const int kk = 8 * i + (lane >> 3); LAS float* s = scr + kk * 33 + 4 * (lane & 7); s[0] = v[i][0] * g[i]; s[1] = v[i][1] * g[i]; s[2] = v[i][2] * g[i]; s[3] = v[i][3] * g[i]; }
    LDS_WAIT(); asm volatile("" ::: "memory");
    const int c = lane & 7;
#pragma unroll
    for (int j = 0; j < 4; ++j) { const int n = (lane >> 3) + 8 * j; const LAS float* s = scr + (8 * c) * 33 + n;
        v4u o; o.x = pk2(s[0 * 33], s[1 * 33]); o.y = pk2(s[2 * 33], s[3 * 33]); o.z = pk2(s[4 * 33], s[5 * 33]); o.w = pk2(s[6 * 33], s[7 * 33]);
        *(v4u*)(WT + (size_t)(dst_row0 + n) * K + k0 + 8 * c) = o; }
    LDS_WAIT(); asm volatile("" ::: "memory");
}
__device__ __forceinline__ void convert_layer(KArgs a, int l, LAS unsigned char* lds, int gw, int NGW, int wave, int lane, int it_lo, int it_hi) {
    LAS float* scr = (LAS float*)(lds + wave * 16384);
    bf16* Wb = l == 0 ? (bf16*)(a->ws + WS_W) : (bf16*)a->out;
    constexpr int I_GU = (2 * FF / 32) * (DM / 64), I_D = (DM / 32) * (FF / 64), I_IN = (NIN / 32) * (DM / 64), I_OUT = (DM / 32) * (DM / 64);
    constexpr int NITEMS = 2 * I_GU + 2 * I_D + I_IN + I_OUT;
    const int it_end = it_hi < NITEMS ? it_hi : NITEMS;
    for (int it = it_lo + gw; it < it_end; it += NGW) {
        int r = it; const float* src; const float* gain = nullptr; int ldn, K, nblk; size_t dsto; int kind;
        const float *gsrc = nullptr, *usrc = nullptr;
        if (r < I_GU) { kind = 1; gsrc = a->w1_gate + (size_t)l * DM * FF; usrc = a->w1_up + (size_t)l * DM * FF; gain = a->norm_ffn1 + l * DM; ldn = FF; K = DM; nblk = 2 * FF / 32; dsto = W_GU1; }
        else if ((r -= I_GU) < I_D) { kind = 0; gsrc = a->w1_down + (size_t)l * DM * FF; ldn = DM; K = FF; nblk = DM / 32; dsto = W_D1; }
        else if ((r -= I_D) < I_IN) { kind = 2; gsrc = a->w_in + (size_t)l * DM * NIN; gain = a->norm_mix + l * DM; ldn = NIN; K = DM; nblk = NIN / 32; dsto = W_IN; }
        else if ((r -= I_IN) < I_OUT) { kind = 0; gsrc = a->w_out + (size_t)l * DM * DM; ldn = DM; K = DM; nblk = DM / 32; dsto = W_OUT; }
        else if ((r -= I_OUT) < I_GU) { kind = 1; gsrc = a->w2_gate + (size_t)l * DM * FF; usrc = a->w2_up + (size_t)l * DM * FF; gain = a->norm_ffn2 + l * DM; ldn = FF; K = DM; nblk = 2 * FF / 32; dsto = W_GU2; }
        else { r -= I_GU; kind = 0; gsrc = a->w2_down + (size_t)l * DM * FF; ldn = DM; K = FF; nblk = DM / 32; dsto = W_D2; }
        const int kb = r / nblk, nb = r % nblk; int sc0 = 32 * nb; src = gsrc;
        if (kind == 1) { const int pn = nb >> 3, lb = nb & 7; src = lb < 4 ? gsrc : usrc; sc0 = 128 * pn + 32 * (lb & 3); }
        else if (kind == 2 && nb >= 40) { const int t = nb - 40, pnl = t >> 3, lb = t & 7, bj = lb >> 2, wc = lb & 3; sc0 = 1280 + 64 * (4 * pnl + wc) + 32 * bj; }
        conv_item(src, ldn, K, gain, (bf16*)((unsigned char*)Wb + dsto), 32 * nb, sc0, 64 * kb, scr, lane);
    }
}

constexpr int KS_STRIDE = 144;
constexpr int KS_BYTES = 384 * KS_STRIDE;
constexpr int TAB_OFF = 2 * KS_BYTES, TAB_N = 388, TAB_ZERO = 196;
static_assert(TAB_OFF + 4 * 4 * TAB_N * 4 <= LDSCTL_OFF, "LDS map");
constexpr float DEFER_THR = 10.0f;
constexpr int GS_STRIDE = 1040;
static_assert(128 * GS_STRIDE <= LDSCTL_OFF, "LDS map");
__device__ __forceinline__ void mixer_phase(KArgs a, int l, LAS unsigned char* lds, int G, int bid, int tid, int wave, int lane) {
    const bf16* Z = (const bf16*)(a->ws + WS_Z); bf16* MIX = (bf16*)(a->ws + WS_MIX);
    const int fr = lane & 15, fq = lane >> 4, tq = fr >> 2, tp = fr & 3;
    LAS unsigned char* Ks = lds; LAS unsigned char* Vs = lds + KS_BYTES; LAS unsigned char* Gs = lds;
#pragma unroll 1
    for (int blk = bid; blk < NBLK; blk += G) {
        const int sb = blk < 128 ? (blk & ~63) : (blk & ~15), se = sb + (blk < 128 ? 64 : 16);
        const bool has_prev = blk > sb, has_next = blk + 1 < se;
#ifndef MIX_NO_ATT
#ifndef REP_ATT
#define REP_ATT 1
#endif
#pragma unroll 1
        for (int kvh2 = 0; kvh2 < 2 * REP_ATT; ++kvh2) { const int kvh = kvh2 & 1;
            const int hq = kvh * 4 + (wave >> 1), half = wave & 1;
            const float sinkl = a->sink[l * 8 + hq] * pg8::K_LOG2E;
            bf16x8 qf[4][2];
#pragma unroll
            for (int qg = 0; qg < 4; ++qg)
#pragma unroll
                for (int dk = 0; dk < 2; ++dk) qf[qg][dk] = *(const bf16x8*)(Z + (size_t)(128 * blk + 64 * half + 16 * qg + fr) * NIN + hq * 64 + 32 * dk + 8 * fq);
            v4u kvr[6], vvr[6], ttr[4];
#pragma unroll
            for (int i = 0; i < 6; ++i) {
                const int id = tid + 512 * i, kj = id >> 3, c = id & 7, kb = kj >> 7;
                const bool ok = kb == 1 || (kb == 0 ? has_prev : has_next);
                kvr[i] = (v4u){0u, 0u, 0u, 0u}; vvr[i] = (v4u){0u, 0u, 0u, 0u};
                if (ok) { const bf16* zr = Z + (size_t)(128 * (blk - 1) + kj) * NIN + 64 * kvh + 8 * c; kvr[i] = *(const v4u*)(zr + 512); vvr[i] = *(const v4u*)(zr + 640); }
            }
            {
                const v4u* tsrc = (const v4u*)(a->ws + WS_TAB) + kvh * (4 * TAB_N);
#pragma unroll
                for (int i = 0; i < 4; ++i) ttr[i] = tid < TAB_N ? tsrc[4 * tid + i] : (v4u){0u, 0u, 0u, 0u};
            }
            __syncthreads();
#pragma unroll
            for (int i = 0; i < 6; ++i) { const int id = tid + 512 * i, kj = id >> 3, c = id & 7;
                *(LAS v4u*)(Ks + kj * KS_STRIDE + c * 16) = kvr[i]; *(LAS v4u*)(Vs + kj * KS_STRIDE + c * 16) = vvr[i]; }
            if (tid < TAB_N) {
#pragma unroll
                for (int i = 0; i < 4; ++i) *(LAS v4u*)(lds + TAB_OFF + 64 * tid + 16 * i) = ttr[i];
            }
            __syncthreads();
            {
                f32x4 o[4][4];
#pragma unroll
                for (int db = 0; db < 4; ++db)
#pragma unroll
                    for (int qg = 0; qg < 4; ++qg) o[db][qg] = (f32x4){0.f, 0.f, 0.f, 0.f};
                float mrow[4], lsum[4];
#pragma unroll
                for (int qg = 0; qg < 4; ++qg) { mrow[qg] = sinkl; lsum[qg] = 0.f; }
                const int dl0 = 4 * fq - fr, kcp = dl0 & 3;
                const LAS unsigned char* tbl = lds + TAB_OFF + ((wave >> 1) * 4 + kcp) * (TAB_N * 4) + 4 * (dl0 - kcp + TAB_ZERO - 128 - 48);
#pragma unroll 2
                for (int kt = 0; kt < 10; ++kt) {
                    const int key0 = 64 * half + 32 * kt, tb = key0 >> 7;
                    if ((tb == 0 && !has_prev) || (tb == 2 && !has_next)) continue;
                    f32x4 s[2][4];
#pragma unroll
                    for (int kb = 0; kb < 2; ++kb)
#pragma unroll
                        for (int qg = 0; qg < 4; ++qg) s[kb][qg] = (f32x4){0.f, 0.f, 0.f, 0.f};
#pragma unroll
                    for (int kb = 0; kb < 2; ++kb)
#pragma unroll
                        for (int dk = 0; dk < 2; ++dk) {
                            const bf16x8 kf = *(const LAS bf16x8*)(Ks + (key0 + 16 * kb + fr) * KS_STRIDE + 64 * dk + 16 * fq);
#pragma unroll
                            for (int qg = 0; qg < 4; ++qg) s[kb][qg] = __builtin_amdgcn_mfma_f32_16x16x32_bf16(kf, qf[qg][dk], s[kb][qg], 0, 0, 0);
                        }
                    bf16x8 pb[4];
                    const LAS unsigned char* tbp = tbl + 128 * kt;
                    bool need = false;
#pragma unroll
                    for (int qg = 0; qg < 4; ++qg) {
#pragma unroll
                        for (int kb = 0; kb < 2; ++kb) s[kb][qg] = s[kb][qg] + *(const LAS f32x4*)(tbp + 64 * (kb - qg + 3));
                        const float lm = fmaxf(fmaxf(fmaxf(s[0][qg][0], s[0][qg][1]), fmaxf(s[0][qg][2], s[0][qg][3])), fmaxf(fmaxf(s[1][qg][0], s[1][qg][1]), fmaxf(s[1][qg][2], s[1][qg][3])));
                        need |= lm > mrow[qg] + DEFER_THR;
                    }
                    if (__builtin_amdgcn_readfirstlane(__any(need))) {
#pragma unroll
                        for (int qg = 0; qg < 4; ++qg) {
                            float mx = fmaxf(fmaxf(fmaxf(s[0][qg][0], s[0][qg][1]), fmaxf(s[0][qg][2], s[0][qg][3])), fmaxf(fmaxf(s[1][qg][0], s[1][qg][1]), fmaxf(s[1][qg][2], s[1][qg][3])));
                            mx = fmaxf(mx, mrow[qg]);
                            mx = fmaxf(mx, __shfl_xor(mx, 16)); mx = fmaxf(mx, __shfl_xor(mx, 32));
                            const float alpha = __builtin_amdgcn_exp2f(mrow[qg] - mx); mrow[qg] = mx;
                            lsum[qg] = lsum[qg] * alpha;
#pragma unroll
                            for (int db = 0; db < 4; ++db) o[db][qg] = o[db][qg] * alpha;
                        }
                    }
#pragma unroll
                    for (int qg = 0; qg < 4; ++qg) {
                        const float mx = mrow[qg];
                        float ps = 0.f;
#pragma unroll
                        for (int kb = 0; kb < 2; ++kb)
#pragma unroll
                            for (int j = 0; j < 4; ++j) { const float p = __builtin_amdgcn_exp2f(s[kb][qg][j] - mx); s[kb][qg][j] = p; ps += p; }
                        lsum[qg] += ps;
                        v4u w; w.x = pk2(s[0][qg][0], s[0][qg][1]); w.y = pk2(s[0][qg][2], s[0][qg][3]); w.z = pk2(s[1][qg][0], s[1][qg][1]); w.w = pk2(s[1][qg][2], s[1][qg][3]);
                        pb[qg] = __builtin_bit_cast(bf16x8, w);
                    }
#pragma unroll
                    for (int db = 0; db < 4; ++db) {
                        const LAS unsigned char* vp = Vs + (key0 + 4 * fq + tq) * KS_STRIDE + (16 * db + 4 * tp) * 2;
                        const s16x4 lo = vtr(vp), hi = vtr(vp + 16 * KS_STRIDE);
                        const bf16x8 vf = (bf16x8){lo[0], lo[1], lo[2], lo[3], hi[0], hi[1], hi[2], hi[3]};
#pragma unroll
                        for (int qg = 0; qg < 4; ++qg) o[db][qg] = __builtin_amdgcn_mfma_f32_16x16x32_bf16(vf, pb[qg], o[db][qg], 0, 0, 0);
                    }
                }
#pragma unroll
                for (int qg = 0; qg < 4; ++qg) {
                    float lt = lsum[qg]; lt += __shfl_xor(lt, 16); lt += __shfl_xor(lt, 32); lt += __builtin_amdgcn_exp2f(sinkl - mrow[qg]);
                    const float inv = 1.0f / lt;
                    bf16* op = MIX + (size_t)(128 * blk + 64 * half + 16 * qg + fr) * DM + hq * 64 + 4 * fq;
#pragma unroll
                    for (int db = 0; db < 4; ++db) { const f32x4 v = o[db][qg] * inv; v2u w; w.x = pk2(v[0], v[1]); w.y = pk2(v[2], v[3]); *(v2u*)(op + 16 * db) = w; }
                }
            }
        }
#endif
        {
            const int tidg = pg8::opaque_v(tid);
            const int h = wave;
            const v4u* wsb = (const v4u*)(a->ws + WS_WSB) + ((size_t)(l * 8 + h) * 32) * 64 + lane;
            v4u gl[16];
#pragma unroll
            for (int i = 0; i < 16; ++i) { const int id = tidg + 512 * i, srow = id >> 6, c = id & 63; gl[i] = *(const v4u*)(Z + (size_t)(128 * blk + srow) * NIN + 1280 + 8 * c); }
            __syncthreads();
#pragma unroll
            for (int i = 0; i < 16; ++i) { const int id = tidg + 512 * i, srow = id >> 6, c = id & 63; *(LAS v4u*)(Gs + srow * GS_STRIDE + c * 16) = gl[i]; }
#pragma unroll 1
            for (int th = 0; th < 2; ++th) {
                const int tbase = 64 * th;
                v4u wf[4][4]; v2u uu[4][4]; float bias[4];
#pragma unroll
                for (int tb = 0; tb < 4; ++tb) { const size_t row = (size_t)128 * blk + tbase + 16 * tb + fr; bias[tb] = a->b_sp[(l * 8 + h) * 128 + tbase + 16 * tb + fr];
#pragma unroll
                    for (int c = 0; c < 4; ++c) wf[tb][c] = wsb[((4 * th + tb) * 4 + c) * 64];
#pragma unroll
                    for (int db = 0; db < 4; ++db) uu[tb][db] = *(const v2u*)(Z + row * NIN + 768 + 64 * h + 16 * db + 4 * fq); }
                if (th == 0) __syncthreads();
                f32x4 d[4][4];
#pragma unroll
                for (int tb = 0; tb < 4; ++tb)
#pragma unroll
                    for (int db = 0; db < 4; ++db) d[tb][db] = (f32x4){0.f, 0.f, 0.f, 0.f};
#pragma unroll
                for (int c = 0; c < 4; ++c)
#pragma unroll
                    for (int db = 0; db < 4; ++db) {
                        const LAS unsigned char* gp = Gs + (32 * c + 8 * fq + tq) * GS_STRIDE + (64 * h + 16 * db + 4 * tp) * 2;
                        const s16x4 lo = vtr(gp), hi = vtr(gp + 4 * GS_STRIDE);
                        const bf16x8 af = (bf16x8){lo[0], lo[1], lo[2], lo[3], hi[0], hi[1], hi[2], hi[3]};
#pragma unroll
                        for (int tb = 0; tb < 4; ++tb) d[tb][db] = __builtin_amdgcn_mfma_f32_16x16x32_bf16(af, __builtin_bit_cast(bf16x8, wf[tb][c]), d[tb][db], 0, 0, 0);
                    }
#pragma unroll
                for (int tb = 0; tb < 4; ++tb) { const size_t row = (size_t)128 * blk + tbase + 16 * tb + fr;
#pragma unroll
                    for (int db = 0; db < 4; ++db) {
                        const int d0 = 64 * h + 16 * db + 4 * fq; const v2u u2 = uu[tb][db]; const f32x4 dv = d[tb][db]; const float bs = bias[tb];
                        v2u w; w.x = pk2(bf_lo(u2.x) * (dv[0] + bs), bf_hi(u2.x) * (dv[1] + bs)); w.y = pk2(bf_lo(u2.y) * (dv[2] + bs), bf_hi(u2.y) * (dv[3] + bs));
                        *(v2u*)(MIX + row * DM + 512 + d0) = w;
                    } }
            }
        }
    }
    __syncthreads();
}

#define GRID_SYNC1() do { XcdBarrier b_ = bar; b_.x = (unsigned)opaque((int)bar.x); xcd_barrier(b_); } while (0)
#ifdef DUP_SYNC
#define GRID_SYNC() do { GRID_SYNC1(); GRID_SYNC1(); } while (0)
#else
#define GRID_SYNC() GRID_SYNC1()
#endif
__global__ void __launch_bounds__(NWAVES * 64, 2) fwd_megakernel(Args a) {
    extern __shared__ __attribute__((aligned(16))) unsigned char lds_raw[];
    LAS unsigned char* lds = (LAS unsigned char*)lds_raw;
    cg::grid_group grid = cg::this_grid();
    const int tid = threadIdx.x, lane = tid & 63, wave = __builtin_amdgcn_readfirstlane(tid >> 6);
    const int G = gridDim.x, bid = blockIdx.x;
    const int vcu = (G % 8 == 0) ? (bid % 8) * (G / 8) + bid / 8 : bid;
    const int gw = vcu * NWAVES + wave, NGW = G * NWAVES;
    if (tid < 64) ((LAS unsigned*)(lds + LDSCTL_OFF))[tid] = 0u;
    __syncthreads();
    const XcdBarrier bar = xcd_barrier_post((unsigned*)(kargs()->ws + WS_BAR), (volatile LAS unsigned*)(lds + LDSCTL_OFF));
    grid.sync();
#define KA (kargs())
#define X (KA->out)
#define SS ((pg8::ss_t*)(KA->ws + WS_SS))
#define XB ((bf16*)(KA->ws + WS_XB))
#define Wb (l == 0 ? (bf16*)(KA->ws + WS_W) : (bf16*)KA->out)
#define Hb ((bf16*)(KA->ws + WS_H))
#define Zb ((bf16*)(KA->ws + WS_Z))
#define MIXb ((bf16*)(KA->ws + WS_MIX))

    { bf16* xb_ = XB; pg8::ss_t* ss_ = SS; const float* xp_ = KA->x_prompt; const float* xs_ = KA->x_sample;
    for (int r0 = gw; r0 < TOK; r0 += 4 * NGW) {
        f32x4 v[4][4];
#pragma unroll
        for (int q = 0; q < 4; ++q) { const int r = r0 + q * NGW; const float* src = r < TOKP ? xp_ + (size_t)r * DM : xs_ + (size_t)(r - TOKP) * DM;
#pragma unroll
            for (int j = 0; j < 4; ++j) v[q][j] = *(const f32x4*)(src + 256 * j + 4 * lane); }
#pragma unroll
        for (int q = 0; q < 4; ++q) { const int r = r0 + q * NGW; float s = 0.f;
#pragma unroll
            for (int j = 0; j < 4; ++j) { const f32x4 x = v[q][j]; v2u w; w.x = pk2(x[0], x[1]); w.y = pk2(x[2], x[3]); *(v2u*)(xb_ + (size_t)r * DM + 256 * j + 4 * lane) = w;
                s += (x[0] * x[0] + x[1] * x[1]) + (x[2] * x[2] + x[3] * x[3]); }
            s = wave_sum(s);
            if (lane == 0) ss_[r] = pg8::ss_fix(s); }
    }
    for (int i = bid * 512 + tid; i < 6 * TOK; i += G * 512) ss_[TOK + i] = 0ull; }
    {
        float* tab_ = (float*)(KA->ws + WS_TAB);
        for (int e = bid * 512 + tid; e < 8 * 4 * TAB_N; e += G * 512) {
            const int hd = e / (4 * TAB_N), k = (e / TAB_N) & 3, i = e % TAB_N, rel = i + k - TAB_ZERO, ad = rel < 0 ? -rel : rel;
            const float sl = __builtin_amdgcn_exp2f(-(float)(hd + 1)) * pg8::K_LOG2E;
            tab_[e] = ad <= 128 ? -sl * (float)ad : -INFINITY;
        }
    }
    {
        const float* wsp_ = KA->w_sp; v4u* wsb_ = (v4u*)(KA->ws + WS_WSB);
        for (int e = bid * 512 + tid; e < NLAYER * 8 * 32 * 64; e += G * 512) {
            const int ln = e & 63, f = e >> 6, c = f & 3, tb = (f >> 2) & 7, lh = f >> 5;
            const float* wp = wsp_ + ((size_t)lh * 128 + 16 * tb + (ln & 15)) * 128 + 32 * c + 8 * (ln >> 4);
            const f32x4 w0 = *(const f32x4*)wp, w1 = *(const f32x4*)(wp + 4);
            v4u o; o.x = pk2(w0[0], w0[1]); o.y = pk2(w0[2], w0[3]); o.z = pk2(w1[0], w1[1]); o.w = pk2(w1[2], w1[3]);
            wsb_[e] = o;
        }
    }
    const int l1_cut = (G == 256) ? L1_CUT : 0;
    convert_layer(kargs(), 0, lds, gw, NGW, wave, lane, 0, 1 << 30);
    convert_layer(kargs(), 1, lds, gw, NGW, wave, lane, l1_cut, 1 << 30);
    GRID_SYNC();

    for (int l = 0; l < NLAYER; ++l) {
        #define ssA (SS + (size_t)(3 * l) * TOK)
#define ssB (SS + (size_t)(3 * l + 1) * TOK)
#define ssC (SS + (size_t)(3 * l + 2) * TOK)
#define ssD (SS + (size_t)(3 * l + 3) * TOK)
        if (PH_MASK & 1) { pg8::Gemm g{XB, (const bf16*)((unsigned char*)Wb + W_GU1), TOK, 2 * FF, DM}; pg8::StaticOrder S; S.init(TOK, 2 * FF, G, opaque(bid));
          pg8::EpiSwiglu E{Hb, FF, ssA};
#ifdef DUP_PA
          pg8::gemm_phase<pg8::EpiSwiglu, pg8::StaticOrder, true, true>(lds, g, S, E); __syncthreads();
#endif
          pg8::gemm_phase<pg8::EpiSwiglu, pg8::StaticOrder, true, true>(lds, g, S, E); }
        GRID_SYNC();
        if (PH_MASK & 2) { pg8::Gemm g{Hb, (const bf16*)((unsigned char*)Wb + W_D1), TOK, DM, FF}; pg8::ReverseOrder S; S.initr(TOK, DM, G, opaque(bid));
          pg8::EpiResid E{XB, ssB, 0.5f};
#ifdef DUP_PB
          { pg8::EpiResid E0{XB, nullptr, 0.0f}; pg8::gemm_phase<pg8::EpiResid, pg8::ReverseOrder, true, true>(lds, g, S, E0); __syncthreads(); }
#endif
          pg8::gemm_phase<pg8::EpiResid, pg8::ReverseOrder, true, true>(lds, g, S, E); }
        GRID_SYNC();
        if (PH_MASK & 4) { pg8::Gemm g{XB, (const bf16*)((unsigned char*)Wb + W_IN), TOK, NIN, DM}; pg8::StaticOrder S; S.init(TOK, NIN, G, opaque(bid));
          pg8::EpiInProj E{Zb, ssB, KA->vgain + l * 512};
          pg8::gemm_phase<pg8::EpiInProj, pg8::StaticOrder, true, true>(lds, g, S, E); }
        if (l == 0 && G == 256 && bid >= 128) {
          const int t_ = pg8::opaque_v((int)threadIdx.x), w_ = __builtin_amdgcn_readfirstlane(t_ >> 6);
          convert_layer(kargs(), 1, lds, (opaque(bid) - 128) * NWAVES + w_, 128 * NWAVES, w_, t_ & 63, 0, L1_CUT); }
        GRID_SYNC();
#ifdef MIXER_COPY
        if (PH_MASK & 8) { for (size_t i = (size_t)bid * 512 + threadIdx.x; i < (size_t)TOK * 128; i += (size_t)G * 512) { const size_t r = i >> 7, c = i & 127; *(v4u*)(MIXb + r * DM + 8 * c) = *(const v4u*)(Zb + r * NIN + 8 * c); } }
#else
        if (PH_MASK & 8) { const int t_ = pg8::opaque_v((int)threadIdx.x); mixer_phase(kargs(), l, lds, G, opaque(vcu), t_, __builtin_amdgcn_readfirstlane(t_ >> 6), t_ & 63); }
#ifdef DUP_PD
        { const int t_ = pg8::opaque_v((int)threadIdx.x); mixer_phase(kargs(), l, lds, G, opaque(vcu), t_, __builtin_amdgcn_readfirstlane(t_ >> 6), t_ & 63); }
#endif
#endif
        GRID_SYNC();
        if (PH_MASK & 16) { pg8::Gemm g{MIXb, (const bf16*)((unsigned char*)Wb + W_OUT), TOK, DM, DM}; pg8::StaticOrder S; S.init(TOK, DM, G, opaque(bid));
          pg8::EpiResid E{XB, ssC, 1.0f};
#ifdef DUP_PB
          { pg8::EpiResid E0{XB, nullptr, 0.0f}; pg8::gemm_phase<pg8::EpiResid, pg8::StaticOrder, true, true>(lds, g, S, E0); __syncthreads(); }
#endif
          pg8::gemm_phase<pg8::EpiResid, pg8::StaticOrder, true, true>(lds, g, S, E); }
        GRID_SYNC();
        if (PH_MASK & 32) { pg8::Gemm g{XB, (const bf16*)((unsigned char*)Wb + W_GU2), TOK, 2 * FF, DM}; pg8::StaticOrder S; S.init(TOK, 2 * FF, G, opaque(bid));
          pg8::EpiSwiglu E{Hb, FF, ssC};
#ifdef DUP_PA
          pg8::gemm_phase<pg8::EpiSwiglu, pg8::StaticOrder, true, true>(lds, g, S, E); __syncthreads();
#endif
          pg8::gemm_phase<pg8::EpiSwiglu, pg8::StaticOrder, true, true>(lds, g, S, E); }
        GRID_SYNC();
        if (PH_MASK & 64) { pg8::Gemm g{Hb, (const bf16*)((unsigned char*)Wb + W_D2), TOK, DM, FF}; pg8::ReverseOrder S; S.initr(TOK, DM, G, opaque(bid));
          pg8::EpiResid E{XB, ssD, 0.5f};
#ifdef DUP_PB
          { pg8::EpiResid E0{XB, nullptr, 0.0f}; pg8::gemm_phase<pg8::EpiResid, pg8::ReverseOrder, true, true>(lds, g, S, E0); __syncthreads(); }
#endif
          pg8::gemm_phase<pg8::EpiResid, pg8::ReverseOrder, true, true>(lds, g, S, E); }
        GRID_SYNC();
    }
    {
        const int t_ = pg8::opaque_v((int)threadIdx.x), lane = t_ & 63, gw = opaque(vcu) * NWAVES + __builtin_amdgcn_readfirstlane(t_ >> 6);
        const pg8::ss_t* ssF = SS + (size_t)6 * TOK; const bf16* xb_ = XB; float* out_ = X;
        f32x4 gn[4];
#pragma unroll
        for (int j = 0; j < 4; ++j) gn[j] = *(const f32x4*)(KA->norm_final + 256 * j + 4 * lane);
        for (int r0 = gw; r0 < TOK; r0 += 4 * NGW) {
            v2u w[4][4]; pg8::ss_t sv[4];
#pragma unroll
            for (int q = 0; q < 4; ++q) { const int r = r0 + q * NGW; sv[q] = ssF[r];
#pragma unroll
                for (int j = 0; j < 4; ++j) w[q][j] = *(const v2u*)(xb_ + (size_t)r * DM + 256 * j + 4 * lane); }
#pragma unroll
            for (int q = 0; q < 4; ++q) { const int r = r0 + q * NGW; const float rs = pg8::rs_of(sv[q]);
#pragma unroll
                for (int j = 0; j < 4; ++j) { const f32x4 v = (f32x4){bf_lo(w[q][j].x), bf_hi(w[q][j].x), bf_lo(w[q][j].y), bf_hi(w[q][j].y)}; *(f32x4*)(out_ + (size_t)r * DM + 256 * j + 4 * lane) = v * rs * gn[j]; } }
        }
    }
}
#undef KA
#undef X
#undef SS
#undef XB
#undef Wb
#undef Hb
#undef Zb
#undef MIXb
#undef ssA
#undef ssB
#undef ssC
#undef ssD

extern "C" void kernel_launch(void* const* d_in, const int* in_sizes, int n_in, void* d_out, int out_size, void* d_ws, size_t ws_size, hipStream_t stream) {
    static int grid = 0;
    if (grid == 0) {
        if (n_in != 18 || out_size != TOK * DM || ws_size < WS_END) { fprintf(stderr, "kernel_launch: unexpected shapes (n_in %d out %d ws %zu, need %zu)\n", n_in, out_size, ws_size, (size_t)WS_END); grid = -1; return; }
        int dev = 0, cus = 0, per_cu = 0;
        if (hipGetDevice(&dev) != hipSuccess || hipDeviceGetAttribute(&cus, hipDeviceAttributeMultiprocessorCount, dev) != hipSuccess) { grid = -1; return; }
        if (hipFuncSetAttribute((const void*)fwd_megakernel, hipFuncAttributeMaxDynamicSharedMemorySize, LDS_BYTES) != hipSuccess) { fprintf(stderr, "kernel_launch: hipFuncSetAttribute failed\n"); grid = -1; return; }
        if (hipOccupancyMaxActiveBlocksPerMultiprocessor(&per_cu, (const void*)fwd_megakernel, NWAVES * 64, LDS_BYTES) != hipSuccess || per_cu < 1) { fprintf(stderr, "kernel_launch: occupancy query says %d\n", per_cu); per_cu = 1; }
        (void)hipGetLastError();
        grid = cus;
    }
    if (grid < 0) return;
    if (hipMemsetAsync((char*)d_ws + WS_BAR, 0, WS_BAR_BYTES, stream) != hipSuccess) { fprintf(stderr, "kernel_launch: memset failed\n"); return; }
    Args a{};
    const float** f = (const float**)&a;
    for (int i = 0; i < 18; ++i) f[i] = (const float*)d_in[i];
    a.out = (float*)d_out; a.ws = (unsigned char*)d_ws;
    void* args[] = {&a};
    hipError_t e = hipLaunchCooperativeKernel((const void*)fwd_megakernel, dim3(grid), dim3(NWAVES * 64), args, LDS_BYTES, stream);
    if (e != hipSuccess) fprintf(stderr, "kernel_launch: cooperative launch failed: %s (grid %d)\n", hipGetErrorString(e), grid);
}
```
